# Optimizing an MI355X kernel written in HIP

```python
import math, functools
import jax, jax.numpy as jnp
from jax import lax
import numpy as np

D_MODEL = 1024
BATCH = 8
SEQ = 2048
DEPTH = 4
DEC_BATCH = 128
DEC_SEQ = 8
PAST_LEN = 16384
PAGE_SIZE = 128

F32 = jnp.float32
N_MIXERS = 4
N_META = 16
CHUNK = 128
EXPAND = 2
D_INNER = EXPAND * D_MODEL
NORM_EPS = 1e-6
L_LRU = (DEPTH + 3) // 4
L_S5 = (DEPTH + 2) // 4
L_RWKV = (DEPTH + 1) // 4
L_RET = DEPTH // 4
LRU_CONV_W = 4
LRU_BLOCKS = 16
LRU_BLOCK = D_INNER // LRU_BLOCKS
LRU_C = 8.0
S5_GROUP = 16
S5_GROUPS = D_INNER // S5_GROUP
S5_STATE = 64
RWKV_HEAD = 64
RWKV_HEADS = D_INNER // RWKV_HEAD
RWKV_DECAY_LORA = 64
RWKV_A_LORA = 64
RWKV_LN_EPS = 64e-5
RET_HEADS = 4
RET_DK = D_MODEL // RET_HEADS
RET_DV = D_INNER // RET_HEADS
ROPE_BASE = 10000.0

kernel_name = 'hybrid_lru_s5_rwkv7_retention_step'


def rms_norm(x, g):
    xf = x.astype(F32)
    y = xf * lax.rsqrt(jnp.mean(xf * xf, axis=-1, keepdims=True) + NORM_EPS)
    return (y * g.astype(F32)).astype(x.dtype)


def rope(x, pos):
    half = x.shape[-1] // 2
    inv = ROPE_BASE ** (-jnp.arange(half, dtype=F32) / half)
    ang = pos.astype(F32)[:, None] * inv[None, :]
    cos = jnp.cos(ang)[None, :, None, :]
    sin = jnp.sin(ang)[None, :, None, :]
    x1, x2 = x[..., :half], x[..., half:]
    return jnp.concatenate([x1 * cos - x2 * sin, x2 * cos + x1 * sin], axis=-1)


def _lin_comb(l, r):
    return (l[0] * r[0], r[0] * l[1] + r[1])


def _cmul(ar, ai, br, bi):
    return (ar * br - ai * bi, ar * bi + ai * br)


def _clin_comb(l, r):
    a_r, a_i = _cmul(l[0], l[1], r[0], r[1])
    t_r, t_i = _cmul(r[0], r[1], l[2], l[3])
    return (a_r, a_i, t_r + r[2], t_i + r[3])


def lru_chunk(p, carry, xn, pos0):
    conv_buf, h0 = carry
    b, l, _ = xn.shape
    uz = xn @ p['w_in']
    u, gate = uz[..., :D_INNER], uz[..., D_INNER:]
    ext = jnp.concatenate([conv_buf.astype(u.dtype), u], axis=1)
    cw = p['conv_w']
    xc = p['conv_b'] + sum(ext[:, j:j + l] * cw[j] for j in range(LRU_CONV_W))
    xb = xc.reshape(b, l, LRU_BLOCKS, LRU_BLOCK)
    gate_r = jax.nn.sigmoid((jnp.einsum('blhi,hij->blhj', xb, p['wa']) + p['ba']).astype(F32)).reshape(b, l, D_INNER)
    gate_i = jax.nn.sigmoid((jnp.einsum('blhi,hij->blhj', xb, p['wx']) + p['bx']).astype(F32)).reshape(b, l, D_INNER)
    log_a = -LRU_C * gate_r * jax.nn.softplus(-p['lam'].astype(F32))
    a = jnp.exp(log_a)
    bx = jnp.sqrt(-jnp.expm1(2.0 * log_a)) * gate_i * xc.astype(F32)
    bx = bx.at[:, 0].add(a[:, 0] * h0.astype(F32))
    _, h = lax.associative_scan(_lin_comb, (a, bx), axis=1)
    y = h.astype(xn.dtype) * jax.nn.silu(gate)
    return (ext[:, l:].astype(conv_buf.dtype), h[:, -1].astype(h0.dtype)), y @ p['w_out']


def s5_chunk(p, carry, xn, pos0):
    s_re, s_im = carry
    b, l, _ = xn.shape
    uz = xn @ p['w_in']
    u, gate = uz[..., :D_INNER], uz[..., D_INNER:]
    uf = u.astype(F32)
    dt = jnp.exp(p['log_dt'].astype(F32))[:, None]
    a_re, a_im = p['a_re'].astype(F32), p['a_im'].astype(F32)
    mag = jnp.exp(dt * a_re)
    ang = dt * a_im
    ab_re, ab_im = mag * jnp.cos(ang), mag * jnp.sin(ang)
    den = a_re * a_re + a_im * a_im
    f_re = ((ab_re - 1.0) * a_re + ab_im * a_im) / den
    f_im = (ab_im * a_re - (ab_re - 1.0) * a_im) / den
    b_re, b_im = p['b_re'].astype(F32), p['b_im'].astype(F32)
    bb_re = f_re[..., None] * b_re - f_im[..., None] * b_im
    bb_im = f_re[..., None] * b_im + f_im[..., None] * b_re
    ug = uf.reshape(b, l, S5_GROUPS, S5_GROUP)
    bu_re = jnp.einsum('blgc,gnc->blgn', ug, bb_re)
    bu_im = jnp.einsum('blgc,gnc->blgn', ug, bb_im)
    sr, si = s_re.astype(F32), s_im.astype(F32)
    bu_re = bu_re.at[:, 0].add(ab_re * sr - ab_im * si)
    bu_im = bu_im.at[:, 0].add(ab_re * si + ab_im * sr)
    shp = bu_re.shape
    _, _, x_re, x_im = lax.associative_scan(
        _clin_comb, (jnp.broadcast_to(ab_re, shp), jnp.broadcast_to(ab_im, shp), bu_re, bu_im), axis=1)
    c_re, c_im = p['c_re'].astype(F32), p['c_im'].astype(F32)
    y = jnp.einsum('blgn,gcn->blgc', x_re, c_re) - jnp.einsum('blgn,gcn->blgc', x_im, c_im)
    y = y.reshape(b, l, D_INNER) + p['d'].astype(F32) * uf
    y = jax.nn.gelu(y).astype(xn.dtype)
    y = y * jax.nn.sigmoid(y @ p['glu_w'] + p['glu_b'])
    y = y * jax.nn.silu(gate)
    return (x_re[:, -1].astype(s_re.dtype), x_im[:, -1].astype(s_im.dtype)), y @ p['w_out']


def rwkv_chunk(p, carry, xn, pos0):
    x_prev, s0 = carry
    b, l, _ = xn.shape
    shifted = jnp.concatenate([x_prev[:, None].astype(xn.dtype), xn[:, :-1]], axis=1)
    xx = shifted - xn
    mu = p['mu']
    xr, xw, xk, xv, xa, xg = (xn + xx * mu[n] for n in range(6))
    r = xr @ p['w_r']
    k = xk @ p['w_k']
    v = xv @ p['w_v']
    g = jax.nn.silu(xg @ p['w_g'])
    w_raw = (p['w0'] + jnp.tanh(xw @ p['w1']) @ p['w2']).astype(F32)
    decay = jnp.exp(-jnp.exp(-jax.nn.softplus(-w_raw) - 0.5))
    a = jax.nn.sigmoid((p['a0'] + (xa @ p['a1']) @ p['a2']).astype(F32))
    hd = lambda t: t.astype(F32).reshape(b, l, RWKV_HEADS, RWKV_HEAD)
    per_head = lambda t: t.astype(F32).reshape(RWKV_HEADS, RWKV_HEAD)
    r, k, v, a, decay = hd(r), hd(k), hd(v), hd(a), hd(decay)
    kk = k * per_head(p['k_k'])
    kk = kk * lax.rsqrt(jnp.maximum(jnp.sum(kk * kk, axis=-1, keepdims=True), 1e-24))
    k = k * (1.0 + (a - 1.0) * per_head(p['k_a']))
    tm = lambda t: jnp.swapaxes(t, 0, 1)

    def step(s, inp):
        r_t, w_t, k_t, v_t, a_t, b_t = inp
        sa = jnp.einsum('bhvk,bhk->bhv', s, a_t)
        s = s * w_t[:, :, None, :] + sa[..., None] * b_t[:, :, None, :] + v_t[..., None] * k_t[:, :, None, :]
        return s, jnp.einsum('bhvk,bhk->bhv', s, r_t)

    s_new, y = lax.scan(step, s0.astype(F32), (tm(r), tm(decay), tm(k), tm(v), tm(-kk), tm(kk * a)))
    y = tm(y)
    mean = jnp.mean(y, axis=-1, keepdims=True)
    var = jnp.mean(jnp.square(y - mean), axis=-1, keepdims=True)
    yn = (y - mean) * lax.rsqrt(var + RWKV_LN_EPS) * per_head(p['ln_w']) + per_head(p['ln_b'])
    bonus = jnp.sum(r * k * per_head(p['r_k']), axis=-1, keepdims=True) * v
    out = (yn + bonus).reshape(b, l, D_INNER).astype(xn.dtype) * g
    return (xn[:, -1].astype(x_prev.dtype), s_new.astype(s0.dtype)), out @ p['w_o']


def ret_chunk(p, carry, xn, pos0):
    (s0,) = carry
    b, l, _ = xn.shape
    pos = pos0 + jnp.arange(l, dtype=jnp.int32)
    q = rope((xn @ p['w_q']).astype(F32).reshape(b, l, RET_HEADS, RET_DK), pos)
    k = rope((xn @ p['w_k']).astype(F32).reshape(b, l, RET_HEADS, RET_DK), pos) * (RET_DK ** -0.5)
    v = (xn @ p['w_v']).astype(F32).reshape(b, l, RET_HEADS, RET_DV)
    g = jax.nn.silu(xn @ p['w_g'])
    log_g = jnp.log1p(-jnp.exp2(-5.0 - jnp.arange(RET_HEADS, dtype=F32)))
    n = jnp.arange(l, dtype=F32)
    diff = n[:, None] - n[None, :]
    mask = jnp.where(diff[None] >= 0, jnp.exp(diff[None] * log_g[:, None, None]), 0.0)
    scores = jnp.einsum('blhd,bmhd->bhlm', q, k) * mask
    s0f = s0.astype(F32)
    y = jnp.einsum('bhlm,bmhe->blhe', scores, v)
    y = y + jnp.einsum('blhd,bhde->blhe', q, s0f) * jnp.exp((n[:, None] + 1.0) * log_g)[None, :, :, None]
    kw = k * jnp.exp((l - 1.0 - n)[:, None] * log_g)[None, :, :, None]
    s_new = jnp.exp(l * log_g)[None, :, None, None] * s0f + jnp.einsum('bmhd,bmhe->bhde', kw, v)
    y = y * lax.rsqrt(jnp.mean(y * y, axis=-1, keepdims=True) + NORM_EPS)
    out = y.reshape(b, l, D_INNER).astype(xn.dtype) * g
    return (s_new.astype(s0.dtype),), out @ p['w_o']


def run_prompt(chunk_fn, carry, xn):
    b, t, d = xn.shape
    carry, y_meta = chunk_fn(carry, xn[:, :N_META], 0)
    n_chunks = (t - N_META) // CHUNK
    xc = jnp.swapaxes(xn[:, N_META:].reshape(b, n_chunks, CHUNK, d), 0, 1)
    starts = N_META + CHUNK * jnp.arange(n_chunks, dtype=jnp.int32)

    def body(c, inp):
        start, xk = inp
        return chunk_fn(c, xk, start)

    carry, yc = lax.scan(body, carry, (starts, xc))
    y = jnp.swapaxes(yc, 0, 1).reshape(b, n_chunks * CHUNK, yc.shape[-1])
    return carry, jnp.concatenate([y_meta.astype(y.dtype), y], axis=1)


def prompt_init_carry(m, b):
    z = lambda *s: jnp.zeros(s, F32)
    if m == 0:
        return (z(b, LRU_CONV_W - 1, D_INNER), z(b, D_INNER))
    if m == 1:
        return (z(b, S5_GROUPS, S5_STATE), z(b, S5_GROUPS, S5_STATE))
    if m == 2:
        return (z(b, D_MODEL), z(b, RWKV_HEADS, RWKV_HEAD, RWKV_HEAD))
    return (z(b, RET_HEADS, RET_DK, RET_DV),)


def setup_inputs(seed: int = 0) -> dict:
    key = jax.random.key(seed)
    keys = iter(jax.random.split(key, 96))

    def nrm(shape, scale):
        return scale * jax.random.normal(next(keys), shape, F32)

    def uni(shape, lo, hi):
        return jax.random.uniform(next(keys), shape, F32, lo, hi)

    D, E = D_MODEL, D_INNER
    sd, se = D ** -0.5, E ** -0.5
    u_lam = uni((L_LRU, E), 0.9, 0.999)
    s_lam = u_lam ** (1.0 / LRU_C)
    w0_base = jnp.tile(jnp.linspace(-6.0, -1.0, RWKV_HEAD, dtype=F32), RWKV_HEADS)
    return {
        'x_prompt': nrm((BATCH, SEQ, D), 1.0),
        'x_sample': nrm((DEC_BATCH, DEC_SEQ, D), 1.0),
        'state_lru_conv': nrm((L_LRU, DEC_BATCH, LRU_CONV_W - 1, E), 1.0),
        'state_lru_h': nrm((L_LRU, DEC_BATCH, E), 0.5),
        'state_s5_re': nrm((L_S5, DEC_BATCH, S5_GROUPS, S5_STATE), 0.1),
        'state_s5_im': nrm((L_S5, DEC_BATCH, S5_GROUPS, S5_STATE), 0.1),
        'state_rwkv_shift': nrm((L_RWKV, DEC_BATCH, D), 1.0),
        'state_rwkv_wkv': nrm((L_RWKV, DEC_BATCH, RWKV_HEADS, RWKV_HEAD, RWKV_HEAD), 0.1),
        'state_ret': nrm((L_RET, DEC_BATCH, RET_HEADS, RET_DK, RET_DV), 0.1),
        'meta_tokens': nrm((N_META, D), 1.0),
        'norm_pre': 1.0 + nrm((DEPTH, D), 0.02),
        'norm_post': 1.0 + nrm((DEPTH, D), 0.02),
        'lru_w_in': nrm((L_LRU, D, 2 * E), sd),
        'lru_conv_w': nrm((L_LRU, LRU_CONV_W, E), 0.5),
        'lru_conv_b': nrm((L_LRU, E), 0.01),
        'lru_wa': nrm((L_LRU, LRU_BLOCKS, LRU_BLOCK, LRU_BLOCK), LRU_BLOCK ** -0.5),
        'lru_ba': nrm((L_LRU, LRU_BLOCKS, LRU_BLOCK), 0.01),
        'lru_wx': nrm((L_LRU, LRU_BLOCKS, LRU_BLOCK, LRU_BLOCK), LRU_BLOCK ** -0.5),
        'lru_bx': nrm((L_LRU, LRU_BLOCKS, LRU_BLOCK), 0.01),
        'lru_lam': jnp.log(s_lam) - jnp.log1p(-s_lam),
        'lru_w_out': nrm((L_LRU, E, D), se),
        's5_w_in': nrm((L_S5, D, 2 * E), sd),
        's5_log_dt': uni((L_S5, S5_GROUPS), math.log(1e-3), math.log(1e-1)),
        's5_a_re': -0.5 + nrm((L_S5, S5_GROUPS, S5_STATE), 0.01),
        's5_a_im': jnp.pi * jnp.arange(S5_STATE, dtype=F32) + nrm((L_S5, S5_GROUPS, S5_STATE), 0.01),
        's5_b_re': nrm((L_S5, S5_GROUPS, S5_STATE, S5_GROUP), (2 * S5_GROUP) ** -0.5),
        's5_b_im': nrm((L_S5, S5_GROUPS, S5_STATE, S5_GROUP), (2 * S5_GROUP) ** -0.5),
        's5_c_re': nrm((L_S5, S5_GROUPS, S5_GROUP, S5_STATE), (2 * S5_STATE) ** -0.5),
        's5_c_im': nrm((L_S5, S5_GROUPS, S5_GROUP, S5_STATE), (2 * S5_STATE) ** -0.5),
        's5_d': nrm((L_S5, E), 1.0),
        's5_glu_w': nrm((L_S5, E, E), se),
        's5_glu_b': nrm((L_S5, E), 0.01),
        's5_w_out': nrm((L_S5, E, D), se),
        'rwkv_mu': uni((L_RWKV, 6, D), 0.0, 1.0),
        'rwkv_w_r': nrm((L_RWKV, D, E), sd),
        'rwkv_w_k': nrm((L_RWKV, D, E), sd),
        'rwkv_w_v': nrm((L_RWKV, D, E), sd),
        'rwkv_w_g': nrm((L_RWKV, D, E), sd),
        'rwkv_w0': w0_base + nrm((L_RWKV, E), 0.1),
        'rwkv_w1': nrm((L_RWKV, D, RWKV_DECAY_LORA), sd),
        'rwkv_w2': nrm((L_RWKV, RWKV_DECAY_LORA, E), 0.1 * RWKV_DECAY_LORA ** -0.5),
        'rwkv_a0': nrm((L_RWKV, E), 0.1),
        'rwkv_a1': nrm((L_RWKV, D, RWKV_A_LORA), sd),
        'rwkv_a2': nrm((L_RWKV, RWKV_A_LORA, E), 0.1 * RWKV_A_LORA ** -0.5),
        'rwkv_k_k': 0.85 + nrm((L_RWKV, E), 0.02),
        'rwkv_k_a': 1.0 + nrm((L_RWKV, E), 0.02),
        'rwkv_r_k': nrm((L_RWKV, E), 0.1),
        'rwkv_ln_w': 1.0 + nrm((L_RWKV, E), 0.02),
        'rwkv_ln_b': nrm((L_RWKV, E), 0.01),
        'rwkv_w_o': nrm((L_RWKV, E, D), se),
        'ret_w_q': nrm((L_RET, D, RET_HEADS * RET_DK), sd),
        'ret_w_k': nrm((L_RET, D, RET_HEADS * RET_DK), sd),
        'ret_w_v': nrm((L_RET, D, E), sd),
        'ret_w_g': nrm((L_RET, D, E), sd),
        'ret_w_o': nrm((L_RET, E, D), se),
    }


def reference(x_prompt, x_sample, state_lru_conv, state_lru_h, state_s5_re, state_s5_im,
              state_rwkv_shift, state_rwkv_wkv, state_ret, meta_tokens, norm_pre, norm_post,
              lru_w_in, lru_conv_w, lru_conv_b, lru_wa, lru_ba, lru_wx, lru_bx, lru_lam, lru_w_out,
              s5_w_in, s5_log_dt, s5_a_re, s5_a_im, s5_b_re, s5_b_im, s5_c_re, s5_c_im, s5_d,
              s5_glu_w, s5_glu_b, s5_w_out,
              rwkv_mu, rwkv_w_r, rwkv_w_k, rwkv_w_v, rwkv_w_g, rwkv_w0, rwkv_w1, rwkv_w2,
              rwkv_a0, rwkv_a1, rwkv_a2, rwkv_k_k, rwkv_k_a, rwkv_r_k, rwkv_ln_w, rwkv_ln_b, rwkv_w_o,
              ret_w_q, ret_w_k, ret_w_v, ret_w_g, ret_w_o):
    params = (
        dict(w_in=lru_w_in, conv_w=lru_conv_w, conv_b=lru_conv_b, wa=lru_wa, ba=lru_ba,
             wx=lru_wx, bx=lru_bx, lam=lru_lam, w_out=lru_w_out),
        dict(w_in=s5_w_in, log_dt=s5_log_dt, a_re=s5_a_re, a_im=s5_a_im, b_re=s5_b_re, b_im=s5_b_im,
             c_re=s5_c_re, c_im=s5_c_im, d=s5_d, glu_w=s5_glu_w, glu_b=s5_glu_b, w_out=s5_w_out),
        dict(mu=rwkv_mu, w_r=rwkv_w_r, w_k=rwkv_w_k, w_v=rwkv_w_v, w_g=rwkv_w_g, w0=rwkv_w0,
             w1=rwkv_w1, w2=rwkv_w2, a0=rwkv_a0, a1=rwkv_a1, a2=rwkv_a2, k_k=rwkv_k_k,
             k_a=rwkv_k_a, r_k=rwkv_r_k, ln_w=rwkv_ln_w, ln_b=rwkv_ln_b, w_o=rwkv_w_o),
        dict(w_q=ret_w_q, w_k=ret_w_k, w_v=ret_w_v, w_g=ret_w_g, w_o=ret_w_o),
    )
    chunk_fns = (lru_chunk, s5_chunk, rwkv_chunk, ret_chunk)
    sample_states = ((state_lru_conv, state_lru_h), (state_s5_re, state_s5_im),
                     (state_rwkv_shift, state_rwkv_wkv), (state_ret,))
    b = x_prompt.shape[0]
    meta = jnp.broadcast_to(meta_tokens[None].astype(x_prompt.dtype), (b, N_META, D_MODEL))
    hp = jnp.concatenate([meta, x_prompt], axis=1)
    hs = x_sample
    new_p = [[] for _ in range(N_MIXERS)]
    new_s = [[] for _ in range(N_MIXERS)]
    for i in range(DEPTH):
        m, j = i % N_MIXERS, i // N_MIXERS
        p = {name: w[j] for name, w in params[m].items()}
        fn = functools.partial(chunk_fns[m], p)
        carry_p, z_p = run_prompt(fn, prompt_init_carry(m, b), rms_norm(hp, norm_pre[i]))
        carry_s, z_s = fn(tuple(s[j] for s in sample_states[m]), rms_norm(hs, norm_pre[i]), PAST_LEN)
        hp = hp + rms_norm(z_p, norm_post[i])
        hs = hs + rms_norm(z_s, norm_post[i])
        new_p[m].append(carry_p)
        new_s[m].append(carry_s)

    def stk(lst, idx):
        return jnp.stack([c[idx] for c in lst])

    y_prompt = hp[:, N_META:]
    y_sample = hs
    return (y_prompt, y_sample,
            stk(new_p[0], 0), stk(new_p[0], 1), stk(new_p[1], 0), stk(new_p[1], 1),
            stk(new_p[2], 0), stk(new_p[2], 1), stk(new_p[3], 0),
            stk(new_s[0], 0), stk(new_s[0], 1), stk(new_s[1], 0), stk(new_s[1], 1),
            stk(new_s[2], 0), stk(new_s[2], 1), stk(new_s[3], 0))
```

```cpp
#include <hip/hip_runtime.h>
#include <hip/hip_cooperative_groups.h>
#include <cstdio>
namespace cg = cooperative_groups;

typedef unsigned short bf16_t;
typedef short bf16x8 __attribute__((ext_vector_type(8)));
typedef float f32x4 __attribute__((ext_vector_type(4)));

constexpr int D = 1024, E = 2048, NB = 8, SEQT = 2064, NSB = 128, DSEQ = 8;
constexpr int RP = NB * SEQT;
constexpr int R = RP + NSB * DSEQ;
constexpr int MT = R / 128;
constexpr int RPAD = 17664;
constexpr int NTHREADS = 512;
constexpr int LDS_BYTES = 147456;
constexpr float EPS = 1e-6f;

constexpr size_t O_YP = 0;
constexpr size_t O_YS = O_YP + (size_t)NB * 2048 * D;
constexpr size_t O_P_LRU_CONV = O_YS + (size_t)NSB * DSEQ * D;
constexpr size_t O_P_LRU_H = O_P_LRU_CONV + (size_t)NB * 3 * E;
constexpr size_t O_P_S5_RE = O_P_LRU_H + (size_t)NB * E;
constexpr size_t O_P_S5_IM = O_P_S5_RE + (size_t)NB * 128 * 64;
constexpr size_t O_P_RW_SHIFT = O_P_S5_IM + (size_t)NB * 128 * 64;
constexpr size_t O_P_RW_WKV = O_P_RW_SHIFT + (size_t)NB * D;
constexpr size_t O_P_RET = O_P_RW_WKV + (size_t)NB * 32 * 64 * 64;
constexpr size_t O_S_LRU_CONV = O_P_RET + (size_t)NB * 4 * 256 * 512;
constexpr size_t O_S_LRU_H = O_S_LRU_CONV + (size_t)NSB * 3 * E;
constexpr size_t O_S_S5_RE = O_S_LRU_H + (size_t)NSB * E;
constexpr size_t O_S_S5_IM = O_S_S5_RE + (size_t)NSB * 128 * 64;
constexpr size_t O_S_RW_SHIFT = O_S_S5_IM + (size_t)NSB * 128 * 64;
constexpr size_t O_S_RW_WKV = O_S_RW_SHIFT + (size_t)NSB * D;
constexpr size_t O_S_RET = O_S_RW_WKV + (size_t)NSB * 32 * 64 * 64;

enum { I_XP = 0, I_XS, I_ST_LRU_CONV, I_ST_LRU_H, I_ST_S5_RE, I_ST_S5_IM, I_ST_RW_SHIFT, I_ST_RW_WKV, I_ST_RET, I_META,
       I_NPRE, I_NPOST, I_LRU_WIN, I_LRU_CW, I_LRU_CB, I_LRU_WA, I_LRU_BA, I_LRU_WX, I_LRU_BX, I_LRU_LAM, I_LRU_WOUT,
       I_S5_WIN, I_S5_LOGDT, I_S5_ARE, I_S5_AIM, I_S5_BRE, I_S5_BIM, I_S5_CRE, I_S5_CIM, I_S5_D, I_S5_GLUW, I_S5_GLUB, I_S5_WOUT,
       I_RW_MU, I_RW_WR, I_RW_WK, I_RW_WV, I_RW_WG, I_RW_W0, I_RW_W1, I_RW_W2, I_RW_A0, I_RW_A1, I_RW_A2, I_RW_KK, I_RW_KA,
       I_RW_RK, I_RW_LNW, I_RW_LNB, I_RW_WO, I_RT_WQ, I_RT_WK, I_RT_WV, I_RT_WG, I_RT_WO, N_IN };

enum { W_LRU_IN = 0, W_LRU_G, W_LRU_OUT, W_S5_IN, W_S5_GLU, W_S5_OUT, W_RW_IN, W_RW_L2, W_RW_OUT, W_RT_IN, W_RT_OUT, N_W };
__host__ __device__ constexpr int w_rows(int j) { return j == W_LRU_IN ? 4096 : j == W_LRU_G ? 4096 : j == W_LRU_OUT ? 1024 : j == W_S5_IN ? 4096 : j == W_S5_GLU ? 2048 :
                                 j == W_S5_OUT ? 1024 : j == W_RW_IN ? 8704 : j == W_RW_L2 ? 4096 : j == W_RW_OUT ? 1024 : j == W_RT_IN ? 6144 : 1024; }
__host__ __device__ constexpr int w_k(int j) { return j == W_LRU_IN ? 1024 : j == W_LRU_G ? 128 : j == W_LRU_OUT ? 2048 : j == W_S5_IN ? 1024 : j == W_S5_GLU ? 2048 :
                              j == W_S5_OUT ? 2048 : j == W_RW_IN ? 1024 : j == W_RW_L2 ? 64 : j == W_RW_OUT ? 2048 : j == W_RT_IN ? 1024 : 2048; }

struct Params {
    const float* in[N_IN];
    float* out;
    float* X; float* Z;
    bf16_t* XN; bf16_t* XM;
    float* X2;
    bf16_t* ACT[7];
    bf16_t* L1;
    float* SSP;
    bf16_t* W[N_W];
    unsigned* bar;
};

#define LAS __attribute__((address_space(3)))
typedef float cvt_f32x2 __attribute__((ext_vector_type(2)));
typedef __bf16 cvt_bf16x2 __attribute__((ext_vector_type(2)));
__device__ __forceinline__ unsigned pack2(float a, float b) { const cvt_f32x2 v = {a, b}; const cvt_bf16x2 h = __builtin_convertvector(v, cvt_bf16x2); return __builtin_bit_cast(unsigned, h); }
__device__ __forceinline__ bf16_t f2bf(float f) { return (bf16_t)(pack2(f, f) & 0xffffu); }
__device__ __forceinline__ float bf2f(bf16_t h) { return __uint_as_float(((unsigned)h) << 16); }
__device__ __forceinline__ float bflo(unsigned u) { return __uint_as_float(u << 16); }
__device__ __forceinline__ float bfhi(unsigned u) { return __uint_as_float(u & 0xffff0000u); }
__device__ __forceinline__ float rcpf_(float x) { return __builtin_amdgcn_rcpf(x); }
__device__ __forceinline__ float sigmoidf_(float x) { return rcpf_(1.0f + __expf(-x)); }
__device__ __forceinline__ float siluf_(float x) { return x * rcpf_(1.0f + __expf(-x)); }
__device__ __forceinline__ float tanhf_(float x) { return 1.0f - 2.0f * rcpf_(1.0f + __expf(2.0f * x)); }
__device__ __forceinline__ float softplusf_(float y) { return fmaxf(y, 0.0f) + __logf(1.0f + __expf(-fabsf(y))); }
__device__ __forceinline__ float wave_sum(float v) {
#pragma unroll
    for (int o = 32; o > 0; o >>= 1) v += __shfl_xor(v, o, 64);
    return v;
}
__device__ __forceinline__ void wave_lds_sync() { asm volatile("s_waitcnt lgkmcnt(0)" ::: "memory"); }
__device__ __forceinline__ f32x4 mfma16(bf16x8 a, bf16x8 b, f32x4 c) { return __builtin_amdgcn_mfma_f32_16x16x32_bf16(a, b, c, 0, 0, 0); }
__device__ __forceinline__ int opaque_tid() { int t = threadIdx.x; asm volatile("" : "+v"(t)); return t; }
__device__ __forceinline__ uint2 pack4(f32x4 v) { uint2 r; r.x = pack2(v[0], v[1]); r.y = pack2(v[2], v[3]); return r; }

__device__ __forceinline__ void phase_norm(const Params& p, int mode, int layer, const float* Xs, float* Xd) {
    const int lane = opaque_tid() & 63, wave = opaque_tid() >> 6;
    const int gw = blockIdx.x * 8 + wave, nw = gridDim.x * 8;
    float4 gpv[4], gqv[4];
#pragma unroll
    for (int k = 0; k < 4; ++k) {
        gpv[k] = mode != 0 ? *(const float4*)(p.in[I_NPOST] + (size_t)(layer - 1) * D + k * 256 + lane * 4) : make_float4(0.f, 0.f, 0.f, 0.f);
        gqv[k] = mode != 3 ? *(const float4*)(p.in[I_NPRE] + (size_t)layer * D + k * 256 + lane * 4) : make_float4(0.f, 0.f, 0.f, 0.f);
    }
    for (int r = gw; r < R; r += nw) {
        const bool prompt = r < RP;
        const int b = prompt ? r / SEQT : (r - RP) / DSEQ;
        const int t = prompt ? r % SEQT : (r - RP) % DSEQ;
        float4 x[4];
        if (mode == 0) {
            const float* src = prompt ? (t < 16 ? p.in[I_META] + (size_t)t * D : p.in[I_XP] + ((size_t)b * 2048 + (t - 16)) * D)
                                      : p.in[I_XS] + (size_t)(r - RP) * D;
#pragma unroll
            for (int k = 0; k < 4; ++k) x[k] = *(const float4*)(src + k * 256 + lane * 4);
        } else {
            float4 z[4]; float ss = 0.f;
#pragma unroll
            for (int k = 0; k < 4; ++k) {
                x[k] = *(const float4*)(Xs + (size_t)r * D + k * 256 + lane * 4);
                z[k] = *(const float4*)(p.Z + (size_t)r * D + k * 256 + lane * 4);
                ss += z[k].x * z[k].x + z[k].y * z[k].y + z[k].z * z[k].z + z[k].w * z[k].w;
            }
            ss = wave_sum(ss);
            const float rs = rsqrtf(ss * (1.0f / D) + EPS);
#pragma unroll
            for (int k = 0; k < 4; ++k) {
                const float4 g = gpv[k];
                x[k].x += z[k].x * rs * g.x; x[k].y += z[k].y * rs * g.y; x[k].z += z[k].z * rs * g.z; x[k].w += z[k].w * rs * g.w;
            }
        }
        if (mode == 3) {
            if (prompt) {
                if (t >= 16) {
                    float* dst = p.out + O_YP + ((size_t)b * 2048 + (t - 16)) * D;
#pragma unroll
                    for (int k = 0; k < 4; ++k) *(float4*)(dst + k * 256 + lane * 4) = x[k];
                }
            } else {
                float* dst = p.out + O_YS + (size_t)(r - RP) * D;
#pragma unroll
                for (int k = 0; k < 4; ++k) *(float4*)(dst + k * 256 + lane * 4) = x[k];
            }
            continue;
        }
        float ss2 = 0.f;
#pragma unroll
        for (int k = 0; k < 4; ++k) {
            *(float4*)(Xd + (size_t)r * D + k * 256 + lane * 4) = x[k];
            ss2 += x[k].x * x[k].x + x[k].y * x[k].y + x[k].z * x[k].z + x[k].w * x[k].w;
        }
        ss2 = wave_sum(ss2);
        const float rs2 = rsqrtf(ss2 * (1.0f / D) + EPS);
#pragma unroll
        for (int k = 0; k < 4; ++k) {
            const float4 g = gqv[k];
            uint2 pk; pk.x = pack2(x[k].x * rs2 * g.x, x[k].y * rs2 * g.y); pk.y = pack2(x[k].z * rs2 * g.z, x[k].w * rs2 * g.w);
            *(uint2*)(p.XN + (size_t)r * D + k * 256 + lane * 4) = pk;
        }
    }
}
__device__ __forceinline__ void phase_norm_rwkv(const Params& p, const float* Xs, float* Xd) {
    const int lane = opaque_tid() & 63, wave = opaque_tid() >> 6;
    const int gw = blockIdx.x * 8 + wave, nw = gridDim.x * 8;
    float4 gpv[4], gqv[4], muv[6][4];
#pragma unroll
    for (int k = 0; k < 4; ++k) {
        gpv[k] = *(const float4*)(p.in[I_NPOST] + (size_t)1 * D + k * 256 + lane * 4);
        gqv[k] = *(const float4*)(p.in[I_NPRE] + (size_t)2 * D + k * 256 + lane * 4);
#pragma unroll
        for (int j = 0; j < 6; ++j) {
            const int mi = j == 0 ? 0 : j == 1 ? 2 : j == 2 ? 3 : j == 3 ? 5 : j == 4 ? 1 : 4;
            muv[j][k] = *(const float4*)(p.in[I_RW_MU] + mi * D + k * 256 + lane * 4);
        }
    }
    for (int r0 = gw * 9; r0 < R; r0 += nw * 9) {
    float4 prev[4];
#pragma unroll
    for (int k = 0; k < 4; ++k) prev[k] = make_float4(0.f, 0.f, 0.f, 0.f);
    for (int rr = -1; rr < 9; ++rr) {
        const int r = r0 + rr;
        if (r < 0 || r >= R) continue;
        const bool prompt = r < RP;
        const int b = prompt ? r / SEQT : (r - RP) / DSEQ;
        const int t = prompt ? r % SEQT : (r - RP) % DSEQ;
        const int tlast = prompt ? SEQT - 1 : DSEQ - 1;
        if (rr < 0 && t == tlast) continue;
        float4 x[4], z[4]; float ss = 0.f;
#pragma unroll
        for (int k = 0; k < 4; ++k) {
            x[k] = *(const float4*)(Xs + (size_t)r * D + k * 256 + lane * 4);
            z[k] = *(const float4*)(p.Z + (size_t)r * D + k * 256 + lane * 4);
            ss += z[k].x * z[k].x + z[k].y * z[k].y + z[k].z * z[k].z + z[k].w * z[k].w;
        }
        ss = wave_sum(ss);
        const float rs = rsqrtf(ss * (1.0f / D) + EPS);
        float ss2 = 0.f;
#pragma unroll
        for (int k = 0; k < 4; ++k) {
            const float4 g = gpv[k];
            x[k].x += z[k].x * rs * g.x; x[k].y += z[k].y * rs * g.y; x[k].z += z[k].z * rs * g.z; x[k].w += z[k].w * rs * g.w;
            ss2 += x[k].x * x[k].x + x[k].y * x[k].y + x[k].z * x[k].z + x[k].w * x[k].w;
        }
        ss2 = wave_sum(ss2);
        const float rs2 = rsqrtf(ss2 * (1.0f / D) + EPS);
        float4 xn[4];
#pragma unroll
        for (int k = 0; k < 4; ++k) {
            const float4 g = gqv[k];
            xn[k].x = x[k].x * rs2 * g.x; xn[k].y = x[k].y * rs2 * g.y; xn[k].z = x[k].z * rs2 * g.z; xn[k].w = x[k].w * rs2 * g.w;
        }
        if (rr >= 0) {
            if (t == 0) {
#pragma unroll
                for (int k = 0; k < 4; ++k) prev[k] = prompt ? make_float4(0.f, 0.f, 0.f, 0.f) : *(const float4*)(p.in[I_ST_RW_SHIFT] + (size_t)b * D + k * 256 + lane * 4);
            }
#pragma unroll
            for (int k = 0; k < 4; ++k) {
                const int c = k * 256 + lane * 4;
                *(float4*)(Xd + (size_t)r * D + c) = x[k];
                if (t == tlast) *(float4*)(p.out + (prompt ? O_P_RW_SHIFT : O_S_RW_SHIFT) + (size_t)b * D + c) = xn[k];
                const float4 dx = make_float4(prev[k].x - xn[k].x, prev[k].y - xn[k].y, prev[k].z - xn[k].z, prev[k].w - xn[k].w);
#pragma unroll
                for (int j = 0; j < 6; ++j) {
                    const float4 m = muv[j][k];
                    uint2 pk; pk.x = pack2(xn[k].x + dx.x * m.x, xn[k].y + dx.y * m.y); pk.y = pack2(xn[k].z + dx.z * m.z, xn[k].w + dx.w * m.w);
                    *(uint2*)(p.XM + ((size_t)j * RPAD + r) * D + c) = pk;
                }
            }
        }
#pragma unroll
        for (int k = 0; k < 4; ++k) prev[k] = xn[k];
    }
    }
}

__device__ __forceinline__ const float* wsrc(const Params& p, int job, int nd, int& stride) {
    switch (job) {
    case W_LRU_IN: stride = 4096; return p.in[I_LRU_WIN] + nd;
    case W_LRU_G: {
        const int h = nd >> 8, q = (nd >> 7) & 1, pp = nd & 127, wn = pp >> 6, part = (pp >> 5) & 1, chl = wn * 32 + (pp & 31);
        stride = 128; return (part ? p.in[I_LRU_WX] : p.in[I_LRU_WA]) + (size_t)h * 128 * 128 + q * 64 + chl;
    }
    case W_LRU_OUT: stride = 1024; return p.in[I_LRU_WOUT] + nd;
    case W_S5_IN: stride = 4096; return p.in[I_S5_WIN] + nd;
    case W_S5_GLU: stride = 2048; return p.in[I_S5_GLUW] + nd;
    case W_S5_OUT: stride = 1024; return p.in[I_S5_WOUT] + nd;
    case W_RW_IN: {
        if (nd < 8192) { stride = 2048; const int w = nd >> 11; const float* s = w == 0 ? p.in[I_RW_WR] : w == 1 ? p.in[I_RW_WK] : w == 2 ? p.in[I_RW_WV] : p.in[I_RW_WG]; return s + (nd & 2047); }
        stride = 64;
        if (nd < 8448) { const int c = nd - 8192; return c < 64 ? p.in[I_RW_W1] + c : nullptr; }
        const int c = nd - 8448; return c < 64 ? p.in[I_RW_A1] + c : nullptr;
    }
    case W_RW_L2: stride = 2048; return nd < 2048 ? p.in[I_RW_W2] + nd : p.in[I_RW_A2] + (nd - 2048);
    case W_RW_OUT: stride = 1024; return p.in[I_RW_WO] + nd;
    case W_RT_IN: {
        if (nd < 2048) {
            stride = 1024; return (nd < 1024 ? p.in[I_RT_WQ] : p.in[I_RT_WK]) + (nd & 1023);
        }
        stride = 2048; return nd < 4096 ? p.in[I_RT_WV] + (nd - 2048) : p.in[I_RT_WG] + (nd - 4096);
    }
    default: stride = 1024; return p.in[I_RT_WO] + nd;
    }
}

__device__ __forceinline__ void phase_prep(const Params& p, char* smem) {
    float* tile = (float*)smem;
    const int tid = opaque_tid();
    int total = 0;
#pragma unroll
    for (int j = 0; j < N_W; ++j) total += (w_rows(j) / 64) * (w_k(j) / 64);
    for (int ti = blockIdx.x; ti < total; ti += gridDim.x) {
        int job = 0, rem = ti;
#pragma unroll
        for (int j = 0; j < N_W; ++j) { const int n = (w_rows(j) / 64) * (w_k(j) / 64); if (job == j && rem >= n) { rem -= n; job = j + 1; } }
        int K = 0;
#pragma unroll
        for (int j = 0; j < N_W; ++j) if (job == j) K = w_k(j);
        const int kt = K / 64, nt0 = rem / kt, kt0 = rem % kt;
        const int n0 = nt0 * 64, k0 = kt0 * 64;
        {
            const int nc = (tid & 15) * 4; int stride;
            const float* s = wsrc(p, job, n0 + nc, stride);
#pragma unroll
            for (int ps = 0; ps < 2; ++ps) {
                const int kr = (tid >> 4) + ps * 32;
                float4 v = make_float4(0.f, 0.f, 0.f, 0.f);
                if (s) v = *(const float4*)(s + (size_t)(k0 + kr) * stride);
                tile[kr * 65 + nc + 0] = v.x; tile[kr * 65 + nc + 1] = v.y; tile[kr * 65 + nc + 2] = v.z; tile[kr * 65 + nc + 3] = v.w;
            }
        }
        __syncthreads();
        {
            const int n = tid >> 3, kc = (tid & 7) * 8;
            uint4 o;
            o.x = pack2(tile[(kc + 0) * 65 + n], tile[(kc + 1) * 65 + n]);
            o.y = pack2(tile[(kc + 2) * 65 + n], tile[(kc + 3) * 65 + n]);
            o.z = pack2(tile[(kc + 4) * 65 + n], tile[(kc + 5) * 65 + n]);
            o.w = pack2(tile[(kc + 6) * 65 + n], tile[(kc + 7) * 65 + n]);
            *(uint4*)(p.W[job] + (size_t)(n0 + n) * K + k0 + kc) = o;
        }
        __syncthreads();
    }
}

__device__ __forceinline__ int swz(int row, int chunk) { return row * 64 + ((chunk ^ (row & 7)) << 3); }

template <class AL, class EP>
__device__ __forceinline__ void gemm_tile(char* smem, AL& al, const bf16_t* __restrict__ Bt, int ldb, int K, EP& ep) {
    bf16_t* As = (bf16_t*)smem;
    bf16_t* Bs = As + 2 * 128 * 64;
    const int tid = opaque_tid(), lane = tid & 63, wave = tid >> 6, wm = wave >> 2, wn = wave & 3, l15 = lane & 15, quad = lane >> 4;
    f32x4 acc[4][4];
#pragma unroll
    for (int i = 0; i < 4; ++i)
#pragma unroll
        for (int j = 0; j < 4; ++j) acc[i][j] = (f32x4){0.f, 0.f, 0.f, 0.f};
    uint4 ra[2], rb[4];
    const int lrow = tid >> 3, lch = tid & 7;
    const int nk = K >> 6;
#pragma unroll
    for (int it = 0; it < 2; ++it) ra[it] = al.load(it, lrow + it * 64, lch * 8);
#pragma unroll
    for (int it = 0; it < 4; ++it) rb[it] = *(const uint4*)(Bt + (size_t)(lrow + it * 64) * ldb + lch * 8);
#pragma unroll
    for (int it = 0; it < 2; ++it) *(uint4*)(As + swz(lrow + it * 64, lch)) = ra[it];
#pragma unroll
    for (int it = 0; it < 4; ++it) *(uint4*)(Bs + swz(lrow + it * 64, lch)) = rb[it];
    __syncthreads();
    for (int kt = 0; kt < nk; ++kt) {
        const int cur = kt & 1;
        const bool more = kt + 1 < nk;
        if (more) {
            const int k0 = (kt + 1) << 6;
#pragma unroll
            for (int it = 0; it < 2; ++it) ra[it] = al.load(it, lrow + it * 64, k0 + lch * 8);
#pragma unroll
            for (int it = 0; it < 4; ++it) rb[it] = *(const uint4*)(Bt + (size_t)(lrow + it * 64) * ldb + k0 + lch * 8);
        }
        const bf16_t* Ac = As + cur * 128 * 64;
        const bf16_t* Bc = Bs + cur * 256 * 64;
#pragma unroll
        for (int kk = 0; kk < 2; ++kk) {
            bf16x8 af[4], bfr[4];
#pragma unroll
            for (int i = 0; i < 4; ++i) af[i] = *(const bf16x8*)(Ac + swz(wm * 64 + i * 16 + l15, kk * 4 + quad));
#pragma unroll
            for (int j = 0; j < 4; ++j) bfr[j] = *(const bf16x8*)(Bc + swz(wn * 64 + j * 16 + l15, kk * 4 + quad));
#pragma unroll
            for (int i = 0; i < 4; ++i)
#pragma unroll
                for (int j = 0; j < 4; ++j) acc[i][j] = mfma16(bfr[j], af[i], acc[i][j]);
        }
        if (more) {
            bf16_t* An = As + (cur ^ 1) * 128 * 64;
            bf16_t* Bn = Bs + (cur ^ 1) * 256 * 64;
#pragma unroll
            for (int it = 0; it < 2; ++it) *(uint4*)(An + swz(lrow + it * 64, lch)) = ra[it];
#pragma unroll
            for (int it = 0; it < 4; ++it) *(uint4*)(Bn + swz(lrow + it * 64, lch)) = rb[it];
        }
        __syncthreads();
    }
    ep(acc, wm * 64 + l15, wn * 64 + quad * 4);
}

struct ALPlain {
    const bf16_t* A; int lda;
    __device__ __forceinline__ uint4 load(int, int row, int k) const { return *(const uint4*)(A + (size_t)row * lda + k); }
};
struct ALRet {
    const bf16_t* y; const bf16_t* g; const float* ssp;
    float sc[2];
    __device__ __forceinline__ uint4 load(int it, int row, int k) {
        if ((k & 511) < 64) {
            const float* s = ssp + (size_t)row * 64 + (k >> 9) * 16;
            const float4 a = *(const float4*)s, b = *(const float4*)(s + 4), c = *(const float4*)(s + 8), d = *(const float4*)(s + 12);
            const float tot = a.x + a.y + a.z + a.w + b.x + b.y + b.z + b.w + c.x + c.y + c.z + c.w + d.x + d.y + d.z + d.w;
            sc[it] = rsqrtf(tot * (1.0f / 512.0f) + EPS);
        }
        const float f = sc[it];
        const uint4 a = *(const uint4*)(y + (size_t)row * E + k);
        const uint4 gg = *(const uint4*)(g + (size_t)row * E + k);
        uint4 o;
        o.x = pack2(bflo(a.x) * f * bflo(gg.x), bfhi(a.x) * f * bfhi(gg.x));
        o.y = pack2(bflo(a.y) * f * bflo(gg.y), bfhi(a.y) * f * bfhi(gg.y));
        o.z = pack2(bflo(a.z) * f * bflo(gg.z), bfhi(a.z) * f * bfhi(gg.z));
        o.w = pack2(bflo(a.w) * f * bflo(gg.w), bfhi(a.w) * f * bfhi(gg.w));
        return o;
    }
};

struct OpZ {
    float* Z;
    __device__ __forceinline__ int row_ctx(int) const { return 0; }
    __device__ __forceinline__ void operator()(int row, int col, f32x4 v, int) const { *(f32x4*)(Z + (size_t)row * D + col) = v; }
    __device__ __forceinline__ void call8(int row, int col, f32x4 a, f32x4 b, int c) const { (*this)(row, col, a, c); (*this)(row, col + 4, b, c); }
};
struct OpInProj {
    bf16_t* U; bf16_t* SG; float* out; bool lru;
    __device__ __forceinline__ float* row_ctx(int row) const {
        if (!lru || row >= R) return nullptr;
        const bool prompt = row < RP;
        const int b = prompt ? row / SEQT : (row - RP) / DSEQ;
        const int t = prompt ? row % SEQT : (row - RP) % DSEQ;
        const int tl = t - (prompt ? SEQT - 3 : DSEQ - 3);
        return tl >= 0 ? out + (prompt ? O_P_LRU_CONV : O_S_LRU_CONV) + ((size_t)b * 3 + tl) * E : nullptr;
    }
    __device__ __forceinline__ void call8(int row, int col, f32x4 a, f32x4 b, float* crow) const {
        if (col >= E) {
#pragma unroll
            for (int e = 0; e < 4; ++e) { a[e] = siluf_(a[e]); b[e] = siluf_(b[e]); }
            const uint2 lo = pack4(a), hi = pack4(b);
            *(uint4*)(SG + (size_t)row * E + col - E) = make_uint4(lo.x, lo.y, hi.x, hi.y);
        } else {
            const uint2 lo = pack4(a), hi = pack4(b);
            *(uint4*)(U + (size_t)row * E + col) = make_uint4(lo.x, lo.y, hi.x, hi.y);
            if (crow) { *(f32x4*)(crow + col) = a; *(f32x4*)(crow + col + 4) = b; }
        }
    }
    __device__ __forceinline__ void operator()(int row, int col, f32x4 v, float* crow) const {
        if (col >= E) {
            v[0] = siluf_(v[0]); v[1] = siluf_(v[1]); v[2] = siluf_(v[2]); v[3] = siluf_(v[3]);
            *(uint2*)(SG + (size_t)row * E + col - E) = pack4(v);
        } else {
            *(uint2*)(U + (size_t)row * E + col) = pack4(v);
            if (crow) *(f32x4*)(crow + col) = v;
        }
    }
};
struct OpGlu {
    const bf16_t* Y1; const bf16_t* SG; bf16_t* Y2; const float* bias;
    __device__ __forceinline__ void call8(int row, int col, f32x4 a, f32x4 b, int c) const { (*this)(row, col, a, c); (*this)(row, col + 4, b, c); }
    __device__ __forceinline__ int row_ctx(int) const { return 0; }
    __device__ __forceinline__ void operator()(int row, int col, f32x4 v, int) const {
        const float4 bb = *(const float4*)(bias + col);
        const size_t o = (size_t)row * E + col;
        const uint2 y1 = *(const uint2*)(Y1 + o), sg = *(const uint2*)(SG + o);
        v[0] = bflo(y1.x) * sigmoidf_(v[0] + bb.x) * bflo(sg.x);
        v[1] = bfhi(y1.x) * sigmoidf_(v[1] + bb.y) * bfhi(sg.x);
        v[2] = bflo(y1.y) * sigmoidf_(v[2] + bb.z) * bflo(sg.y);
        v[3] = bfhi(y1.y) * sigmoidf_(v[3] + bb.w) * bfhi(sg.y);
        *(uint2*)(Y2 + o) = pack4(v);
    }
};
struct OpRwkvIn {
    bf16_t* d0; bf16_t* d1; bf16_t* d2; bf16_t* d3; bf16_t* L1;
    __device__ __forceinline__ void call8(int row, int col, f32x4 a, f32x4 b, int c) const { (*this)(row, col, a, c); (*this)(row, col + 4, b, c); }
    __device__ __forceinline__ int row_ctx(int) const { return 0; }
    __device__ __forceinline__ void operator()(int row, int col, f32x4 v, int) const {
        if (col < 8192) {
            const int reg = col >> 11;
            if (reg == 3) { v[0] = siluf_(v[0]); v[1] = siluf_(v[1]); v[2] = siluf_(v[2]); v[3] = siluf_(v[3]); }
            bf16_t* dst = reg == 0 ? d0 : reg == 1 ? d1 : reg == 2 ? d2 : d3;
            *(uint2*)(dst + (size_t)row * E + (col & 2047)) = pack4(v);
        } else {
            const int cc = col - 8192, part = cc >> 8, c = cc & 255;
            if (c < 64) {
                if (part == 0) { v[0] = tanhf_(v[0]); v[1] = tanhf_(v[1]); v[2] = tanhf_(v[2]); v[3] = tanhf_(v[3]); }
                *(uint2*)(L1 + (size_t)row * 128 + part * 64 + c) = pack4(v);
            }
        }
    }
};
struct OpLora2 {
    bf16_t* DL; bf16_t* AA; const float* w0; const float* a0;
    __device__ __forceinline__ void call8(int row, int col, f32x4 a, f32x4 b, int c) const { (*this)(row, col, a, c); (*this)(row, col + 4, b, c); }
    __device__ __forceinline__ int row_ctx(int) const { return 0; }
    __device__ __forceinline__ void operator()(int row, int col, f32x4 v, int) const {
        const bool isw = col < E; const int c = col & 2047;
        const float4 bb = *(const float4*)((isw ? w0 : a0) + c);
        v[0] += bb.x; v[1] += bb.y; v[2] += bb.z; v[3] += bb.w;
#pragma unroll
        for (int e = 0; e < 4; ++e) v[e] = isw ? __expf(-softplusf_(-v[e]) - 0.5f) : sigmoidf_(v[e]);
        *(uint2*)((isw ? DL : AA) + (size_t)row * E + c) = pack4(v);
    }
};

template <class Op> struct OldEpi {
    Op op; int m0, n0;
    __device__ __forceinline__ void operator()(f32x4 (&acc)[4][4], int r0, int c0) const {
#pragma unroll
        for (int i = 0; i < 4; ++i) {
            const auto ctx = op.row_ctx(m0 + r0 + i * 16);
#pragma unroll
            for (int j = 0; j < 4; ++j) op(m0 + r0 + i * 16, n0 + c0 + j * 16, acc[i][j], ctx);
        }
    }
};

namespace pg8 {
constexpr int BM = 256, BK = 64, HALF = 128, HTB = HALF * BK * 2, STAGE_BYTES = 8 * HTB, NXCD = 8, WGM = 8;
__device__ __forceinline__ int lds_byte(int r, int c) { const int st = (r >> 4) * 2 + (c >> 5), rr = r & 15, cc = c & 31, ob = rr * 64 + cc * 2; return st * 1024 + (ob ^ (((ob >> 9) & 1) << 5)); }
__device__ __forceinline__ void stage_rc(int b, int& Rr, int& C) { const int st = b / 1024, sb = b % 1024, swz = sb ^ (((sb >> 9) & 1) << 5); Rr = (st >> 1) * 16 + swz / 64; C = (st & 1) * 32 + (swz % 64) / 2; }
__device__ __forceinline__ int perm32(int rho) { const int n = rho >> 4, i = rho & 15; return 8 * (i >> 2) + 4 * n + (i & 3); }
struct Unit { int pm, pn; };
struct Gemm { const bf16_t* A; const bf16_t* Bt; int M, N, K; size_t a_sel_bytes; };
__device__ __forceinline__ size_t a_sel(const Gemm& g, int pn) { const int sgrp = pn >> 3; return g.a_sel_bytes * (size_t)((sgrp < 4 ? sgrp : 4) + (pn == 33 ? 1 : 0)); }
struct StaticOrder {
    int nM, nN, nwg, G, c;
    __device__ void init(int M, int N, int G_, int c_) { nM = M / BM; nN = N / BM; nwg = nM * nN; G = G_; c = c_; }
    __device__ bool next(int i, Unit& u) const {
        const long L = (long)i * G + c; if (L >= nwg) return false;
        int wgid = (int)L; { const int q = nwg / NXCD, r = nwg % NXCD, xcd = wgid % NXCD, off = wgid / NXCD; wgid = (xcd < r ? xcd * (q + 1) : r * (q + 1) + (xcd - r) * q) + off; }
        const int nig = WGM * nN, gid = wgid / nig, fm = gid * WGM, gsz = (nM - fm) < WGM ? (nM - fm) : WGM;
        u.pm = fm + ((wgid % nig) % gsz); u.pn = (wgid % nig) / gsz; return true;
    }
};
template <class Epi>
__device__ __forceinline__ void gemm_phase(LAS unsigned char* lds, const Gemm g, const StaticOrder& S, const Epi& Ep) {
    const int tid = opaque_tid(), wid = __builtin_amdgcn_readfirstlane(tid >> 6), lane = tid & 63, wr = wid >> 2, wc = wid & 3, fr = lane & 15, fq = lane >> 4;
    const int K = g.K, nt = K / BK;
    unsigned voffA[2], voffB[2];
#pragma unroll
    for (int i = 0; i < 2; ++i) { int Rr, C; stage_rc(tid * 16 + i * 8192, Rr, C); const int Rb = Epi::PERM ? ((Rr & ~31) + perm32(Rr & 31)) : Rr;
        voffA[i] = (unsigned)(Rr * K + C) * 2u; voffB[i] = (unsigned)(Rb * K + C) * 2u; }
    const size_t kstep = (size_t)(BK * 2);
    const size_t hstep = (size_t)HALF * K * 2;
    const size_t tstep = 2 * hstep;
    const unsigned ldsw = (unsigned)wid * 1024u;
    const int aoff = lds_byte(wr * 64 + fr, fq * 8), boff = lds_byte(wc * 32 + fr, fq * 8);
#define PG8_SA(b, h) (((b) * 2 + (h)) * HTB)
#define PG8_SB(b, h) ((4 + (b) * 2 + (h)) * HTB)
#define PG8_STAGE(bufoff, gbase, voff) do { _Pragma("unroll") for (int _i = 0; _i < 2; ++_i) \
        __builtin_amdgcn_global_load_lds((const unsigned*)((const char*)(gbase) + (voff)[_i]), (LAS unsigned*)(lds + (bufoff) + ldsw + _i * 8192), 16, 0, 0); } while (0)
#define PG8_LDA(dst, b, h) do { _Pragma("unroll") for (int m = 0; m < 4; ++m) _Pragma("unroll") for (int k = 0; k < 2; ++k) dst[m][k] = *(const LAS bf16x8*)(lds + PG8_SA(b, h) + aoff + m * 2048 + k * 1024); } while (0)
#define PG8_LDB(dst, b, h) do { _Pragma("unroll") for (int n = 0; n < 2; ++n) _Pragma("unroll") for (int k = 0; k < 2; ++k) dst[n][k] = *(const LAS bf16x8*)(lds + PG8_SB(b, h) + boff + n * 2048 + k * 1024); } while (0)
#define PG8_MMA(ai, bj, At, Bt) do { __builtin_amdgcn_s_setprio(1); _Pragma("unroll") for (int m = 0; m < 4; ++m) _Pragma("unroll") for (int n = 0; n < 2; ++n) _Pragma("unroll") for (int k = 0; k < 2; ++k) \
        acc[ai][bj][m][n] = __builtin_amdgcn_mfma_f32_16x16x32_bf16(Bt[n][k], At[m][k], acc[ai][bj][m][n], 0, 0, 0); __builtin_amdgcn_s_setprio(0); } while (0)
#define PG8_WAIT_V(n) asm volatile("s_waitcnt vmcnt(" #n ")" ::: "memory")
#define PG8_WAIT_L(n) asm volatile("s_waitcnt lgkmcnt(" #n ")" ::: "memory")
#define PG8_BAR __builtin_amdgcn_s_barrier()
#define PG8_SCHED __builtin_amdgcn_sched_barrier(0)
    Unit cur, nxt; int ui = 0;
    if (!S.next(0, cur)) return;
    f32x4 acc[2][2][4][2];
#pragma unroll
    for (int a = 0; a < 2; ++a)
#pragma unroll
        for (int b = 0; b < 2; ++b)
#pragma unroll
            for (int m = 0; m < 4; ++m)
#pragma unroll
                for (int n = 0; n < 2; ++n) acc[a][b][m][n] = (f32x4){0.f, 0.f, 0.f, 0.f};
    bf16x8 At[4][2], B0[2][2], B1[2][2];
    const char* cA = (const char*)g.A + a_sel(g, cur.pn) + (size_t)cur.pm * tstep; const char* cB = (const char*)g.Bt + (size_t)cur.pn * tstep;
    PG8_STAGE(PG8_SB(0, 0), cB, voffB); PG8_STAGE(PG8_SA(0, 0), cA, voffA); PG8_STAGE(PG8_SB(0, 1), cB + hstep, voffB); PG8_STAGE(PG8_SA(0, 1), cA + hstep, voffA);
    if (wr == 1) PG8_BAR;
    PG8_WAIT_V(4); PG8_BAR;
    PG8_STAGE(PG8_SB(1, 0), cB + kstep, voffB); PG8_STAGE(PG8_SA(1, 0), cA + kstep, voffA); PG8_STAGE(PG8_SB(1, 1), cB + hstep + kstep, voffB);
    PG8_WAIT_V(6); PG8_BAR;
    for (;;) {
        const bool has_next = S.next(ui + 1, nxt);
        const char* nA = has_next ? (const char*)g.A + a_sel(g, nxt.pn) + (size_t)nxt.pm * tstep : cA; const char* nB = has_next ? (const char*)g.Bt + (size_t)nxt.pn * tstep : cB;
        for (int t = 0; t < nt; t += 2) {
            const bool last = (t == nt - 2);
            const char* a1 = cA + (size_t)(t + 1) * kstep;
            const char* a2 = last ? nA : cA + (size_t)(t + 2) * kstep; const char* b2 = last ? nB : cB + (size_t)(t + 2) * kstep;
            const char* a3 = a2 + kstep; const char* b3 = b2 + kstep;
            PG8_LDB(B0, 0, 0); PG8_SCHED; PG8_LDA(At, 0, 0); PG8_STAGE(PG8_SA(1, 1), a1 + hstep, voffA);
            PG8_WAIT_L(8); PG8_BAR; PG8_WAIT_L(0); PG8_MMA(0, 0, At, B0); PG8_BAR; PG8_SCHED;
            PG8_LDB(B1, 0, 1); PG8_STAGE(PG8_SB(0, 0), b2, voffB);
            PG8_BAR; PG8_WAIT_L(0); PG8_MMA(0, 1, At, B1); PG8_BAR;
            PG8_LDA(At, 0, 1); PG8_STAGE(PG8_SA(0, 0), a2, voffA);
            PG8_BAR; PG8_WAIT_L(0); PG8_MMA(1, 0, At, B0); PG8_BAR; PG8_SCHED;
            PG8_STAGE(PG8_SB(0, 1), b2 + hstep, voffB);
            PG8_WAIT_V(6); PG8_BAR; PG8_MMA(1, 1, At, B1); PG8_BAR;
            PG8_LDB(B0, 1, 0); PG8_SCHED; PG8_LDA(At, 1, 0); PG8_STAGE(PG8_SA(0, 1), a2 + hstep, voffA);
            PG8_WAIT_L(8); PG8_BAR; PG8_WAIT_L(0); PG8_MMA(0, 0, At, B0); PG8_BAR; PG8_SCHED;
            PG8_LDB(B1, 1, 1); PG8_STAGE(PG8_SB(1, 0), b3, voffB);
            PG8_BAR; PG8_WAIT_L(0); PG8_MMA(0, 1, At, B1); PG8_BAR;
            PG8_LDA(At, 1, 1); PG8_STAGE(PG8_SA(1, 0), a3, voffA);
            PG8_BAR; PG8_WAIT_L(0); PG8_MMA(1, 0, At, B0); PG8_BAR; PG8_SCHED;
            PG8_STAGE(PG8_SB(1, 1), b3 + hstep, voffB);
            PG8_WAIT_V(6); PG8_BAR; PG8_MMA(1, 1, At, B1); PG8_BAR;
        }
        Ep(acc, cur, wr, wc, fr, fq);
        if (!has_next) break;
#pragma unroll
        for (int a = 0; a < 2; ++a)
#pragma unroll
            for (int b = 0; b < 2; ++b)
#pragma unroll
                for (int m = 0; m < 4; ++m)
#pragma unroll
                    for (int n = 0; n < 2; ++n) acc[a][b][m][n] = (f32x4){0.f, 0.f, 0.f, 0.f};
        cur = nxt; cA = nA; cB = nB; ++ui;
    }
    PG8_WAIT_V(0);
    if (wr == 0) PG8_BAR;
    PG8_BAR;
#undef PG8_SA
#undef PG8_SB
#undef PG8_STAGE
#undef PG8_LDA
#undef PG8_LDB
#undef PG8_MMA
#undef PG8_WAIT_V
#undef PG8_WAIT_L
#undef PG8_BAR
#undef PG8_SCHED
}
}

template <class Op, bool PERM_> struct Pg8Epi {
    static constexpr bool PERM = PERM_;
    Op op;
    __device__ __forceinline__ void operator()(const f32x4 (&acc)[2][2][4][2], const pg8::Unit& u, int wr, int wc, int fr, int fq) const {
#pragma unroll
        for (int ai = 0; ai < 2; ++ai)
#pragma unroll
            for (int m = 0; m < 4; ++m) {
                const int row = u.pm * 256 + ai * 128 + wr * 64 + m * 16 + fr;
                const auto ctx = op.row_ctx(row);
#pragma unroll
                for (int bj = 0; bj < 2; ++bj) {
                    if (PERM) op.call8(row, u.pn * 256 + bj * 128 + wc * 32 + fq * 8, acc[ai][bj][m][0], acc[ai][bj][m][1], ctx);
                    else {
#pragma unroll
                        for (int n = 0; n < 2; ++n) op(row, u.pn * 256 + bj * 128 + wc * 32 + n * 16 + fq * 4, acc[ai][bj][m][n], ctx);
                    }
                }
            }
    }
};
struct Pg8EpiRetIn {
    static constexpr bool PERM = true;
    bf16_t* Q; bf16_t* Kk; bf16_t* V; bf16_t* G;
    __device__ __forceinline__ void operator()(const f32x4 (&acc)[2][2][4][2], const pg8::Unit& u, int wr, int wc, int fr, int fq) const {
        const int nt = u.pn;
        float invf[2][4];
#pragma unroll
        for (int n = 0; n < 2; ++n)
#pragma unroll
            for (int e = 0; e < 4; ++e) invf[n][e] = __builtin_amdgcn_exp2f(-(float)(wc * 32 + fq * 8 + n * 4 + e) * (13.287712379549449f / 128.0f)) * 0.15915494309189535f;
#pragma unroll
        for (int ai = 0; ai < 2; ++ai)
#pragma unroll
            for (int m = 0; m < 4; ++m) {
                const int row = u.pm * 256 + ai * 128 + wr * 64 + m * 16 + fr;
                if (nt >= 8) {
#pragma unroll
                    for (int bj = 0; bj < 2; ++bj)
#pragma unroll
                        for (int n = 0; n < 2; ++n) {
                            f32x4 v = acc[ai][bj][m][n];
                            if (nt >= 16) { v[0] = siluf_(v[0]); v[1] = siluf_(v[1]); v[2] = siluf_(v[2]); v[3] = siluf_(v[3]); }
                            *(uint2*)((nt >= 16 ? G : V) + (size_t)row * E + (nt & 7) * 256 + bj * 128 + wc * 32 + fq * 8 + n * 4) = pack4(v);
                        }
                } else {
                    const int h = nt & 3;
                    const float scl = nt >= 4 ? 0.0625f : 1.0f;
                    bf16_t* dst = nt >= 4 ? Kk : Q;
                    const float pos = (float)(row < RP ? row % SEQT : 16384 + (row - RP) % DSEQ);
#pragma unroll
                    for (int n = 0; n < 2; ++n) {
                        const int d1 = wc * 32 + fq * 8 + n * 4;
                        f32x4 o1, o2;
#pragma unroll
                        for (int e = 0; e < 4; ++e) {
                            const float rev = __builtin_amdgcn_fractf(pos * invf[n][e]);
                            const float sn = __builtin_amdgcn_sinf(rev), cs = __builtin_amdgcn_cosf(rev);
                            const float x1 = acc[ai][0][m][n][e], x2 = acc[ai][1][m][n][e];
                            o1[e] = (x1 * cs - x2 * sn) * scl; o2[e] = (x2 * cs + x1 * sn) * scl;
                        }
                        *(uint2*)(dst + (size_t)row * D + h * 256 + d1) = pack4(o1);
                        *(uint2*)(dst + (size_t)row * D + h * 256 + 128 + d1) = pack4(o2);
                    }
                }
            }
    }
};

template <class Epi>
__device__ __forceinline__ void run_pg8(char* smem, const bf16_t* A, const bf16_t* Bt, int N, int K, const Epi& ep, size_t a_sel_bytes = 0) {
    const int slot = (int)((volatile LAS unsigned*)(smem + LDS_BYTES - 16))[2];
    pg8::StaticOrder so; so.init(RPAD, N, gridDim.x, slot);
    pg8::Gemm g{A, Bt, RPAD, N, K, a_sel_bytes};
    pg8::gemm_phase((LAS unsigned char*)smem, g, so, ep);
}
__device__ __forceinline__ void phase_gemm_inproj(const Params& p, char* smem, int wj, bool lru) {
    Pg8Epi<OpInProj, true> ep{{p.ACT[0], p.ACT[1], p.out, lru}};
    run_pg8(smem, p.XN, p.W[wj], 4096, D, ep);
}
__device__ __forceinline__ void phase_gemm_out(const Params& p, char* smem, int wj, const bf16_t* Y) {
    Pg8Epi<OpZ, false> ep{{p.Z}};
    run_pg8(smem, Y, p.W[wj], D, E, ep);
}
__device__ __forceinline__ void phase_gemm_glu(const Params& p, char* smem) {
    Pg8Epi<OpGlu, true> ep{{p.ACT[2], p.ACT[1], p.ACT[3], p.in[I_S5_GLUB]}};
    run_pg8(smem, p.ACT[2], p.W[W_S5_GLU], E, E, ep);
}
__device__ __forceinline__ void phase_gemm_rwkv_in(const Params& p, char* smem) {
    Pg8Epi<OpRwkvIn, true> ep{{p.ACT[0], p.ACT[1], p.ACT[2], p.ACT[3], p.L1}};
    run_pg8(smem, p.XM, p.W[W_RW_IN], 8704, D, ep, (size_t)RPAD * D * 2);
}
__device__ __forceinline__ void phase_gemm_lora2(const Params& p, char* smem) {
    for (int tile = blockIdx.x; tile < MT * 16; tile += gridDim.x) {
        const int nt = tile / MT, mt = tile % MT;
        ALPlain al{p.L1 + (size_t)mt * 128 * 128 + (nt < 8 ? 0 : 64), 128};
        OldEpi<OpLora2> ep{{p.ACT[4], p.ACT[5], p.in[I_RW_W0], p.in[I_RW_A0]}, mt * 128, nt * 256};
        gemm_tile(smem, al, p.W[W_RW_L2] + (size_t)nt * 256 * 64, 64, 64, ep);
    }
}
__device__ __forceinline__ void phase_gemm_ret_in(const Params& p, char* smem) {
    Pg8EpiRetIn ep{p.ACT[0], p.ACT[1], p.ACT[2], p.ACT[3]};
    run_pg8(smem, p.XN, p.W[W_RT_IN], 6144, D, ep);
}
__device__ __forceinline__ void phase_gemm_ret_out(const Params& p, char* smem) {
    for (int tile = blockIdx.x; tile < MT * 4; tile += gridDim.x) {
        const int nt = tile / MT, mt = tile % MT;
        ALRet al{p.ACT[4] + (size_t)mt * 128 * E, p.ACT[3] + (size_t)mt * 128 * E, p.SSP + (size_t)mt * 128 * 64, {0.f, 0.f}};
        OldEpi<OpZ> ep{{p.Z}, mt * 128, nt * 256};
        gemm_tile(smem, al, p.W[W_RT_OUT] + (size_t)nt * 256 * E, E, E, ep);
    }
}

__device__ __forceinline__ void lru_uload(uint4 (&ubuf)[7], const bf16_t* U, int bg, int c, int rg, int h, int cgp) {
    const int nrows = c < 16 ? 128 : 16;
    const int lr = rg * 4;
#pragma unroll
    for (int jj = 0; jj < 7; ++jj) {
        const int tt = c * 128 + lr - 3 + jj;
        ubuf[jj] = make_uint4(0u, 0u, 0u, 0u);
        if (lr < nrows && tt >= 0) ubuf[jj] = *(const uint4*)(U + (size_t)(bg * SEQT + tt) * E + h * 128 + cgp * 8);
    }
}
__device__ __forceinline__ void phase_lru(const Params& p, char* smem) {
    bf16_t* Al = (bf16_t*)smem;
    bf16_t* Bl = Al + 128 * 136;
    float* SA = (float*)(smem + 2 * 128 * 136 * 2);
    float* SB = SA + 128 * 64;
    float* SEG = SB + 128 * 64;
    float* CAR = SEG + 2 * 8 * 64;
    float* CWL = CAR + 128;
    float* EPL = CWL + 640;
    const int tid = opaque_tid(), lane = tid & 63, wave = tid >> 6, l15 = lane & 15, quad = lane >> 4;
    const int wm = wave >> 1, wn = wave & 1;
    const bf16_t* U = p.ACT[0]; const bf16_t* SG = p.ACT[1]; bf16_t* Y = p.ACT[2];
    for (int item = blockIdx.x; item < 512; item += gridDim.x) {
        const bool sample = item >= 256;
        const int it = item & 255, bg = it >> 5, h = (it >> 1) & 15, q = it & 1;
        const int chbase = h * 128 + q * 64;
#pragma unroll
        for (int i = 0; i < 4; ++i) {
            const int idx = tid + i * 512, row = idx >> 4, ch = idx & 15;
            *(uint4*)(Bl + row * 136 + ch * 8) = *(const uint4*)(p.W[W_LRU_G] + (size_t)(h * 256 + q * 128 + row) * 128 + ch * 8);
        }
        if (tid < 128) {
            CAR[tid] = 0.f;
            const int kch = h * 128 + tid;
#pragma unroll
            for (int j = 0; j < 4; ++j) CWL[j * 128 + tid] = p.in[I_LRU_CW][j * E + kch];
            CWL[4 * 128 + tid] = p.in[I_LRU_CB][kch];
        } else if (tid < 192) {
            const int cl = tid - 128, ch = chbase + cl;
            EPL[cl] = p.in[I_LRU_BA][ch]; EPL[64 + cl] = p.in[I_LRU_BX][ch]; EPL[128 + cl] = softplusf_(-p.in[I_LRU_LAM][ch]);
        }
        const int cgp = tid & 15, rg = tid >> 4;
        const int ntiles = sample ? 1 : 17;
        float hc = 0.f;
        uint4 ubuf[7];
        if (!sample) lru_uload(ubuf, U, bg, 0, rg, h, cgp);
        __syncthreads();
        for (int c = 0; c < ntiles; ++c) {
            const int nrows = sample ? 128 : (c < 16 ? 128 : 16);
#pragma unroll
            for (int ps = 0; ps < 2; ++ps) {
                const int lr = rg * 4 + ps * 2;
                if (lr < nrows) {
                    float uu[5][8];
#pragma unroll
                    for (int jj = 0; jj < 5; ++jj) {
                        uint4 raw = make_uint4(0u, 0u, 0u, 0u); bool have = true; float4 f0 = make_float4(0.f, 0.f, 0.f, 0.f), f1 = f0;
                        if (!sample) {
                            raw = ubuf[ps * 2 + jj];
                        } else {
                            const int sq = lr >> 3, ts = lr & 7, sb = bg * 16 + sq, ee = ts - 3 + jj;
                            if (ee >= 0) { raw = *(const uint4*)(U + (size_t)(RP + sb * 8 + ee) * E + h * 128 + cgp * 8); }
                            else { have = false; const float* s = p.in[I_ST_LRU_CONV] + ((size_t)sb * 3 + (3 + ee)) * E + h * 128 + cgp * 8; f0 = *(const float4*)s; f1 = *(const float4*)(s + 4); }
                        }
                        if (have) { f0.x = bflo(raw.x); f0.y = bfhi(raw.x); f0.z = bflo(raw.y); f0.w = bfhi(raw.y); f1.x = bflo(raw.z); f1.y = bfhi(raw.z); f1.z = bflo(raw.w); f1.w = bfhi(raw.w); }
                        uu[jj][0] = f0.x; uu[jj][1] = f0.y; uu[jj][2] = f0.z; uu[jj][3] = f0.w; uu[jj][4] = f1.x; uu[jj][5] = f1.y; uu[jj][6] = f1.z; uu[jj][7] = f1.w;
                    }
#pragma unroll
                    for (int rr = 0; rr < 2; ++rr) {
                        float xc[8];
#pragma unroll
                        for (int k = 0; k < 8; ++k) {
                            const int kc = cgp * 8 + k;
                            xc[k] = CWL[512 + kc] + CWL[kc] * uu[rr][k] + CWL[128 + kc] * uu[rr + 1][k] + CWL[256 + kc] * uu[rr + 2][k] + CWL[384 + kc] * uu[rr + 3][k];
                        }
                        uint4 o; o.x = pack2(xc[0], xc[1]); o.y = pack2(xc[2], xc[3]); o.z = pack2(xc[4], xc[5]); o.w = pack2(xc[6], xc[7]);
                        *(uint4*)(Al + (lr + rr) * 136 + cgp * 8) = o;
                    }
                } else {
#pragma unroll
                    for (int rr = 0; rr < 2; ++rr) *(uint4*)(Al + (lr + rr) * 136 + cgp * 8) = make_uint4(0u, 0u, 0u, 0u);
                }
            }
            __syncthreads();
            if (!sample && c + 1 < ntiles) lru_uload(ubuf, U, bg, c + 1, rg, h, cgp);
            f32x4 acc[2][4];
#pragma unroll
            for (int i = 0; i < 2; ++i)
#pragma unroll
                for (int j = 0; j < 4; ++j) acc[i][j] = (f32x4){0.f, 0.f, 0.f, 0.f};
#pragma unroll
            for (int kk = 0; kk < 4; ++kk) {
                bf16x8 af[2], bfr[4];
#pragma unroll
                for (int i = 0; i < 2; ++i) af[i] = *(const bf16x8*)(Al + (wm * 32 + i * 16 + l15) * 136 + kk * 32 + quad * 8);
#pragma unroll
                for (int j = 0; j < 4; ++j) bfr[j] = *(const bf16x8*)(Bl + (wn * 64 + j * 16 + l15) * 136 + kk * 32 + quad * 8);
#pragma unroll
                for (int i = 0; i < 2; ++i)
#pragma unroll
                    for (int j = 0; j < 4; ++j) acc[i][j] = mfma16(bfr[j], af[i], acc[i][j]);
            }
#pragma unroll
            for (int i = 0; i < 2; ++i) {
                const int row = wm * 32 + i * 16 + l15;
#pragma unroll
                for (int j = 0; j < 2; ++j) {
                    const int chl = wn * 32 + j * 16 + quad * 4;
                    const uint2 xr = *(const uint2*)(Al + row * 136 + q * 64 + chl);
                    const float xcv[4] = {bflo(xr.x), bfhi(xr.x), bflo(xr.y), bfhi(xr.y)};
                    f32x4 av, bv;
#pragma unroll
                    for (int e = 0; e < 4; ++e) {
                        const float gr = sigmoidf_(acc[i][j][e] + EPL[chl + e]), gi = sigmoidf_(acc[i][j + 2][e] + EPL[64 + chl + e]);
                        const float la = -8.0f * gr * EPL[128 + chl + e];
                        av[e] = __expf(la);
                        bv[e] = __builtin_amdgcn_sqrtf(fmaxf(1.0f - av[e] * av[e], 0.f)) * gi * xcv[e];
                    }
                    *(f32x4*)(SA + row * 64 + chl) = av;
                    *(f32x4*)(SB + row * 64 + chl) = bv;
                }
            }
            __syncthreads();
            const int ch = tid & 63, seg = tid >> 6;
            if (!sample) {
                float P = 1.f, H = 0.f;
#pragma unroll 4
                for (int rr = 0; rr < 16; ++rr) {
                    const int row = seg * 16 + rr;
                    if (row < nrows) { const float a = SA[row * 64 + ch], bx = SB[row * 64 + ch]; H = a * H + bx; P *= a; }
                }
                SEG[seg * 64 + ch] = P; SEG[512 + seg * 64 + ch] = H;
                __syncthreads();
                hc = CAR[(c & 1) * 64 + ch];
                for (int s2 = 0; s2 < seg; ++s2) hc = SEG[s2 * 64 + ch] * hc + SEG[512 + s2 * 64 + ch];
#pragma unroll
                for (int rr = 0; rr < 16; ++rr) {
                    const int row = seg * 16 + rr;
                    if (row < nrows) {
                        const float a = SA[row * 64 + ch], bx = SB[row * 64 + ch];
                        hc = a * hc + bx;
                        const size_t o = (size_t)(bg * SEQT + c * 128 + row) * E + chbase + ch;
                        Y[o] = f2bf(hc * bf2f(SG[o]));
                    }
                }
                if (seg == 7) CAR[((c + 1) & 1) * 64 + ch] = hc;
            } else {
#pragma unroll 1
                for (int sq = 0; sq < 2; ++sq) {
                    const int sb = bg * 16 + seg * 2 + sq;
                    float hh = p.in[I_ST_LRU_H][(size_t)sb * E + chbase + ch];
#pragma unroll 4
                    for (int t = 0; t < 8; ++t) {
                        const int row = seg * 16 + sq * 8 + t;
                        hh = SA[row * 64 + ch] * hh + SB[row * 64 + ch];
                        const size_t o = (size_t)(RP + sb * 8 + t) * E + chbase + ch;
                        Y[o] = f2bf(hh * bf2f(SG[o]));
                    }
                    p.out[O_S_LRU_H + (size_t)sb * E + chbase + ch] = hh;
                }
            }
        }
        if (!sample && (tid >> 6) == 7) p.out[O_P_LRU_H + (size_t)bg * E + chbase + (tid & 63)] = hc;
        __syncthreads();
    }
}

__device__ __forceinline__ void phase_s5(const Params& p, char* smem) {
    const int lane = opaque_tid() & 63, wave = opaque_tid() >> 6, l15 = lane & 15, quad = lane >> 4;
    float* BU = (float*)(smem + wave * 13312);
    bf16_t* XL = (bf16_t*)(smem + wave * 13312 + 8448);
    float* FL = (float*)(smem + wave * 13312 + 8448 + 4352);
    const bf16_t* U = p.ACT[0]; bf16_t* Y1 = p.ACT[2];
    const int slot4 = (wave & 3) * gridDim.x + blockIdx.x, nslots4 = 4 * gridDim.x;
    const int item_lo = wave < 4 ? 0 : 1024, item_hi = wave < 4 ? 1024 : 1024 + 16384;
    for (int item = item_lo + slot4; item < item_hi; item += nslots4) {
        const bool sample = item >= 1024;
        const int it = sample ? item - 1024 : item, b = it >> 7, g = it & 127;
        const int row0 = sample ? RP + b * 8 : b * SEQT, nsteps = sample ? 8 : SEQT;
        const int n = lane;
        const float dt = __expf(p.in[I_S5_LOGDT][g]);
        const float are = p.in[I_S5_ARE][g * 64 + n], aim = p.in[I_S5_AIM][g * 64 + n];
        const float mag = __expf(dt * are), ang = dt * aim;
        const float abr = mag * __cosf(ang), abi = mag * __sinf(ang);
        const float den = are * are + aim * aim;
        FL[n] = ((abr - 1.0f) * are + abi * aim) / den;
        FL[64 + n] = (abi * are - (abr - 1.0f) * aim) / den;
        wave_lds_sync();
        bf16x8 bbf[8];
#pragma unroll
        for (int grp = 0; grp < 4; ++grp) {
            bbf[grp] = (bf16x8){0, 0, 0, 0, 0, 0, 0, 0}; bbf[grp + 4] = bbf[grp];
            if (quad < 2) {
                const int np = grp * 16 + l15;
                const float fr_ = FL[np], fi_ = FL[64 + np];
                const float* br = p.in[I_S5_BRE] + ((size_t)g * 64 + np) * 16 + quad * 8;
                const float* bi = p.in[I_S5_BIM] + ((size_t)g * 64 + np) * 16 + quad * 8;
                const float4 r0 = *(const float4*)br, r1 = *(const float4*)(br + 4), i0 = *(const float4*)bi, i1 = *(const float4*)(bi + 4);
                const float rr[8] = {r0.x, r0.y, r0.z, r0.w, r1.x, r1.y, r1.z, r1.w}, ii[8] = {i0.x, i0.y, i0.z, i0.w, i1.x, i1.y, i1.z, i1.w};
#pragma unroll
                for (int k = 0; k < 8; ++k) { bbf[grp][k] = (short)f2bf(fr_ * rr[k] - fi_ * ii[k]); bbf[grp + 4][k] = (short)f2bf(fr_ * ii[k] + fi_ * rr[k]); }
            }
        }
        bf16x8 cf[4];
#pragma unroll
        for (int kb = 0; kb < 4; ++kb) {
            const float* src = (kb < 2 ? p.in[I_S5_CRE] : p.in[I_S5_CIM]) + ((size_t)g * 16 + l15) * 64 + (kb & 1) * 32 + quad * 8;
            const float sgn = kb < 2 ? 1.0f : -1.0f;
            const float4 c0 = *(const float4*)src, c1 = *(const float4*)(src + 4);
            cf[kb][0] = (short)f2bf(sgn * c0.x); cf[kb][1] = (short)f2bf(sgn * c0.y); cf[kb][2] = (short)f2bf(sgn * c0.z); cf[kb][3] = (short)f2bf(sgn * c0.w);
            cf[kb][4] = (short)f2bf(sgn * c1.x); cf[kb][5] = (short)f2bf(sgn * c1.y); cf[kb][6] = (short)f2bf(sgn * c1.z); cf[kb][7] = (short)f2bf(sgn * c1.w);
        }
        const float4 dd = *(const float4*)(p.in[I_S5_D] + g * 16 + quad * 4);
        float xr = 0.f, xi = 0.f;
        if (sample) { xr = p.in[I_ST_S5_RE][((size_t)b * 128 + g) * 64 + n]; xi = p.in[I_ST_S5_IM][((size_t)b * 128 + g) * 64 + n]; }
        uint4 ufn = make_uint4(0u, 0u, 0u, 0u); uint2 udn = make_uint2(0u, 0u);
        if (l15 < nsteps) {
            if (quad < 2) ufn = *(const uint4*)(U + (size_t)(row0 + l15) * E + g * 16 + quad * 8);
            udn = *(const uint2*)(U + (size_t)(row0 + l15) * E + g * 16 + quad * 4);
        }
        for (int tt = 0; tt < nsteps; tt += 16) {
            const int nv = min(16, nsteps - tt);
            const uint4 ufc = ufn; const uint2 udc = udn;
            ufn = make_uint4(0u, 0u, 0u, 0u); udn = make_uint2(0u, 0u);
            if (tt + 16 + l15 < nsteps) {
                if (quad < 2) ufn = *(const uint4*)(U + (size_t)(row0 + tt + 16 + l15) * E + g * 16 + quad * 8);
                udn = *(const uint2*)(U + (size_t)(row0 + tt + 16 + l15) * E + g * 16 + quad * 4);
            }
            bf16x8 uf;
            uf[0] = (short)(ufc.x & 0xffffu); uf[1] = (short)(ufc.x >> 16); uf[2] = (short)(ufc.y & 0xffffu); uf[3] = (short)(ufc.y >> 16);
            uf[4] = (short)(ufc.z & 0xffffu); uf[5] = (short)(ufc.z >> 16); uf[6] = (short)(ufc.w & 0xffffu); uf[7] = (short)(ufc.w >> 16);
#pragma unroll
            for (int blk = 0; blk < 8; ++blk) {
                const f32x4 r = mfma16(bbf[blk], uf, (f32x4){0.f, 0.f, 0.f, 0.f});
                *(f32x4*)(BU + l15 * 132 + blk * 16 + quad * 4) = r;
            }
            wave_lds_sync();
            float bur[16], bui[16];
#pragma unroll
            for (int t = 0; t < 16; ++t) { bur[t] = BU[t * 132 + n]; bui[t] = BU[t * 132 + 64 + n]; }
#pragma unroll
            for (int t = 0; t < 16; ++t) {
                if (t < nv) {
                    const float nxr = abr * xr - abi * xi + bur[t], nxi = abr * xi + abi * xr + bui[t];
                    xr = nxr; xi = nxi;
                }
                XL[t * 136 + n] = f2bf(xr); XL[t * 136 + 64 + n] = f2bf(xi);
            }
            wave_lds_sync();
            f32x4 acc = (f32x4){0.f, 0.f, 0.f, 0.f};
#pragma unroll
            for (int kb = 0; kb < 4; ++kb) {
                const bf16x8 xf = *(const bf16x8*)(XL + l15 * 136 + kb * 32 + quad * 8);
                acc = mfma16(cf[kb], xf, acc);
            }
            if (l15 < nv) {
                f32x4 y; y[0] = acc[0] + dd.x * bflo(udc.x); y[1] = acc[1] + dd.y * bfhi(udc.x); y[2] = acc[2] + dd.z * bflo(udc.y); y[3] = acc[3] + dd.w * bfhi(udc.y);
#pragma unroll
                for (int e = 0; e < 4; ++e) { const float v = y[e]; y[e] = 0.5f * v * (1.0f + tanhf_(0.7978845608028654f * (v + 0.044715f * v * v * v))); }
                *(uint2*)(Y1 + (size_t)(row0 + tt + l15) * E + g * 16 + quad * 4) = pack4(y);
            }
            wave_lds_sync();
        }
        float* o = p.out + (sample ? O_S_S5_RE : O_P_S5_RE) + ((size_t)b * 128 + g) * 64 + n;
        o[0] = xr;
        o[(sample ? O_S_S5_IM - O_S_S5_RE : O_P_S5_IM - O_P_S5_RE)] = xi;
    }
}

typedef float f32x2 __attribute__((ext_vector_type(2)));
__device__ __forceinline__ float half_sum(float v) {
#pragma unroll
    for (int o = 16; o > 0; o >>= 1) v += __shfl_xor(v, o, 64);
    return v;
}
__device__ __forceinline__ float dpp_sum8(float x) {
    x += __int_as_float(__builtin_amdgcn_mov_dpp(__float_as_int(x), 0xB1, 0xf, 0xf, true));
    x += __int_as_float(__builtin_amdgcn_mov_dpp(__float_as_int(x), 0x4E, 0xf, 0xf, true));
    x += __int_as_float(__builtin_amdgcn_mov_dpp(__float_as_int(x), 0x141, 0xf, 0xf, true));
    return x;
}
struct RwItem { int sample, b, h, row0, nsteps; };
__device__ __forceinline__ RwItem rw_decode(int item) {
    RwItem r; r.sample = item >= 256; const int it = r.sample ? item - 256 : item; r.b = it >> 5; r.h = it & 31;
    r.row0 = r.sample ? RP + r.b * 8 : r.b * SEQT; r.nsteps = r.sample ? 8 : SEQT; return r;
}
constexpr int RW_NIT = 256 + 4096;
struct RwTile { int item, tt, have; };
__device__ __forceinline__ RwTile rw_next(const RwTile& c) {
    RwTile n = c;
    if (!c.have) return n;
    const int nsteps = c.item >= 256 ? 8 : SEQT;
    n.tt = c.tt + 16;
    if (n.tt >= nsteps) { n.item = c.item + gridDim.x; n.tt = 0; n.have = n.item < RW_NIT; }
    return n;
}
struct RwPre { unsigned r2, k2, v2, d2, a2, g2; float2 kkp, kap, rkp, lnw, lnb; size_t o; int valid; };
struct RwEpi { unsigned g2; float2 lnw, lnb; size_t o; int valid; };
__device__ __forceinline__ void rw_load(RwPre& q, const Params& p, const RwTile& tl, int pt, int c2) {
    const RwItem it = rw_decode(tl.have ? tl.item : 0);
    const int chh = it.h * 64 + c2 * 2;
    q.valid = tl.have && (tl.tt + pt) < it.nsteps;
    q.o = (size_t)(it.row0 + tl.tt + pt) * E + chh;
    q.r2 = q.k2 = q.v2 = q.d2 = q.a2 = q.g2 = 0u;
    if (q.valid) {
        q.r2 = *(const unsigned*)(p.ACT[0] + q.o); q.k2 = *(const unsigned*)(p.ACT[1] + q.o); q.v2 = *(const unsigned*)(p.ACT[2] + q.o);
        q.g2 = *(const unsigned*)(p.ACT[3] + q.o); q.d2 = *(const unsigned*)(p.ACT[4] + q.o); q.a2 = *(const unsigned*)(p.ACT[5] + q.o);
    }
    q.kkp = *(const float2*)(p.in[I_RW_KK] + chh); q.kap = *(const float2*)(p.in[I_RW_KA] + chh); q.rkp = *(const float2*)(p.in[I_RW_RK] + chh);
    q.lnw = *(const float2*)(p.in[I_RW_LNW] + chh); q.lnb = *(const float2*)(p.in[I_RW_LNB] + chh);
}
__device__ __forceinline__ float row_sum16(float x) {
    x += __int_as_float(__builtin_amdgcn_mov_dpp(__float_as_int(x), 0xB1, 0xf, 0xf, true));
    x += __int_as_float(__builtin_amdgcn_mov_dpp(__float_as_int(x), 0x4E, 0xf, 0xf, true));
    x += __int_as_float(__builtin_amdgcn_mov_dpp(__float_as_int(x), 0x141, 0xf, 0xf, true));
    x += __int_as_float(__builtin_amdgcn_mov_dpp(__float_as_int(x), 0x140, 0xf, 0xf, true));
    return x;
}
__device__ __forceinline__ float half_sum32(float x) { x = row_sum16(x); return x + __shfl_xor(x, 16, 64); }
__device__ __forceinline__ void rw_store(const RwPre& q, float* VEC, float* VV, float* BON, int pt, int c2) {
    const float r0 = bflo(q.r2), r1 = bfhi(q.r2), k0 = bflo(q.k2), k1 = bfhi(q.k2), a0 = bflo(q.a2), a1 = bfhi(q.a2);
    const float w0 = __expf(-bflo(q.d2)), w1 = __expf(-bfhi(q.d2));
    float kk0 = k0 * q.kkp.x, kk1 = k1 * q.kkp.y;
    const float ss = half_sum32(kk0 * kk0 + kk1 * kk1);
    const float inv = rsqrtf(fmaxf(ss, 1e-24f));
    kk0 *= inv; kk1 *= inv;
    const float km0 = k0 * (1.0f + (a0 - 1.0f) * q.kap.x), km1 = k1 * (1.0f + (a1 - 1.0f) * q.kap.y);
    const float bon = half_sum32(r0 * km0 * q.rkp.x + r1 * km1 * q.rkp.y);
    float* ve = VEC + pt * 320 + c2 * 2;
    *(float2*)(ve) = make_float2(w0, w1);
    *(float2*)(ve + 64) = make_float2(-kk0, -kk1);
    *(float2*)(ve + 128) = make_float2(kk0 * a0, kk1 * a1);
    *(float2*)(ve + 192) = make_float2(km0, km1);
    *(float2*)(ve + 256) = make_float2(r0, r1);
    *(float2*)(VV + pt * 64 + c2 * 2) = make_float2(bflo(q.v2), bfhi(q.v2));
    if (c2 == 0) BON[pt] = bon;
}
__device__ __forceinline__ void rw_epilogue(const RwEpi& e, const Params& p, const float* VV, const float* BON, const float* YL, int pt, int c2) {
    const float2 yy = *(const float2*)(YL + pt * 64 + c2 * 2);
    const float mean = half_sum32(yy.x + yy.y) * (1.0f / 64.0f);
    const float d0 = yy.x - mean, d1 = yy.y - mean;
    const float var = half_sum32(d0 * d0 + d1 * d1) * (1.0f / 64.0f);
    const float rstd = rsqrtf(var + 64e-5f);
    if (e.valid) {
        const float2 v2 = *(const float2*)(VV + pt * 64 + c2 * 2);
        const float bon = BON[pt];
        const float o0 = (d0 * rstd * e.lnw.x + e.lnb.x + bon * v2.x) * bflo(e.g2);
        const float o1 = (d1 * rstd * e.lnw.y + e.lnb.y + bon * v2.y) * bfhi(e.g2);
        *(unsigned*)(p.ACT[6] + e.o) = pack2(o0, o1);
    }
}
__device__ __forceinline__ RwEpi rw_epi_of(const RwPre& q) { RwEpi e; e.g2 = q.g2; e.lnw = q.lnw; e.lnb = q.lnb; e.o = q.o; e.valid = q.valid; return e; }
struct RwVec { f32x4 w[2], a[2], b[2], k[2], r[2]; float2 vv; };
__device__ __forceinline__ void rw_vload(RwVec& q, const float* VEC, const float* VV, int t, int oct, int v0) {
    const float* ve = VEC + t * 320 + oct * 8;
    q.w[0] = *(const f32x4*)ve; q.w[1] = *(const f32x4*)(ve + 4);
    q.a[0] = *(const f32x4*)(ve + 64); q.a[1] = *(const f32x4*)(ve + 68);
    q.b[0] = *(const f32x4*)(ve + 128); q.b[1] = *(const f32x4*)(ve + 132);
    q.k[0] = *(const f32x4*)(ve + 192); q.k[1] = *(const f32x4*)(ve + 196);
    q.r[0] = *(const f32x4*)(ve + 256); q.r[1] = *(const f32x4*)(ve + 260);
    q.vv = *(const float2*)(VV + t * 64 + v0);
}
__device__ __forceinline__ void rw_step(f32x2 (&S)[2][4], const RwVec& q, float* YL, int t, int oct, int v0) {
    const f32x2 a0 = (f32x2){q.a[0][0], q.a[0][1]}, a1 = (f32x2){q.a[0][2], q.a[0][3]}, a2 = (f32x2){q.a[1][0], q.a[1][1]}, a3 = (f32x2){q.a[1][2], q.a[1][3]};
    const f32x2 sp0 = S[0][0] * a0 + S[0][1] * a1 + S[0][2] * a2 + S[0][3] * a3;
    const f32x2 sp1 = S[1][0] * a0 + S[1][1] * a1 + S[1][2] * a2 + S[1][3] * a3;
    const float sa0 = dpp_sum8(sp0[0] + sp0[1]), sa1 = dpp_sum8(sp1[0] + sp1[1]);
    const f32x2 w0 = (f32x2){q.w[0][0], q.w[0][1]}, w1 = (f32x2){q.w[0][2], q.w[0][3]}, w2 = (f32x2){q.w[1][0], q.w[1][1]}, w3 = (f32x2){q.w[1][2], q.w[1][3]};
    const f32x2 b0 = (f32x2){q.b[0][0], q.b[0][1]}, b1 = (f32x2){q.b[0][2], q.b[0][3]}, b2 = (f32x2){q.b[1][0], q.b[1][1]}, b3 = (f32x2){q.b[1][2], q.b[1][3]};
    const f32x2 k0 = (f32x2){q.k[0][0], q.k[0][1]}, k1 = (f32x2){q.k[0][2], q.k[0][3]}, k2 = (f32x2){q.k[1][0], q.k[1][1]}, k3 = (f32x2){q.k[1][2], q.k[1][3]};
    {
        const f32x2 sa2 = (f32x2){sa0, sa0}, vv2 = (f32x2){q.vv.x, q.vv.x};
        S[0][0] = S[0][0] * w0 + sa2 * b0 + vv2 * k0; S[0][1] = S[0][1] * w1 + sa2 * b1 + vv2 * k1;
        S[0][2] = S[0][2] * w2 + sa2 * b2 + vv2 * k2; S[0][3] = S[0][3] * w3 + sa2 * b3 + vv2 * k3;
    }
    {
        const f32x2 sa2 = (f32x2){sa1, sa1}, vv2 = (f32x2){q.vv.y, q.vv.y};
        S[1][0] = S[1][0] * w0 + sa2 * b0 + vv2 * k0; S[1][1] = S[1][1] * w1 + sa2 * b1 + vv2 * k1;
        S[1][2] = S[1][2] * w2 + sa2 * b2 + vv2 * k2; S[1][3] = S[1][3] * w3 + sa2 * b3 + vv2 * k3;
    }
    const f32x2 r0 = (f32x2){q.r[0][0], q.r[0][1]}, r1 = (f32x2){q.r[0][2], q.r[0][3]}, r2 = (f32x2){q.r[1][0], q.r[1][1]}, r3 = (f32x2){q.r[1][2], q.r[1][3]};
    const f32x2 yp0 = S[0][0] * r0 + S[0][1] * r1 + S[0][2] * r2 + S[0][3] * r3;
    const f32x2 yp1 = S[1][0] * r0 + S[1][1] * r1 + S[1][2] * r2 + S[1][3] * r3;
    const float y0 = dpp_sum8(yp0[0] + yp0[1]), y1 = dpp_sum8(yp1[0] + yp1[1]);
    if (oct == 0) *(float2*)(YL + t * 64 + v0) = make_float2(y0, y1);
}
__device__ __forceinline__ void phase_rwkv(const Params& p, char* smem) {
    constexpr int BUF_F = 16 * 5 * 64 + 16 * 64 + 64 + 16 * 64;
    float* base = (float*)smem;
    const int tid = opaque_tid(), lane = tid & 63, wave = tid >> 6;
    const bool scanner = wave < 4;
    const int oct = lane & 7, v0 = (wave & 3) * 16 + (lane >> 3) * 2;
    const int hid = tid & 255, pt0 = hid >> 5, c2 = hid & 31;
    RwTile tk; tk.item = blockIdx.x; tk.tt = 0; tk.have = blockIdx.x < RW_NIT;
    f32x2 S[2][4], Sn[2][4];
#pragma unroll
    for (int r = 0; r < 2; ++r)
#pragma unroll
        for (int i = 0; i < 4; ++i) { S[r][i] = (f32x2){0.f, 0.f}; Sn[r][i] = S[r][i]; }
    RwPre preN[2]; RwEpi epiP[2], epiC[2];
    epiP[0].valid = 0; epiP[1].valid = 0; epiP[0].o = 0; epiP[1].o = 0; epiP[0].g2 = 0; epiP[1].g2 = 0;
    epiP[0].lnw = epiP[0].lnb = epiP[1].lnw = epiP[1].lnb = make_float2(0.f, 0.f);
    epiC[0] = epiP[0]; epiC[1] = epiP[1];
    if (scanner) {
        const RwItem it = rw_decode(tk.have ? tk.item : 0);
        if (tk.have && it.sample) {
#pragma unroll
            for (int r = 0; r < 2; ++r) {
                const float* st = p.in[I_ST_RW_WKV] + (((size_t)it.b * 32 + it.h) * 64 + v0 + r) * 64 + oct * 8;
                const float4 s0 = *(const float4*)st, s1 = *(const float4*)(st + 4);
                Sn[r][0] = (f32x2){s0.x, s0.y}; Sn[r][1] = (f32x2){s0.z, s0.w}; Sn[r][2] = (f32x2){s1.x, s1.y}; Sn[r][3] = (f32x2){s1.z, s1.w};
            }
        }
    } else {
        RwPre pre0[2];
        rw_load(pre0[0], p, tk, pt0, c2); rw_load(pre0[1], p, tk, pt0 + 8, c2);
        const RwTile t1 = rw_next(tk);
        rw_load(preN[0], p, t1, pt0, c2); rw_load(preN[1], p, t1, pt0 + 8, c2);
        rw_store(pre0[0], base, base + 5120, base + 6144, pt0, c2); rw_store(pre0[1], base, base + 5120, base + 6144, pt0 + 8, c2);
        epiC[0] = rw_epi_of(pre0[0]); epiC[1] = rw_epi_of(pre0[1]);
    }
    __syncthreads();
    int kb = 0;
    bool first = true;
    while (tk.have) {
        const RwTile t1 = rw_next(tk);
        const int kn = kb == 2 ? 0 : kb + 1, kp = kb == 0 ? 2 : kb - 1;
        if (scanner) {
            const RwItem cur = rw_decode(tk.item);
            f32x2 Snn[2][4];
#pragma unroll
            for (int r = 0; r < 2; ++r)
#pragma unroll
                for (int i = 0; i < 4; ++i) Snn[r][i] = (f32x2){0.f, 0.f};
            if (t1.have && t1.tt == 0 && t1.item >= 256) {
                const RwItem nx = rw_decode(t1.item);
#pragma unroll
                for (int r = 0; r < 2; ++r) {
                    const float* st = p.in[I_ST_RW_WKV] + (((size_t)nx.b * 32 + nx.h) * 64 + v0 + r) * 64 + oct * 8;
                    const float4 s0 = *(const float4*)st, s1 = *(const float4*)(st + 4);
                    Snn[r][0] = (f32x2){s0.x, s0.y}; Snn[r][1] = (f32x2){s0.z, s0.w}; Snn[r][2] = (f32x2){s1.x, s1.y}; Snn[r][3] = (f32x2){s1.z, s1.w};
                }
            }
            if (tk.tt == 0) {
#pragma unroll
                for (int r = 0; r < 2; ++r)
#pragma unroll
                    for (int i = 0; i < 4; ++i) S[r][i] = Sn[r][i];
            }
            {
                const float* VEC = base + kb * BUF_F; const float* VV = VEC + 5120; float* YL = base + kb * BUF_F + 6144 + 64;
                const int nv = min(16, cur.nsteps - tk.tt);
                RwVec A, B;
                rw_vload(A, VEC, VV, 0, oct, v0);
                for (int t = 0; t < nv; t += 2) {
                    rw_vload(B, VEC, VV, t + 1, oct, v0);
                    rw_step(S, A, YL, t, oct, v0);
                    rw_vload(A, VEC, VV, t + 2, oct, v0);
                    rw_step(S, B, YL, t + 1, oct, v0);
                }
            }
            if (tk.tt + 16 >= cur.nsteps) {
#pragma unroll
                for (int r = 0; r < 2; ++r) {
                    float* dst = p.out + (cur.sample ? O_S_RW_WKV : O_P_RW_WKV) + (((size_t)cur.b * 32 + cur.h) * 64 + v0 + r) * 64 + oct * 8;
                    *(float4*)dst = make_float4(S[r][0][0], S[r][0][1], S[r][1][0], S[r][1][1]);
                    *(float4*)(dst + 4) = make_float4(S[r][2][0], S[r][2][1], S[r][3][0], S[r][3][1]);
                }
            }
            if (t1.tt == 0) {
#pragma unroll
                for (int r = 0; r < 2; ++r)
#pragma unroll
                    for (int i = 0; i < 4; ++i) Sn[r][i] = Snn[r][i];
            }
        } else {
            float* Bn = base + kn * BUF_F;
            rw_store(preN[0], Bn, Bn + 5120, Bn + 6144, pt0, c2); rw_store(preN[1], Bn, Bn + 5120, Bn + 6144, pt0 + 8, c2);
            RwEpi epiN[2]; epiN[0] = rw_epi_of(preN[0]); epiN[1] = rw_epi_of(preN[1]);
            const RwTile t2 = rw_next(t1);
            rw_load(preN[0], p, t2, pt0, c2); rw_load(preN[1], p, t2, pt0 + 8, c2);
            if (!first) {
                const float* Bp = base + kp * BUF_F;
                rw_epilogue(epiP[0], p, Bp + 5120, Bp + 6144, Bp + 6144 + 64, pt0, c2); rw_epilogue(epiP[1], p, Bp + 5120, Bp + 6144, Bp + 6144 + 64, pt0 + 8, c2);
            }
            epiP[0] = epiC[0]; epiP[1] = epiC[1]; epiC[0] = epiN[0]; epiC[1] = epiN[1];
        }
        __syncthreads();
        tk = t1; kb = kn; first = false;
    }
    if (!scanner && !first) {
        const int kp = kb == 0 ? 2 : kb - 1;
        const float* Bp = base + kp * BUF_F;
        rw_epilogue(epiP[0], p, Bp + 5120, Bp + 6144, Bp + 6144 + 64, pt0, c2); rw_epilogue(epiP[1], p, Bp + 5120, Bp + 6144, Bp + 6144 + 64, pt0 + 8, c2);
    }
}

__device__ __forceinline__ void ret_gload(uint4 (&qn)[4], uint4 (&kn)[4], uint4& vn, const bf16_t* Q, const bf16_t* Kg, const bf16_t* V,
                                          int row0, int c0, int nsteps, int h, int s, int tid, int lane, int wave) {
    const int Lv = min(64, nsteps - c0);
#pragma unroll
    for (int i4 = 0; i4 < 4; ++i4) {
        const int idx = tid + i4 * 512, row = idx >> 5, kc = (idx & 31) * 8;
        qn[i4] = make_uint4(0u, 0u, 0u, 0u); kn[i4] = qn[i4];
        if (row < Lv) qn[i4] = *(const uint4*)(Q + (size_t)(row0 + c0 + row) * D + h * 256 + kc);
        if (lane < Lv) kn[i4] = *(const uint4*)(Kg + (size_t)(row0 + c0 + lane) * D + h * 256 + (wave + i4 * 8) * 8);
    }
    vn = make_uint4(0u, 0u, 0u, 0u);
    if (lane < Lv) vn = *(const uint4*)(V + (size_t)(row0 + c0 + lane) * E + h * 512 + s * 64 + wave * 8);
}
__device__ __forceinline__ void phase_ret(const Params& p, char* smem) {
    bf16_t* Ql = (bf16_t*)smem;
    bf16_t* Kl = Ql + 64 * 264;
    bf16_t* VT = Kl + 256 * 72;
    bf16_t* Pl = VT + 64 * 72;
    bf16_t* ST = Pl + 64 * 72;
    const int tid = opaque_tid(), lane = tid & 63, wave = tid >> 6, l15 = lane & 15, quad = lane >> 4;
    const bf16_t* Q = p.ACT[0]; const bf16_t* Kg = p.ACT[1]; const bf16_t* V = p.ACT[2]; bf16_t* Y = p.ACT[4];
    for (int item = blockIdx.x; item < 256 + 4096; item += gridDim.x) {
        const bool sample = item >= 256;
        const int it = sample ? item - 256 : item, b = it >> 5, h = (it >> 3) & 3, s = it & 7;
        const int row0 = sample ? RP + b * 8 : b * SEQT, nsteps = sample ? 8 : SEQT;
        const float lg2 = log2f(1.0f - exp2f(-5.0f - (float)h));
        f32x4 accS[2][4];
        const size_t sbase = (((size_t)b * 4 + h) * 256 + wave * 32 + quad * 4) * 512 + s * 64 + l15;
#pragma unroll
        for (int i = 0; i < 2; ++i)
#pragma unroll
            for (int j = 0; j < 4; ++j) {
                if (sample) {
#pragma unroll
                    for (int e = 0; e < 4; ++e) accS[i][j][e] = p.in[I_ST_RET][sbase + (size_t)(i * 16 + e) * 512 + j * 16];
                } else accS[i][j] = (f32x4){0.f, 0.f, 0.f, 0.f};
            }
#pragma unroll
        for (int i = 0; i < 2; ++i)
#pragma unroll
            for (int j = 0; j < 4; ++j) *(uint2*)(ST + (j * 16 + l15) * 264 + wave * 32 + i * 16 + quad * 4) = pack4(accS[i][j]);
        uint4 qn[4], kn[4], vn;
        ret_gload(qn, kn, vn, Q, Kg, V, row0, 0, nsteps, h, s, tid, lane, wave);
        for (int c0 = 0; c0 < nsteps; c0 += 64) {
            const int Lv = min(64, nsteps - c0);
            uint4 kq[4];
#pragma unroll
            for (int i4 = 0; i4 < 4; ++i4) {
                const int idx = tid + i4 * 512, row = idx >> 5, kc = (idx & 31) * 8;
                kq[i4] = kn[i4];
                *(uint4*)(Ql + row * 264 + kc) = qn[i4];
                *(uint4*)(Kl + lane * 264 + (wave + i4 * 8) * 8) = kq[i4];
            }
            {
                const int row = lane, dvc = wave * 8; const uint4 vv = vn;
                VT[(dvc + 0) * 72 + row] = (bf16_t)(vv.x & 0xffffu); VT[(dvc + 1) * 72 + row] = (bf16_t)(vv.x >> 16);
                VT[(dvc + 2) * 72 + row] = (bf16_t)(vv.y & 0xffffu); VT[(dvc + 3) * 72 + row] = (bf16_t)(vv.y >> 16);
                VT[(dvc + 4) * 72 + row] = (bf16_t)(vv.z & 0xffffu); VT[(dvc + 5) * 72 + row] = (bf16_t)(vv.z >> 16);
                VT[(dvc + 6) * 72 + row] = (bf16_t)(vv.w & 0xffffu); VT[(dvc + 7) * 72 + row] = (bf16_t)(vv.w >> 16);
            }
            __syncthreads();
            if (c0 + 64 < nsteps) ret_gload(qn, kn, vn, Q, Kg, V, row0, c0 + 64, nsteps, h, s, tid, lane, wave);
            {
                const int ti = wave >> 1, t_abs = ti * 16 + l15;
#pragma unroll
                for (int s2 = 0; s2 < 2; ++s2) {
                    const int si = (wave & 1) * 2 + s2;
                    f32x4 acc = (f32x4){0.f, 0.f, 0.f, 0.f};
#pragma unroll
                    for (int kb = 0; kb < 8; ++kb) {
                        const bf16x8 kf = *(const bf16x8*)(Kl + (si * 16 + l15) * 264 + kb * 32 + quad * 8);
                        const bf16x8 qf = *(const bf16x8*)(Ql + (ti * 16 + l15) * 264 + kb * 32 + quad * 8);
                        acc = mfma16(kf, qf, acc);
                    }
                    f32x4 pv;
#pragma unroll
                    for (int e = 0; e < 4; ++e) { const int s_abs = si * 16 + quad * 4 + e; pv[e] = s_abs <= t_abs ? acc[e] * exp2f((float)(t_abs - s_abs) * lg2) : 0.f; }
                    *(uint2*)(Pl + t_abs * 72 + si * 16 + quad * 4) = pack4(pv);
                }
            }
            __syncthreads();
#pragma unroll
            for (int i4 = 0; i4 < 4; ++i4) {
                const int row = lane, kc = (wave + i4 * 8) * 8;
                const float wgt = row < Lv ? exp2f((float)(Lv - 1 - row) * lg2) : 0.f;
                const uint4 kv = kq[i4];
                Kl[(kc + 0) * 72 + row] = f2bf(bflo(kv.x) * wgt); Kl[(kc + 1) * 72 + row] = f2bf(bfhi(kv.x) * wgt);
                Kl[(kc + 2) * 72 + row] = f2bf(bflo(kv.y) * wgt); Kl[(kc + 3) * 72 + row] = f2bf(bfhi(kv.y) * wgt);
                Kl[(kc + 4) * 72 + row] = f2bf(bflo(kv.z) * wgt); Kl[(kc + 5) * 72 + row] = f2bf(bfhi(kv.z) * wgt);
                Kl[(kc + 6) * 72 + row] = f2bf(bflo(kv.w) * wgt); Kl[(kc + 7) * 72 + row] = f2bf(bfhi(kv.w) * wgt);
            }
            __syncthreads();
            {
                const int ti = wave >> 1, t_abs = ti * 16 + l15;
                const float dec = exp2f((float)(t_abs + 1) * lg2);
                float ssq = 0.f;
#pragma unroll
                for (int d2 = 0; d2 < 2; ++d2) {
                    const int dvt = (wave & 1) * 2 + d2;
                    f32x4 a1 = (f32x4){0.f, 0.f, 0.f, 0.f}, a2 = a1;
#pragma unroll
                    for (int kb = 0; kb < 2; ++kb) {
                        const bf16x8 vf = *(const bf16x8*)(VT + (dvt * 16 + l15) * 72 + kb * 32 + quad * 8);
                        const bf16x8 pf = *(const bf16x8*)(Pl + (ti * 16 + l15) * 72 + kb * 32 + quad * 8);
                        a1 = mfma16(vf, pf, a1);
                    }
#pragma unroll
                    for (int kb = 0; kb < 8; ++kb) {
                        const bf16x8 sf = *(const bf16x8*)(ST + (dvt * 16 + l15) * 264 + kb * 32 + quad * 8);
                        const bf16x8 qf = *(const bf16x8*)(Ql + (ti * 16 + l15) * 264 + kb * 32 + quad * 8);
                        a2 = mfma16(sf, qf, a2);
                    }
                    f32x4 yv;
#pragma unroll
                    for (int e = 0; e < 4; ++e) { yv[e] = a1[e] + dec * a2[e]; ssq += yv[e] * yv[e]; }
                    if (t_abs < Lv) *(uint2*)(Y + (size_t)(row0 + c0 + t_abs) * E + h * 512 + s * 64 + dvt * 16 + quad * 4) = pack4(yv);
                }
                ssq += __shfl_xor(ssq, 16, 64); ssq += __shfl_xor(ssq, 32, 64);
                if (quad == 0 && t_abs < Lv) p.SSP[(size_t)(row0 + c0 + t_abs) * 64 + h * 16 + s * 2 + (wave & 1)] = ssq;
            }
            {
                const float dL = exp2f((float)Lv * lg2);
#pragma unroll
                for (int i = 0; i < 2; ++i)
#pragma unroll
                    for (int j = 0; j < 4; ++j) accS[i][j] *= dL;
#pragma unroll
                for (int kb = 0; kb < 2; ++kb) {
                    bf16x8 kf[2], vf[4];
#pragma unroll
                    for (int i = 0; i < 2; ++i) kf[i] = *(const bf16x8*)(Kl + (wave * 32 + i * 16 + l15) * 72 + kb * 32 + quad * 8);
#pragma unroll
                    for (int j = 0; j < 4; ++j) vf[j] = *(const bf16x8*)(VT + (j * 16 + l15) * 72 + kb * 32 + quad * 8);
#pragma unroll
                    for (int i = 0; i < 2; ++i)
#pragma unroll
                        for (int j = 0; j < 4; ++j) accS[i][j] = mfma16(kf[i], vf[j], accS[i][j]);
                }
            }
            __syncthreads();
#pragma unroll
            for (int i = 0; i < 2; ++i)
#pragma unroll
                for (int j = 0; j < 4; ++j) *(uint2*)(ST + (j * 16 + l15) * 264 + wave * 32 + i * 16 + quad * 4) = pack4(accS[i][j]);
        }
        float* dst = p.out + (sample ? O_S_RET : O_P_RET);
#pragma unroll
        for (int i = 0; i < 2; ++i)
#pragma unroll
            for (int j = 0; j < 4; ++j)
#pragma unroll
                for (int e = 0; e < 4; ++e) dst[sbase + (size_t)(i * 16 + e) * 512 + j * 16] = accS[i][j][e];
        __syncthreads();
    }
}

#define XB_TMO      128
#define XB_XCNT(j)  (256  + 64 * (j))
#define XB_XSUB(j)  (1280 + 64 * (j))
#define XB_XGEN(j)  (2304 + 64 * (j))
#define XB_TOP      3328
#define XB_TOPGEN   3392
#define XCD_BAR_WORDS 3456
#define XB_SPIN_CAP (1u << 22)
__device__ __forceinline__ unsigned xb_ld(unsigned* p)              { return __hip_atomic_load(p, __ATOMIC_RELAXED, __HIP_MEMORY_SCOPE_AGENT); }
__device__ __forceinline__ unsigned xb_add(unsigned* p, unsigned v) { return __hip_atomic_fetch_add(p, v, __ATOMIC_RELAXED, __HIP_MEMORY_SCOPE_AGENT); }
__device__ __forceinline__ unsigned xb_xcc_id() { return (unsigned)__builtin_amdgcn_s_getreg((3 << 11) | 20) & 0xFu; }
#define XB_SPIN(cond, bar) do { unsigned _sp = 0; while (cond) { __builtin_amdgcn_s_sleep(1); \
    if ((++_sp & 255u) == 0u) { if (xb_ld(&(bar)[XB_TMO])) break; if (_sp > XB_SPIN_CAP) { atomicAdd(&(bar)[XB_TMO], 1u); break; } } } } while (0)
struct XcdBarrier { unsigned* bar; unsigned x; volatile LAS unsigned* st; };
__device__ __forceinline__ XcdBarrier xcd_barrier_post(unsigned* bar, volatile LAS unsigned* st) {
    XcdBarrier b; b.bar = bar; b.x = xb_xcc_id(); b.st = st;
    if (threadIdx.x == 0) st[3] = xb_add(&bar[XB_XCNT(b.x)], 1u);
    return b;
}
__device__ __forceinline__ void xcd_barrier_complete(unsigned* bar, unsigned x, unsigned& nloc, unsigned& nx) {
    const unsigned G = gridDim.x * gridDim.y * gridDim.z;
    unsigned sum, cnt, mine, sp = 0u;
    for (;;) {
        sum = 0u; cnt = 0u; mine = 0u;
#pragma unroll
        for (unsigned j = 0; j < 16; ++j) { const unsigned c = xb_ld(&bar[XB_XCNT(j)]); sum += c; cnt += (c > 0u) ? 1u : 0u; mine = (j == x) ? c : mine; }
        if (sum == G) break;
        __builtin_amdgcn_s_sleep(1);
        if ((++sp & 255u) == 0u) { if (xb_ld(&bar[XB_TMO])) break; if (sp > XB_SPIN_CAP) { atomicAdd(&bar[XB_TMO], 1u); break; } }
    }
    nloc = mine > 0u ? mine : 1u; nx = cnt > 0u ? cnt : 1u;
}
__device__ __forceinline__ void xcd_barrier(const XcdBarrier& b) {
    asm volatile("s_waitcnt vmcnt(0)" ::: "memory");
    __syncthreads();
    if (threadIdx.x == 0) {
        unsigned* bar = b.bar;
        __builtin_amdgcn_s_waitcnt(0);
        unsigned nloc = b.st[0], nx = b.st[1];
        if (nloc == 0u) { xcd_barrier_complete(bar, b.x, nloc, nx); b.st[0] = nloc; b.st[1] = nx; }
        const unsigned old = xb_add(&bar[XB_XSUB(b.x)], 1u);
        const unsigned gen = old / nloc;
        if (old + 1u == (gen + 1u) * nloc) {
            __builtin_amdgcn_fence(__ATOMIC_RELEASE, "agent");
            asm volatile("s_waitcnt vmcnt(0)" ::: "memory");
            const unsigned og = xb_add(&bar[XB_TOP], 1u);
            const unsigned tg = og / nx;
            if (og + 1u == (tg + 1u) * nx) xb_add(&bar[XB_TOPGEN], 1u);
            else XB_SPIN(xb_ld(&bar[XB_TOPGEN]) == tg, bar);
            __builtin_amdgcn_fence(__ATOMIC_ACQUIRE, "agent");
            xb_add(&bar[XB_XGEN(b.x)], 1u);
            asm volatile("s_waitcnt vmcnt(0)" ::: "memory");
        } else {
            XB_SPIN(xb_ld(&bar[XB_XGEN(b.x)]) == gen, bar);
            __builtin_amdgcn_fence(__ATOMIC_ACQUIRE, "agent");
            asm volatile("s_waitcnt vmcnt(0)" ::: "memory");
        }
    }
    __syncthreads();
}

__global__ void __launch_bounds__(NTHREADS) fwd_megakernel(Params p) {
    extern __shared__ __attribute__((aligned(16))) char smem[];
    cg::grid_group grid = cg::this_grid();
    volatile LAS unsigned* xst = (volatile LAS unsigned*)(smem + LDS_BYTES - 16);
    if (threadIdx.x < 4) xst[threadIdx.x] = threadIdx.x == 2 ? blockIdx.x : 0u;
    __syncthreads();
    const XcdBarrier xb = xcd_barrier_post(p.bar, xst);
    phase_prep(p, smem);
    phase_norm(p, 0, 0, p.X, p.X);
    grid.sync();
    if (threadIdx.x == 0) {
        bool even = gridDim.x == 256;
        for (int j = 0; j < 8; ++j) even = even && xb_ld(&p.bar[XB_XCNT(j)]) == 32u;
        if (even) xst[2] = xb.x + 8u * xst[3];
    }
    __syncthreads();
    phase_gemm_inproj(p, smem, W_LRU_IN, true);
    xcd_barrier(xb);
    phase_lru(p, smem);
    xcd_barrier(xb);
    phase_gemm_out(p, smem, W_LRU_OUT, p.ACT[2]);
    xcd_barrier(xb);
    phase_norm(p, 1, 1, p.X, p.X);
    xcd_barrier(xb);
    phase_gemm_inproj(p, smem, W_S5_IN, false);
    xcd_barrier(xb);
    phase_s5(p, smem);
    xcd_barrier(xb);
    phase_gemm_glu(p, smem);
    xcd_barrier(xb);
    phase_gemm_out(p, smem, W_S5_OUT, p.ACT[3]);
    xcd_barrier(xb);
    phase_norm_rwkv(p, p.X, p.X2);
    xcd_barrier(xb);
    phase_gemm_rwkv_in(p, smem);
    xcd_barrier(xb);
    phase_gemm_lora2(p, smem);
    xcd_barrier(xb);
    phase_rwkv(p, smem);
    xcd_barrier(xb);
    phase_gemm_out(p, smem, W_RW_OUT, p.ACT[6]);
    xcd_barrier(xb);
    phase_norm(p, 1, 3, p.X2, p.X2);
    xcd_barrier(xb);
    phase_gemm_ret_in(p, smem);
    xcd_barrier(xb);
    phase_ret(p, smem);
    xcd_barrier(xb);
    phase_gemm_ret_out(p, smem);
    xcd_barrier(xb);
    phase_norm(p, 3, 4, p.X2, p.X2);
}

extern "C" void kernel_launch(void* const* d_in, const int* in_sizes, int n_in, void* d_out, int out_size, void* d_ws, size_t ws_size, hipStream_t stream) {
    static int grid_blocks = 0;
    if (!grid_blocks) {
        int dev = 0, cus = 0, per_cu = 0;
        hipGetDevice(&dev);
        hipDeviceGetAttribute(&cus, hipDeviceAttributeMultiprocessorCount, dev);
        hipFuncSetAttribute((const void*)fwd_megakernel, hipFuncAttributeMaxDynamicSharedMemorySize, LDS_BYTES);
        hipOccupancyMaxActiveBlocksPerMultiprocessor(&per_cu, fwd_megakernel, NTHREADS, LDS_BYTES);
        if (per_cu < 1) per_cu = 1;
        if (per_cu > 1) per_cu = 1;
        grid_blocks = cus * per_cu;
    }
    Params p{};
    for (int i = 0; i < N_IN; ++i) p.in[i] = (const float*)d_in[i];
    p.out = (float*)d_out;
    char* ws = (char*)d_ws;
    size_t off = 0;
    auto take = [&](size_t bytes) { char* r = ws + off; off += (bytes + 255) & ~(size_t)255; return r; };
    p.X = (float*)take((size_t)RPAD * D * 4);
    p.Z = (float*)take((size_t)RPAD * D * 4);
    p.XN = (bf16_t*)take((size_t)RPAD * D * 2);
    p.XM = (bf16_t*)take((size_t)6 * RPAD * D * 2);
    p.X2 = (float*)take((size_t)RPAD * D * 4);
    for (int i = 0; i < 7; ++i) p.ACT[i] = (bf16_t*)take((size_t)RPAD * E * 2);
    p.L1 = (bf16_t*)take((size_t)RPAD * 128 * 2);
    p.SSP = (float*)take((size_t)R * 64 * 4);
    for (int j = 0; j < N_W; ++j) p.W[j] = (bf16_t*)take((size_t)w_rows(j) * w_k(j) * 2);
    p.bar = (unsigned*)take(XCD_BAR_WORDS * 4);
    if (off > ws_size) { fprintf(stderr, "workspace too small: need %zu have %zu\n", off, ws_size); return; }
    hipMemsetAsync(p.bar, 0, XCD_BAR_WORDS * 4, stream);
    void* args[] = {&p};
    hipError_t e = hipLaunchCooperativeKernel((const void*)fwd_megakernel, dim3(grid_blocks), dim3(NTHREADS), args, LDS_BYTES, stream);
    if (e != hipSuccess) fprintf(stderr, "cooperative launch failed: %s (grid %d)\n", hipGetErrorString(e), grid_blocks);
}
```

```cpp
#include <hip/hip_runtime.h>
#include <hip/hip_cooperative_groups.h>
#include <cstdio>
namespace cg = cooperative_groups;

typedef unsigned short bf16_t;
typedef short bf16x8 __attribute__((ext_vector_type(8)));
typedef float f32x4 __attribute__((ext_vector_type(4)));

constexpr int D = 1024, E = 2048, NB = 8, SEQT = 2064, NSB = 128, DSEQ = 8;
constexpr int RP = NB * SEQT;
constexpr int R = RP + NSB * DSEQ;
constexpr int MT = R / 128;
constexpr int RPAD = 17664;
constexpr int NTHREADS = 512;
constexpr int LDS_BYTES = 147456;
constexpr float EPS = 1e-6f;

constexpr size_t O_YP = 0;
constexpr size_t O_YS = O_YP + (size_t)NB * 2048 * D;
constexpr size_t O_P_LRU_CONV = O_YS + (size_t)NSB * DSEQ * D;
constexpr size_t O_P_LRU_H = O_P_LRU_CONV + (size_t)NB * 3 * E;
constexpr size_t O_P_S5_RE = O_P_LRU_H + (size_t)NB * E;
constexpr size_t O_P_S5_IM = O_P_S5_RE + (size_t)NB * 128 * 64;
constexpr size_t O_P_RW_SHIFT = O_P_S5_IM + (size_t)NB * 128 * 64;
constexpr size_t O_P_RW_WKV = O_P_RW_SHIFT + (size_t)NB * D;
constexpr size_t O_P_RET = O_P_RW_WKV + (size_t)NB * 32 * 64 * 64;
constexpr size_t O_S_LRU_CONV = O_P_RET + (size_t)NB * 4 * 256 * 512;
constexpr size_t O_S_LRU_H = O_S_LRU_CONV + (size_t)NSB * 3 * E;
constexpr size_t O_S_S5_RE = O_S_LRU_H + (size_t)NSB * E;
constexpr size_t O_S_S5_IM = O_S_S5_RE + (size_t)NSB * 128 * 64;
constexpr size_t O_S_RW_SHIFT = O_S_S5_IM + (size_t)NSB * 128 * 64;
constexpr size_t O_S_RW_WKV = O_S_RW_SHIFT + (size_t)NSB * D;
constexpr size_t O_S_RET = O_S_RW_WKV + (size_t)NSB * 32 * 64 * 64;

enum { I_XP = 0, I_XS, I_ST_LRU_CONV, I_ST_LRU_H, I_ST_S5_RE, I_ST_S5_IM, I_ST_RW_SHIFT, I_ST_RW_WKV, I_ST_RET, I_META,
       I_NPRE, I_NPOST, I_LRU_WIN, I_LRU_CW, I_LRU_CB, I_LRU_WA, I_LRU_BA, I_LRU_WX, I_LRU_BX, I_LRU_LAM, I_LRU_WOUT,
       I_S5_WIN, I_S5_LOGDT, I_S5_ARE, I_S5_AIM, I_S5_BRE, I_S5_BIM, I_S5_CRE, I_S5_CIM, I_S5_D, I_S5_GLUW, I_S5_GLUB, I_S5_WOUT,
       I_RW_MU, I_RW_WR, I_RW_WK, I_RW_WV, I_RW_WG, I_RW_W0, I_RW_W1, I_RW_W2, I_RW_A0, I_RW_A1, I_RW_A2, I_RW_KK, I_RW_KA,
       I_RW_RK, I_RW_LNW, I_RW_LNB, I_RW_WO, I_RT_WQ, I_RT_WK, I_RT_WV, I_RT_WG, I_RT_WO, N_IN };

enum { W_LRU_IN = 0, W_LRU_G, W_LRU_OUT, W_S5_IN, W_S5_GLU, W_S5_OUT, W_RW_IN, W_RW_L2, W_RW_OUT, W_RT_IN, W_RT_OUT, N_W };
__host__ __device__ constexpr int w_rows(int j) { return j == W_LRU_IN ? 4096 : j == W_LRU_G ? 4096 : j == W_LRU_OUT ? 1024 : j == W_S5_IN ? 4096 : j == W_S5_GLU ? 2048 :
                                 j == W_S5_OUT ? 1024 : j == W_RW_IN ? 8704 : j == W_RW_L2 ? 4096 : j == W_RW_OUT ? 1024 : j == W_RT_IN ? 6144 : 1024; }
__host__ __device__ constexpr int w_k(int j) { return j == W_LRU_IN ? 1024 : j == W_LRU_G ? 128 : j == W_LRU_OUT ? 2048 : j == W_S5_IN ? 1024 : j == W_S5_GLU ? 2048 :
                              j == W_S5_OUT ? 2048 : j == W_RW_IN ? 1024 : j == W_RW_L2 ? 64 : j == W_RW_OUT ? 2048 : j == W_RT_IN ? 1024 : 2048; }

struct Params {
    const float* in[N_IN];
    float* out;
    float* X; float* Z;
    bf16_t* XN; bf16_t* XM;
    float* X2;
    bf16_t* ACT[7];
    bf16_t* L1;
    float* SSP;
    bf16_t* W[N_W];
    unsigned* bar;
};

#define LAS __attribute__((address_space(3)))
typedef float cvt_f32x2 __attribute__((ext_vector_type(2)));
typedef __bf16 cvt_bf16x2 __attribute__((ext_vector_type(2)));
__device__ __forceinline__ unsigned pack2(float a, float b) { const cvt_f32x2 v = {a, b}; const cvt_bf16x2 h = __builtin_convertvector(v, cvt_bf16x2); return __builtin_bit_cast(unsigned, h); }
__device__ __forceinline__ bf16_t f2bf(float f) { return (bf16_t)(pack2(f, f) & 0xffffu); }
__device__ __forceinline__ float bf2f(bf16_t h) { return __uint_as_float(((unsigned)h) << 16); }
__device__ __forceinline__ float bflo(unsigned u) { return __uint_as_float(u << 16); }
__device__ __forceinline__ float bfhi(unsigned u) { return __uint_as_float(u & 0xffff0000u); }
__device__ __forceinline__ float rcpf_(float x) { return __builtin_amdgcn_rcpf(x); }
__device__ __forceinline__ float sigmoidf_(float x) { return rcpf_(1.0f + __expf(-x)); }
__device__ __forceinline__ float siluf_(float x) { return x * rcpf_(1.0f + __expf(-x)); }
__device__ __forceinline__ float tanhf_(float x) { return 1.0f - 2.0f * rcpf_(1.0f + __expf(2.0f * x)); }
__device__ __forceinline__ float softplusf_(float y) { return fmaxf(y, 0.0f) + __logf(1.0f + __expf(-fabsf(y))); }
__device__ __forceinline__ float wave_sum(float v) {
#pragma unroll
    for (int o = 32; o > 0; o >>= 1) v += __shfl_xor(v, o, 64);
    return v;
}
__device__ __forceinline__ void wave_lds_sync() { asm volatile("s_waitcnt lgkmcnt(0)" ::: "memory"); }
__device__ __forceinline__ f32x4 mfma16(bf16x8 a, bf16x8 b, f32x4 c) { return __builtin_amdgcn_mfma_f32_16x16x32_bf16(a, b, c, 0, 0, 0); }
__device__ __forceinline__ int opaque_tid() { int t = threadIdx.x; asm volatile("" : "+v"(t)); return t; }
__device__ __forceinline__ uint2 pack4(f32x4 v) { uint2 r; r.x = pack2(v[0], v[1]); r.y = pack2(v[2], v[3]); return r; }

__device__ __forceinline__ void phase_norm(const Params& p, int mode, int layer, const float* Xs, float* Xd) {
    const int lane = opaque_tid() & 63, wave = opaque_tid() >> 6;
    const int gw = blockIdx.x * 8 + wave, nw = gridDim.x * 8;
    for (int r = gw; r < R; r += nw) {
        const bool prompt = r < RP;
        const int b = prompt ? r / SEQT : (r - RP) / DSEQ;
        const int t = prompt ? r % SEQT : (r - RP) % DSEQ;
        float4 x[4];
        if (mode == 0) {
            const float* src = prompt ? (t < 16 ? p.in[I_META] + (size_t)t * D : p.in[I_XP] + ((size_t)b * 2048 + (t - 16)) * D)
                                      : p.in[I_XS] + (size_t)(r - RP) * D;
#pragma unroll
            for (int k = 0; k < 4; ++k) x[k] = *(const float4*)(src + k * 256 + lane * 4);
        } else {
            float4 z[4]; float ss = 0.f;
#pragma unroll
            for (int k = 0; k < 4; ++k) {
                x[k] = *(const float4*)(Xs + (size_t)r * D + k * 256 + lane * 4);
                z[k] = *(const float4*)(p.Z + (size_t)r * D + k * 256 + lane * 4);
                ss += z[k].x * z[k].x + z[k].y * z[k].y + z[k].z * z[k].z + z[k].w * z[k].w;
            }
            ss = wave_sum(ss);
            const float rs = rsqrtf(ss * (1.0f / D) + EPS);
            const float* gp = p.in[I_NPOST] + (size_t)(layer - 1) * D;
#pragma unroll
            for (int k = 0; k < 4; ++k) {
                const float4 g = *(const float4*)(gp + k * 256 + lane * 4);
                x[k].x += z[k].x * rs * g.x; x[k].y += z[k].y * rs * g.y; x[k].z += z[k].z * rs * g.z; x[k].w += z[k].w * rs * g.w;
            }
        }
        if (mode == 3) {
            if (prompt) {
                if (t >= 16) {
                    float* dst = p.out + O_YP + ((size_t)b * 2048 + (t - 16)) * D;
#pragma unroll
                    for (int k = 0; k < 4; ++k) *(float4*)(dst + k * 256 + lane * 4) = x[k];
                }
            } else {
                float* dst = p.out + O_YS + (size_t)(r - RP) * D;
#pragma unroll
                for (int k = 0; k < 4; ++k) *(float4*)(dst + k * 256 + lane * 4) = x[k];
            }
            continue;
        }
        float ss2 = 0.f;
#pragma unroll
        for (int k = 0; k < 4; ++k) {
            *(float4*)(Xd + (size_t)r * D + k * 256 + lane * 4) = x[k];
            ss2 += x[k].x * x[k].x + x[k].y * x[k].y + x[k].z * x[k].z + x[k].w * x[k].w;
        }
        ss2 = wave_sum(ss2);
        const float rs2 = rsqrtf(ss2 * (1.0f / D) + EPS);
        const float* gq = p.in[I_NPRE] + (size_t)layer * D;
#pragma unroll
        for (int k = 0; k < 4; ++k) {
            const float4 g = *(const float4*)(gq + k * 256 + lane * 4);
            uint2 pk; pk.x = pack2(x[k].x * rs2 * g.x, x[k].y * rs2 * g.y); pk.y = pack2(x[k].z * rs2 * g.z, x[k].w * rs2 * g.w);
            *(uint2*)(p.XN + (size_t)r * D + k * 256 + lane * 4) = pk;
        }
    }
}
__device__ __forceinline__ void phase_norm_rwkv(const Params& p, const float* Xs, float* Xd) {
    const int lane = opaque_tid() & 63, wave = opaque_tid() >> 6;
    const int gw = blockIdx.x * 8 + wave, nw = gridDim.x * 8;
    const float* gp = p.in[I_NPOST] + (size_t)1 * D;
    const float* gq = p.in[I_NPRE] + (size_t)2 * D;
    for (int r0 = gw * 9; r0 < R; r0 += nw * 9) {
    float4 prev[4];
#pragma unroll
    for (int k = 0; k < 4; ++k) prev[k] = make_float4(0.f, 0.f, 0.f, 0.f);
    for (int rr = -1; rr < 9; ++rr) {
        const int r = r0 + rr;
        if (r < 0 || r >= R) continue;
        const bool prompt = r < RP;
        const int b = prompt ? r / SEQT : (r - RP) / DSEQ;
        const int t = prompt ? r % SEQT : (r - RP) % DSEQ;
        const int tlast = prompt ? SEQT - 1 : DSEQ - 1;
        if (rr < 0 && t == tlast) continue;
        float4 x[4], z[4]; float ss = 0.f;
#pragma unroll
        for (int k = 0; k < 4; ++k) {
            x[k] = *(const float4*)(Xs + (size_t)r * D + k * 256 + lane * 4);
            z[k] = *(const float4*)(p.Z + (size_t)r * D + k * 256 + lane * 4);
            ss += z[k].x * z[k].x + z[k].y * z[k].y + z[k].z * z[k].z + z[k].w * z[k].w;
        }
        ss = wave_sum(ss);
        const float rs = rsqrtf(ss * (1.0f / D) + EPS);
        float ss2 = 0.f;
#pragma unroll
        for (int k = 0; k < 4; ++k) {
            const float4 g = *(const float4*)(gp + k * 256 + lane * 4);
            x[k].x += z[k].x * rs * g.x; x[k].y += z[k].y * rs * g.y; x[k].z += z[k].z * rs * g.z; x[k].w += z[k].w * rs * g.w;
            ss2 += x[k].x * x[k].x + x[k].y * x[k].y + x[k].z * x[k].z + x[k].w * x[k].w;
        }
        ss2 = wave_sum(ss2);
        const float rs2 = rsqrtf(ss2 * (1.0f / D) + EPS);
        float4 xn[4];
#pragma unroll
        for (int k = 0; k < 4; ++k) {
            const float4 g = *(const float4*)(gq + k * 256 + lane * 4);
            xn[k].x = x[k].x * rs2 * g.x; xn[k].y = x[k].y * rs2 * g.y; xn[k].z = x[k].z * rs2 * g.z; xn[k].w = x[k].w * rs2 * g.w;
        }
        if (rr >= 0) {
            if (t == 0) {
#pragma unroll
                for (int k = 0; k < 4; ++k) prev[k] = prompt ? make_float4(0.f, 0.f, 0.f, 0.f) : *(const float4*)(p.in[I_ST_RW_SHIFT] + (size_t)b * D + k * 256 + lane * 4);
            }
#pragma unroll
            for (int k = 0; k < 4; ++k) {
                const int c = k * 256 + lane * 4;
                *(float4*)(Xd + (size_t)r * D + c) = x[k];
                if (t == tlast) *(float4*)(p.out + (prompt ? O_P_RW_SHIFT : O_S_RW_SHIFT) + (size_t)b * D + c) = xn[k];
                const float4 dx = make_float4(prev[k].x - xn[k].x, prev[k].y - xn[k].y, prev[k].z - xn[k].z, prev[k].w - xn[k].w);
#pragma unroll
                for (int j = 0; j < 6; ++j) {
                    const int mi = j == 0 ? 0 : j == 1 ? 2 : j == 2 ? 3 : j == 3 ? 5 : j == 4 ? 1 : 4;
                    const float4 m = *(const float4*)(p.in[I_RW_MU] + mi * D + c);
                    uint2 pk; pk.x = pack2(xn[k].x + dx.x * m.x, xn[k].y + dx.y * m.y); pk.y = pack2(xn[k].z + dx.z * m.z, xn[k].w + dx.w * m.w);
                    *(uint2*)(p.XM + ((size_t)j * RPAD + r) * D + c) = pk;
                }
            }
        }
#pragma unroll
        for (int k = 0; k < 4; ++k) prev[k] = xn[k];
    }
    }
}

__device__ __forceinline__ const float* wsrc(const Params& p, int job, int nd, int& stride) {
    switch (job) {
    case W_LRU_IN: stride = 4096; return p.in[I_LRU_WIN] + nd;
    case W_LRU_G: {
        const int h = nd >> 8, q = (nd >> 7) & 1, pp = nd & 127, wn = pp >> 6, part = (pp >> 5) & 1, chl = wn * 32 + (pp & 31);
        stride = 128; return (part ? p.in[I_LRU_WX] : p.in[I_LRU_WA]) + (size_t)h * 128 * 128 + q * 64 + chl;
    }
    case W_LRU_OUT: stride = 1024; return p.in[I_LRU_WOUT] + nd;
    case W_S5_IN: stride = 4096; return p.in[I_S5_WIN] + nd;
    case W_S5_GLU: stride = 2048; return p.in[I_S5_GLUW] + nd;
    case W_S5_OUT: stride = 1024; return p.in[I_S5_WOUT] + nd;
    case W_RW_IN: {
        if (nd < 8192) { stride = 2048; const int w = nd >> 11; const float* s = w == 0 ? p.in[I_RW_WR] : w == 1 ? p.in[I_RW_WK] : w == 2 ? p.in[I_RW_WV] : p.in[I_RW_WG]; return s + (nd & 2047); }
        stride = 64;
        if (nd < 8448) { const int c = nd - 8192; return c < 64 ? p.in[I_RW_W1] + c : nullptr; }
        const int c = nd - 8448; return c < 64 ? p.in[I_RW_A1] + c : nullptr;
    }
    case W_RW_L2: stride = 2048; return nd < 2048 ? p.in[I_RW_W2] + nd : p.in[I_RW_A2] + (nd - 2048);
    case W_RW_OUT: stride = 1024; return p.in[I_RW_WO] + nd;
    case W_RT_IN: {
        if (nd < 2048) {
            stride = 1024; return (nd < 1024 ? p.in[I_RT_WQ] : p.in[I_RT_WK]) + (nd & 1023);
        }
        stride = 2048; return nd < 4096 ? p.in[I_RT_WV] + (nd - 2048) : p.in[I_RT_WG] + (nd - 4096);
    }
    default: stride = 1024; return p.in[I_RT_WO] + nd;
    }
}

__device__ __forceinline__ void phase_prep(const Params& p, char* smem) {
    float* tile = (float*)smem;
    const int tid = opaque_tid();
    int total = 0;
#pragma unroll
    for (int j = 0; j < N_W; ++j) total += (w_rows(j) / 64) * (w_k(j) / 64);
    for (int ti = blockIdx.x; ti < total; ti += gridDim.x) {
        int job = 0, rem = ti;
#pragma unroll
        for (int j = 0; j < N_W; ++j) { const int n = (w_rows(j) / 64) * (w_k(j) / 64); if (job == j && rem >= n) { rem -= n; job = j + 1; } }
        int K = 0;
#pragma unroll
        for (int j = 0; j < N_W; ++j) if (job == j) K = w_k(j);
        const int kt = K / 64, nt0 = rem / kt, kt0 = rem % kt;
        const int n0 = nt0 * 64, k0 = kt0 * 64;
        {
            const int nc = (tid & 15) * 4; int stride;
            const float* s = wsrc(p, job, n0 + nc, stride);
#pragma unroll
            for (int ps = 0; ps < 2; ++ps) {
                const int kr = (tid >> 4) + ps * 32;
                float4 v = make_float4(0.f, 0.f, 0.f, 0.f);
                if (s) v = *(const float4*)(s + (size_t)(k0 + kr) * stride);
                tile[kr * 65 + nc + 0] = v.x; tile[kr * 65 + nc + 1] = v.y; tile[kr * 65 + nc + 2] = v.z; tile[kr * 65 + nc + 3] = v.w;
            }
        }
        __syncthreads();
        {
            const int n = tid >> 3, kc = (tid & 7) * 8;
            uint4 o;
            o.x = pack2(tile[(kc + 0) * 65 + n], tile[(kc + 1) * 65 + n]);
            o.y = pack2(tile[(kc + 2) * 65 + n], tile[(kc + 3) * 65 + n]);
            o.z = pack2(tile[(kc + 4) * 65 + n], tile[(kc + 5) * 65 + n]);
            o.w = pack2(tile[(kc + 6) * 65 + n], tile[(kc + 7) * 65 + n]);
            *(uint4*)(p.W[job] + (size_t)(n0 + n) * K + k0 + kc) = o;
        }
        __syncthreads();
    }
}

__device__ __forceinline__ int swz(int row, int chunk) { return row * 64 + ((chunk ^ (row & 7)) << 3); }

template <class AL, class EP>
__device__ __forceinline__ void gemm_tile(char* smem, AL& al, const bf16_t* __restrict__ Bt, int ldb, int K, EP& ep) {
    bf16_t* As = (bf16_t*)smem;
    bf16_t* Bs = As + 2 * 128 * 64;
    const int tid = opaque_tid(), lane = tid & 63, wave = tid >> 6, wm = wave >> 2, wn = wave & 3, l15 = lane & 15, quad = lane >> 4;
    f32x4 acc[4][4];
#pragma unroll
    for (int i = 0; i < 4; ++i)
#pragma unroll
        for (int j = 0; j < 4; ++j) acc[i][j] = (f32x4){0.f, 0.f, 0.f, 0.f};
    uint4 ra[2], rb[4];
    const int lrow = tid >> 3, lch = tid & 7;
    const int nk = K >> 6;
#pragma unroll
    for (int it = 0; it < 2; ++it) ra[it] = al.load(it, lrow + it * 64, lch * 8);
#pragma unroll
    for (int it = 0; it < 4; ++it) rb[it] = *(const uint4*)(Bt + (size_t)(lrow + it * 64) * ldb + lch * 8);
#pragma unroll
    for (int it = 0; it < 2; ++it) *(uint4*)(As + swz(lrow + it * 64, lch)) = ra[it];
#pragma unroll
    for (int it = 0; it < 4; ++it) *(uint4*)(Bs + swz(lrow + it * 64, lch)) = rb[it];
    __syncthreads();
    for (int kt = 0; kt < nk; ++kt) {
        const int cur = kt & 1;
        const bool more = kt + 1 < nk;
        if (more) {
            const int k0 = (kt + 1) << 6;
#pragma unroll
            for (int it = 0; it < 2; ++it) ra[it] = al.load(it, lrow + it * 64, k0 + lch * 8);
#pragma unroll
            for (int it = 0; it < 4; ++it) rb[it] = *(const uint4*)(Bt + (size_t)(lrow + it * 64) * ldb + k0 + lch * 8);
        }
        const bf16_t* Ac = As + cur * 128 * 64;
        const bf16_t* Bc = Bs + cur * 256 * 64;
#pragma unroll
        for (int kk = 0; kk < 2; ++kk) {
            bf16x8 af[4], bfr[4];
#pragma unroll
            for (int i = 0; i < 4; ++i) af[i] = *(const bf16x8*)(Ac + swz(wm * 64 + i * 16 + l15, kk * 4 + quad));
#pragma unroll
            for (int j = 0; j < 4; ++j) bfr[j] = *(const bf16x8*)(Bc + swz(wn * 64 + j * 16 + l15, kk * 4 + quad));
#pragma unroll
            for (int i = 0; i < 4; ++i)
#pragma unroll
                for (int j = 0; j < 4; ++j) acc[i][j] = mfma16(bfr[j], af[i], acc[i][j]);
        }
        if (more) {
            bf16_t* An = As + (cur ^ 1) * 128 * 64;
            bf16_t* Bn = Bs + (cur ^ 1) * 256 * 64;
#pragma unroll
            for (int it = 0; it < 2; ++it) *(uint4*)(An + swz(lrow + it * 64, lch)) = ra[it];
#pragma unroll
            for (int it = 0; it < 4; ++it) *(uint4*)(Bn + swz(lrow + it * 64, lch)) = rb[it];
        }
        __syncthreads();
    }
    ep(acc, wm * 64 + l15, wn * 64 + quad * 4);
}

struct ALPlain {
    const bf16_t* A; int lda;
    __device__ __forceinline__ uint4 load(int, int row, int k) const { return *(const uint4*)(A + (size_t)row * lda + k); }
};
struct ALRet {
    const bf16_t* y; const bf16_t* g; const float* ssp;
    float sc[2];
    __device__ __forceinline__ uint4 load(int it, int row, int k) {
        if ((k & 511) < 64) {
            const float* s = ssp + (size_t)row * 64 + (k >> 9) * 16;
            const float4 a = *(const float4*)s, b = *(const float4*)(s + 4), c = *(const float4*)(s + 8), d = *(const float4*)(s + 12);
            const float tot = a.x + a.y + a.z + a.w + b.x + b.y + b.z + b.w + c.x + c.y + c.z + c.w + d.x + d.y + d.z + d.w;
            sc[it] = rsqrtf(tot * (1.0f / 512.0f) + EPS);
        }
        const float f = sc[it];
        const uint4 a = *(const uint4*)(y + (size_t)row * E + k);
        const uint4 gg = *(const uint4*)(g + (size_t)row * E + k);
        uint4 o;
        o.x = pack2(bflo(a.x) * f * bflo(gg.x), bfhi(a.x) * f * bfhi(gg.x));
        o.y = pack2(bflo(a.y) * f * bflo(gg.y), bfhi(a.y) * f * bfhi(gg.y));
        o.z = pack2(bflo(a.z) * f * bflo(gg.z), bfhi(a.z) * f * bfhi(gg.z));
        o.w = pack2(bflo(a.w) * f * bflo(gg.w), bfhi(a.w) * f * bfhi(gg.w));
        return o;
    }
};

struct OpZ {
    float* Z;
    __device__ __forceinline__ int row_ctx(int) const { return 0; }
    __device__ __forceinline__ void operator()(int row, int col, f32x4 v, int) const { *(f32x4*)(Z + (size_t)row * D + col) = v; }
    __device__ __forceinline__ void call8(int row, int col, f32x4 a, f32x4 b, int c) const { (*this)(row, col, a, c); (*this)(row, col + 4, b, c); }
};
struct OpInProj {
    bf16_t* U; bf16_t* SG; float* out; bool lru;
    __device__ __forceinline__ float* row_ctx(int row) const {
        if (!lru || row >= R) return nullptr;
        const bool prompt = row < RP;
        const int b = prompt ? row / SEQT : (row - RP) / DSEQ;
        const int t = prompt ? row % SEQT : (row - RP) % DSEQ;
        const int tl = t - (prompt ? SEQT - 3 : DSEQ - 3);
        return tl >= 0 ? out + (prompt ? O_P_LRU_CONV : O_S_LRU_CONV) + ((size_t)b * 3 + tl) * E : nullptr;
    }
    __device__ __forceinline__ void call8(int row, int col, f32x4 a, f32x4 b, float* crow) const {
        if (col >= E) {
#pragma unroll
            for (int e = 0; e < 4; ++e) { a[e] = siluf_(a[e]); b[e] = siluf_(b[e]); }
            const uint2 lo = pack4(a), hi = pack4(b);
            *(uint4*)(SG + (size_t)row * E + col - E) = make_uint4(lo.x, lo.y, hi.x, hi.y);
        } else {
            const uint2 lo = pack4(a), hi = pack4(b);
            *(uint4*)(U + (size_t)row * E + col) = make_uint4(lo.x, lo.y, hi.x, hi.y);
            if (crow) { *(f32x4*)(crow + col) = a; *(f32x4*)(crow + col + 4) = b; }
        }
    }
    __device__ __forceinline__ void operator()(int row, int col, f32x4 v, float* crow) const {
        if (col >= E) {
            v[0] = siluf_(v[0]); v[1] = siluf_(v[1]); v[2] = siluf_(v[2]); v[3] = siluf_(v[3]);
            *(uint2*)(SG + (size_t)row * E + col - E) = pack4(v);
        } else {
            *(uint2*)(U + (size_t)row * E + col) = pack4(v);
            if (crow) *(f32x4*)(crow + col) = v;
        }
    }
};
struct OpGlu {
    const bf16_t* Y1; const bf16_t* SG; bf16_t* Y2; const float* bias;
    __device__ __forceinline__ void call8(int row, int col, f32x4 a, f32x4 b, int c) const { (*this)(row, col, a, c); (*this)(row, col + 4, b, c); }
    __device__ __forceinline__ int row_ctx(int) const { return 0; }
    __device__ __forceinline__ void operator()(int row, int col, f32x4 v, int) const {
        const float4 bb = *(const float4*)(bias + col);
        const size_t o = (size_t)row * E + col;
        const uint2 y1 = *(const uint2*)(Y1 + o), sg = *(const uint2*)(SG + o);
        v[0] = bflo(y1.x) * sigmoidf_(v[0] + bb.x) * bflo(sg.x);
        v[1] = bfhi(y1.x) * sigmoidf_(v[1] + bb.y) * bfhi(sg.x);
        v[2] = bflo(y1.y) * sigmoidf_(v[2] + bb.z) * bflo(sg.y);
        v[3] = bfhi(y1.y) * sigmoidf_(v[3] + bb.w) * bfhi(sg.y);
        *(uint2*)(Y2 + o) = pack4(v);
    }
};
struct OpRwkvIn {
    bf16_t* d0; bf16_t* d1; bf16_t* d2; bf16_t* d3; bf16_t* L1;
    __device__ __forceinline__ void call8(int row, int col, f32x4 a, f32x4 b, int c) const { (*this)(row, col, a, c); (*this)(row, col + 4, b, c); }
    __device__ __forceinline__ int row_ctx(int) const { return 0; }
    __device__ __forceinline__ void operator()(int row, int col, f32x4 v, int) const {
        if (col < 8192) {
            const int reg = col >> 11;
            if (reg == 3) { v[0] = siluf_(v[0]); v[1] = siluf_(v[1]); v[2] = siluf_(v[2]); v[3] = siluf_(v[3]); }
            bf16_t* dst = reg == 0 ? d0 : reg == 1 ? d1 : reg == 2 ? d2 : d3;
            *(uint2*)(dst + (size_t)row * E + (col & 2047)) = pack4(v);
        } else {
            const int cc = col - 8192, part = cc >> 8, c = cc & 255;
            if (c < 64) {
                if (part == 0) { v[0] = tanhf_(v[0]); v[1] = tanhf_(v[1]); v[2] = tanhf_(v[2]); v[3] = tanhf_(v[3]); }
                *(uint2*)(L1 + (size_t)row * 128 + part * 64 + c) = pack4(v);
            }
        }
    }
};
struct OpLora2 {
    bf16_t* DL; bf16_t* AA; const float* w0; const float* a0;
    __device__ __forceinline__ void call8(int row, int col, f32x4 a, f32x4 b, int c) const { (*this)(row, col, a, c); (*this)(row, col + 4, b, c); }
    __device__ __forceinline__ int row_ctx(int) const { return 0; }
    __device__ __forceinline__ void operator()(int row, int col, f32x4 v, int) const {
        const bool isw = col < E; const int c = col & 2047;
        const float4 bb = *(const float4*)((isw ? w0 : a0) + c);
        v[0] += bb.x; v[1] += bb.y; v[2] += bb.z; v[3] += bb.w;
#pragma unroll
        for (int e = 0; e < 4; ++e) v[e] = isw ? __expf(-softplusf_(-v[e]) - 0.5f) : sigmoidf_(v[e]);
        *(uint2*)((isw ? DL : AA) + (size_t)row * E + c) = pack4(v);
    }
};

template <class Op> struct OldEpi {
    Op op; int m0, n0;
    __device__ __forceinline__ void operator()(f32x4 (&acc)[4][4], int r0, int c0) const {
#pragma unroll
        for (int i = 0; i < 4; ++i) {
            const auto ctx = op.row_ctx(m0 + r0 + i * 16);
#pragma unroll
            for (int j = 0; j < 4; ++j) op(m0 + r0 + i * 16, n0 + c0 + j * 16, acc[i][j], ctx);
        }
    }
};

namespace pg8 {
constexpr int BM = 256, BK = 64, HALF = 128, HTB = HALF * BK * 2, STAGE_BYTES = 8 * HTB, NXCD = 8, WGM = 8;
__device__ __forceinline__ int lds_byte(int r, int c) { const int st = (r >> 4) * 2 + (c >> 5), rr = r & 15, cc = c & 31, ob = rr * 64 + cc * 2; return st * 1024 + (ob ^ (((ob >> 9) & 1) << 5)); }
__device__ __forceinline__ void stage_rc(int b, int& Rr, int& C) { const int st = b / 1024, sb = b % 1024, swz = sb ^ (((sb >> 9) & 1) << 5); Rr = (st >> 1) * 16 + swz / 64; C = (st & 1) * 32 + (swz % 64) / 2; }
__device__ __forceinline__ int perm32(int rho) { const int n = rho >> 4, i = rho & 15; return 8 * (i >> 2) + 4 * n + (i & 3); }
struct Unit { int pm, pn; };
struct Gemm { const bf16_t* A; const bf16_t* Bt; int M, N, K; size_t a_sel_bytes; };
__device__ __forceinline__ size_t a_sel(const Gemm& g, int pn) { const int sgrp = pn >> 3; return g.a_sel_bytes * (size_t)((sgrp < 4 ? sgrp : 4) + (pn == 33 ? 1 : 0)); }
struct StaticOrder {
    int nM, nN, nwg, G, c;
    __device__ void init(int M, int N, int G_, int c_) { nM = M / BM; nN = N / BM; nwg = nM * nN; G = G_; c = c_; }
    __device__ bool next(int i, Unit& u) const {
        const long L = (long)i * G + c; if (L >= nwg) return false;
        int wgid = (int)L; { const int q = nwg / NXCD, r = nwg % NXCD, xcd = wgid % NXCD, off = wgid / NXCD; wgid = (xcd < r ? xcd * (q + 1) : r * (q + 1) + (xcd - r) * q) + off; }
        const int nig = WGM * nN, gid = wgid / nig, fm = gid * WGM, gsz = (nM - fm) < WGM ? (nM - fm) : WGM;
        u.pm = fm + ((wgid % nig) % gsz); u.pn = (wgid % nig) / gsz; return true;
    }
};
template <class Epi>
__device__ __forceinline__ void gemm_phase(LAS unsigned char* lds, const Gemm g, const StaticOrder& S, const Epi& Ep) {
    const int tid = opaque_tid(), wid = __builtin_amdgcn_readfirstlane(tid >> 6), lane = tid & 63, wr = wid >> 2, wc = wid & 3, fr = lane & 15, fq = lane >> 4;
    const int K = g.K, nt = K / BK;
    unsigned voffA[2], voffB[2];
#pragma unroll
    for (int i = 0; i < 2; ++i) { int Rr, C; stage_rc(tid * 16 + i * 8192, Rr, C); const int Rb = Epi::PERM ? ((Rr & ~31) + perm32(Rr & 31)) : Rr;
        voffA[i] = (unsigned)(Rr * K + C) * 2u; voffB[i] = (unsigned)(Rb * K + C) * 2u; }
    const size_t kstep = (size_t)(BK * 2);
    const size_t hstep = (size_t)HALF * K * 2;
    const size_t tstep = 2 * hstep;
    const unsigned ldsw = (unsigned)wid * 1024u;
    const int aoff = lds_byte(wr * 64 + fr, fq * 8), boff = lds_byte(wc * 32 + fr, fq * 8);
#define PG8_SA(b, h) (((b) * 2 + (h)) * HTB)
#define PG8_SB(b, h) ((4 + (b) * 2 + (h)) * HTB)
#define PG8_STAGE(bufoff, gbase, voff) do { _Pragma("unroll") for (int _i = 0; _i < 2; ++_i) \
        __builtin_amdgcn_global_load_lds((const unsigned*)((const char*)(gbase) + (voff)[_i]), (LAS unsigned*)(lds + (bufoff) + ldsw + _i * 8192), 16, 0, 0); } while (0)
#define PG8_LDA(dst, b, h) do { _Pragma("unroll") for (int m = 0; m < 4; ++m) _Pragma("unroll") for (int k = 0; k < 2; ++k) dst[m][k] = *(const LAS bf16x8*)(lds + PG8_SA(b, h) + aoff + m * 2048 + k * 1024); } while (0)
#define PG8_LDB(dst, b, h) do { _Pragma("unroll") for (int n = 0; n < 2; ++n) _Pragma("unroll") for (int k = 0; k < 2; ++k) dst[n][k] = *(const LAS bf16x8*)(lds + PG8_SB(b, h) + boff + n * 2048 + k * 1024); } while (0)
#define PG8_MMA(ai, bj, At, Bt) do { __builtin_amdgcn_s_setprio(1); _Pragma("unroll") for (int m = 0; m < 4; ++m) _Pragma("unroll") for (int n = 0; n < 2; ++n) _Pragma("unroll") for (int k = 0; k < 2; ++k) \
        acc[ai][bj][m][n] = __builtin_amdgcn_mfma_f32_16x16x32_bf16(Bt[n][k], At[m][k], acc[ai][bj][m][n], 0, 0, 0); __builtin_amdgcn_s_setprio(0); } while (0)
#define PG8_WAIT_V(n) asm volatile("s_waitcnt vmcnt(" #n ")" ::: "memory")
#define PG8_WAIT_L(n) asm volatile("s_waitcnt lgkmcnt(" #n ")" ::: "memory")
#define PG8_BAR __builtin_amdgcn_s_barrier()
#define PG8_SCHED __builtin_amdgcn_sched_barrier(0)
    Unit cur, nxt; int ui = 0;
    if (!S.next(0, cur)) return;
    f32x4 acc[2][2][4][2];
#pragma unroll
    for (int a = 0; a < 2; ++a)
#pragma unroll
        for (int b = 0; b < 2; ++b)
#pragma unroll
            for (int m = 0; m < 4; ++m)
#pragma unroll
                for (int n = 0; n < 2; ++n) acc[a][b][m][n] = (f32x4){0.f, 0.f, 0.f, 0.f};
    bf16x8 At[4][2], B0[2][2], B1[2][2];
    const char* cA = (const char*)g.A + a_sel(g, cur.pn) + (size_t)cur.pm * tstep; const char* cB = (const char*)g.Bt + (size_t)cur.pn * tstep;
    PG8_STAGE(PG8_SB(0, 0), cB, voffB); PG8_STAGE(PG8_SA(0, 0), cA, voffA); PG8_STAGE(PG8_SB(0, 1), cB + hstep, voffB); PG8_STAGE(PG8_SA(0, 1), cA + hstep, voffA);
    if (wr == 1) PG8_BAR;
    PG8_WAIT_V(4); PG8_BAR;
    PG8_STAGE(PG8_SB(1, 0), cB + kstep, voffB); PG8_STAGE(PG8_SA(1, 0), cA + kstep, voffA); PG8_STAGE(PG8_SB(1, 1), cB + hstep + kstep, voffB);
    PG8_WAIT_V(6); PG8_BAR;
    for (;;) {
        const bool has_next = S.next(ui + 1, nxt);
        const char* nA = has_next ? (const char*)g.A + a_sel(g, nxt.pn) + (size_t)nxt.pm * tstep : cA; const char* nB = has_next ? (const char*)g.Bt + (size_t)nxt.pn * tstep : cB;
        for (int t = 0; t < nt; t += 2) {
            const bool last = (t == nt - 2);
            const char* a1 = cA + (size_t)(t + 1) * kstep;
            const char* a2 = last ? nA : cA + (size_t)(t + 2) * kstep; const char* b2 = last ? nB : cB + (size_t)(t + 2) * kstep;
            const char* a3 = a2 + kstep; const char* b3 = b2 + kstep;
            PG8_LDB(B0, 0, 0); PG8_SCHED; PG8_LDA(At, 0, 0); PG8_STAGE(PG8_SA(1, 1), a1 + hstep, voffA);
            PG8_WAIT_L(8); PG8_BAR; PG8_WAIT_L(0); PG8_MMA(0, 0, At, B0); PG8_BAR; PG8_SCHED;
            PG8_LDB(B1, 0, 1); PG8_STAGE(PG8_SB(0, 0), b2, voffB);
            PG8_BAR; PG8_WAIT_L(0); PG8_MMA(0, 1, At, B1); PG8_BAR;
            PG8_LDA(At, 0, 1); PG8_STAGE(PG8_SA(0, 0), a2, voffA);
            PG8_BAR; PG8_WAIT_L(0); PG8_MMA(1, 0, At, B0); PG8_BAR; PG8_SCHED;
            PG8_STAGE(PG8_SB(0, 1), b2 + hstep, voffB);
            PG8_WAIT_V(6); PG8_BAR; PG8_MMA(1, 1, At, B1); PG8_BAR;
            PG8_LDB(B0, 1, 0); PG8_SCHED; PG8_LDA(At, 1, 0); PG8_STAGE(PG8_SA(0, 1), a2 + hstep, voffA);
            PG8_WAIT_L(8); PG8_BAR; PG8_WAIT_L(0); PG8_MMA(0, 0, At, B0); PG8_BAR; PG8_SCHED;
            PG8_LDB(B1, 1, 1); PG8_STAGE(PG8_SB(1, 0), b3, voffB);
            PG8_BAR; PG8_WAIT_L(0); PG8_MMA(0, 1, At, B1); PG8_BAR;
            PG8_LDA(At, 1, 1); PG8_STAGE(PG8_SA(1, 0), a3, voffA);
            PG8_BAR; PG8_WAIT_L(0); PG8_MMA(1, 0, At, B0); PG8_BAR; PG8_SCHED;
            PG8_STAGE(PG8_SB(1, 1), b3 + hstep, voffB);
            PG8_WAIT_V(6); PG8_BAR; PG8_MMA(1, 1, At, B1); PG8_BAR;
            if constexpr (Epi::HEAD_RESCALE) {
                if ((t & 7) == 6 && !last) {
                    const LAS float* sc = (const LAS float*)(lds + 131072) + (ui & 1) * 1024 + (t >> 3);
#pragma unroll
                    for (int ai = 0; ai < 2; ++ai)
#pragma unroll
                        for (int m = 0; m < 4; ++m) {
                            const int r = ai * 128 + wr * 64 + m * 16 + fr;
                            const float ratio = sc[r * 4] * __builtin_amdgcn_rcpf(sc[r * 4 + 1]);
#pragma unroll
                            for (int bj = 0; bj < 2; ++bj)
#pragma unroll
                                for (int n = 0; n < 2; ++n) acc[ai][bj][m][n] *= ratio;
                        }
                }
            }
        }
        if constexpr (Epi::HEAD_RESCALE) Ep.call_ui(acc, cur, ui, wr, wc, fr, fq, lds);
        else Ep(acc, cur, wr, wc, fr, fq);
        if (!has_next) break;
#pragma unroll
        for (int a = 0; a < 2; ++a)
#pragma unroll
            for (int b = 0; b < 2; ++b)
#pragma unroll
                for (int m = 0; m < 4; ++m)
#pragma unroll
                    for (int n = 0; n < 2; ++n) acc[a][b][m][n] = (f32x4){0.f, 0.f, 0.f, 0.f};
        cur = nxt; cA = nA; cB = nB; ++ui;
    }
    PG8_WAIT_V(0);
    if (wr == 0) PG8_BAR;
    PG8_BAR;
#undef PG8_SA
#undef PG8_SB
#undef PG8_STAGE
#undef PG8_LDA
#undef PG8_LDB
#undef PG8_MMA
#undef PG8_WAIT_V
#undef PG8_WAIT_L
#undef PG8_BAR
#undef PG8_SCHED
}
}

template <class Op, bool PERM_> struct Pg8Epi {
    static constexpr bool PERM = PERM_, HEAD_RESCALE = false;
    Op op;
    __device__ __forceinline__ void operator()(const f32x4 (&acc)[2][2][4][2], const pg8::Unit& u, int wr, int wc, int fr, int fq) const {
#pragma unroll
        for (int ai = 0; ai < 2; ++ai)
#pragma unroll
            for (int m = 0; m < 4; ++m) {
                const int row = u.pm * 256 + ai * 128 + wr * 64 + m * 16 + fr;
                const auto ctx = op.row_ctx(row);
#pragma unroll
                for (int bj = 0; bj < 2; ++bj) {
                    if (PERM) op.call8(row, u.pn * 256 + bj * 128 + wc * 32 + fq * 8, acc[ai][bj][m][0], acc[ai][bj][m][1], ctx);
                    else {
#pragma unroll
                        for (int n = 0; n < 2; ++n) op(row, u.pn * 256 + bj * 128 + wc * 32 + n * 16 + fq * 4, acc[ai][bj][m][n], ctx);
                    }
                }
            }
    }
};
struct Pg8EpiRetIn {
    static constexpr bool PERM = true, HEAD_RESCALE = false;
    bf16_t* Q; bf16_t* Kk; bf16_t* V; bf16_t* G;
    __device__ __forceinline__ void operator()(const f32x4 (&acc)[2][2][4][2], const pg8::Unit& u, int wr, int wc, int fr, int fq) const {
        const int nt = u.pn;
        float invf[2][4];
#pragma unroll
        for (int n = 0; n < 2; ++n)
#pragma unroll
            for (int e = 0; e < 4; ++e) invf[n][e] = __builtin_amdgcn_exp2f(-(float)(wc * 32 + fq * 8 + n * 4 + e) * (13.287712379549449f / 128.0f)) * 0.15915494309189535f;
#pragma unroll
        for (int ai = 0; ai < 2; ++ai)
#pragma unroll
            for (int m = 0; m < 4; ++m) {
                const int row = u.pm * 256 + ai * 128 + wr * 64 + m * 16 + fr;
                if (nt >= 8) {
#pragma unroll
                    for (int bj = 0; bj < 2; ++bj)
#pragma unroll
                        for (int n = 0; n < 2; ++n) {
                            f32x4 v = acc[ai][bj][m][n];
                            if (nt >= 16) { v[0] = siluf_(v[0]); v[1] = siluf_(v[1]); v[2] = siluf_(v[2]); v[3] = siluf_(v[3]); }
                            *(uint2*)((nt >= 16 ? G : V) + (size_t)row * E + (nt & 7) * 256 + bj * 128 + wc * 32 + fq * 8 + n * 4) = pack4(v);
                        }
                } else {
                    const int h = nt & 3;
                    const float scl = nt >= 4 ? 0.0625f : 1.0f;
                    bf16_t* dst = nt >= 4 ? Kk : Q;
                    const float pos = (float)(row < RP ? row % SEQT : 16384 + (row - RP) % DSEQ);
#pragma unroll
                    for (int n = 0; n < 2; ++n) {
                        const int d1 = wc * 32 + fq * 8 + n * 4;
                        f32x4 o1, o2;
#pragma unroll
                        for (int e = 0; e < 4; ++e) {
                            const float rev = __builtin_amdgcn_fractf(pos * invf[n][e]);
                            const float sn = __builtin_amdgcn_sinf(rev), cs = __builtin_amdgcn_cosf(rev);
                            const float x1 = acc[ai][0][m][n][e], x2 = acc[ai][1][m][n][e];
                            o1[e] = (x1 * cs - x2 * sn) * scl; o2[e] = (x2 * cs + x1 * sn) * scl;
                        }
                        *(uint2*)(dst + (size_t)row * D + h * 256 + d1) = pack4(o1);
                        *(uint2*)(dst + (size_t)row * D + h * 256 + 128 + d1) = pack4(o2);
                    }
                }
            }
    }
};

struct Pg8EpiRetOut {
    static constexpr bool PERM = false, HEAD_RESCALE = true;
    float* Z;
    __device__ __forceinline__ void call_ui(const f32x4 (&acc)[2][2][4][2], const pg8::Unit& u, int ui, int wr, int wc, int fr, int fq, LAS unsigned char* lds) const {
        const LAS float* sc = (const LAS float*)(lds + 131072) + (ui & 1) * 1024 + 3;
#pragma unroll
        for (int ai = 0; ai < 2; ++ai)
#pragma unroll
            for (int m = 0; m < 4; ++m) {
                const int r = ai * 128 + wr * 64 + m * 16 + fr;
                const float s3 = sc[r * 4];
                float* rp = Z + (size_t)(u.pm * 256 + r) * D + u.pn * 256 + wc * 32 + fq * 4;
#pragma unroll
                for (int bj = 0; bj < 2; ++bj)
#pragma unroll
                    for (int n = 0; n < 2; ++n) *(f32x4*)(rp + bj * 128 + n * 16) = acc[ai][bj][m][n] * s3;
            }
    }
};
template <class Epi>
__device__ __forceinline__ void run_pg8(char* smem, const bf16_t* A, const bf16_t* Bt, int N, int K, const Epi& ep, size_t a_sel_bytes = 0) {
    const int slot = (int)((volatile LAS unsigned*)(smem + LDS_BYTES - 16))[2];
    pg8::StaticOrder so; so.init(RPAD, N, gridDim.x, slot);
    pg8::Gemm g{A, Bt, RPAD, N, K, a_sel_bytes};
    pg8::gemm_phase((LAS unsigned char*)smem, g, so, ep);
}
__device__ __forceinline__ void phase_gemm_inproj(const Params& p, char* smem, int wj, bool lru) {
    Pg8Epi<OpInProj, true> ep{{p.ACT[0], p.ACT[1], p.out, lru}};
    run_pg8(smem, p.XN, p.W[wj], 4096, D, ep);
}
__device__ __forceinline__ void phase_gemm_out(const Params& p, char* smem, int wj, const bf16_t* Y) {
    Pg8Epi<OpZ, false> ep{{p.Z}};
    run_pg8(smem, Y, p.W[wj], D, E, ep);
}
__device__ __forceinline__ void phase_gemm_glu(const Params& p, char* smem) {
    Pg8Epi<OpGlu, true> ep{{p.ACT[2], p.ACT[1], p.ACT[3], p.in[I_S5_GLUB]}};
    run_pg8(smem, p.ACT[2], p.W[W_S5_GLU], E, E, ep);
}
__device__ __forceinline__ void phase_gemm_rwkv_in(const Params& p, char* smem) {
    Pg8Epi<OpRwkvIn, true> ep{{p.ACT[0], p.ACT[1], p.ACT[2], p.ACT[3], p.L1}};
    run_pg8(smem, p.XM, p.W[W_RW_IN], 8704, D, ep, (size_t)RPAD * D * 2);
}
__device__ __forceinline__ void phase_gemm_lora2(const Params& p, char* smem) {
    for (int tile = blockIdx.x; tile < MT * 16; tile += gridDim.x) {
        const int nt = tile / MT, mt = tile % MT;
        ALPlain al{p.L1 + (size_t)mt * 128 * 128 + (nt < 8 ? 0 : 64), 128};
        OldEpi<OpLora2> ep{{p.ACT[4], p.ACT[5], p.in[I_RW_W0], p.in[I_RW_A0]}, mt * 128, nt * 256};
        gemm_tile(smem, al, p.W[W_RW_L2] + (size_t)nt * 256 * 64, 64, 64, ep);
    }
}
__device__ __forceinline__ void phase_gemm_ret_in(const Params& p, char* smem) {
    Pg8EpiRetIn ep{p.ACT[0], p.ACT[1], p.ACT[2], p.ACT[3]};
    run_pg8(smem, p.XN, p.W[W_RT_IN], 6144, D, ep);
}
__device__ __forceinline__ void phase_gemm_ret_out(const Params& p, char* smem) {
    const int slot = (int)((volatile LAS unsigned*)(smem + LDS_BYTES - 16))[2];
    pg8::StaticOrder so; so.init(RPAD, D, gridDim.x, slot);
    {
        float* sc = (float*)(smem + 131072);
        const int tid = opaque_tid(), r = tid >> 1, h0 = (tid & 1) * 2;
#pragma unroll
        for (int ui = 0; ui < 2; ++ui) {
            pg8::Unit u;
            if (so.next(ui, u)) {
                const int row = u.pm * 256 + r;
#pragma unroll
                for (int hh = 0; hh < 2; ++hh) {
                    float scale = 1.0f;
                    if (row < R) {
                        const float* q = p.SSP + (size_t)row * 64 + (h0 + hh) * 16;
                        const float4 a = *(const float4*)q, b = *(const float4*)(q + 4), c = *(const float4*)(q + 8), d = *(const float4*)(q + 12);
                        const float tot = a.x + a.y + a.z + a.w + b.x + b.y + b.z + b.w + c.x + c.y + c.z + c.w + d.x + d.y + d.z + d.w;
                        scale = rsqrtf(tot * (1.0f / 512.0f) + EPS);
                    }
                    sc[ui * 1024 + r * 4 + h0 + hh] = scale;
                }
            }
        }
    }
    __syncthreads();
    pg8::Gemm g{p.ACT[4], p.W[W_RT_OUT], RPAD, D, E, 0};
    Pg8EpiRetOut ep{p.Z};
    pg8::gemm_phase((LAS unsigned char*)smem, g, so, ep);
}

__device__ __forceinline__ void lru_uload(uint4 (&ubuf)[7], const bf16_t* U, int bg, int c, int rg, int h, int cgp) {
    const int nrows = c < 16 ? 128 : 16;
    const int lr = rg * 4;
#pragma unroll
    for (int jj = 0; jj < 7; ++jj) {
        const int tt = c * 128 + lr - 3 + jj;
        ubuf[jj] = make_uint4(0u, 0u, 0u, 0u);
        if (lr < nrows && tt >= 0) ubuf[jj] = *(const uint4*)(U + (size_t)(bg * SEQT + tt) * E + h * 128 + cgp * 8);
    }
}
__device__ __forceinline__ void phase_lru(const Params& p, char* smem) {
    bf16_t* Al = (bf16_t*)smem;
    bf16_t* Bl = Al + 128 * 136;
    float* SA = (float*)(smem + 2 * 128 * 136 * 2);
    float* SB = SA + 128 * 64;
    float* SEG = SB + 128 * 64;
    float* CAR = SEG + 2 * 8 * 64;
    float* CWL = CAR + 128;
    float* EPL = CWL + 640;
    const int tid = opaque_tid(), lane = tid & 63, wave = tid >> 6, l15 = lane & 15, quad = lane >> 4;
    const int wm = wave >> 1, wn = wave & 1;
    const bf16_t* U = p.ACT[0]; const bf16_t* SG = p.ACT[1]; bf16_t* Y = p.ACT[2];
    for (int item = blockIdx.x; item < 512; item += gridDim.x) {
        const bool sample = item >= 256;
        const int it = item & 255, bg = it >> 5, h = (it >> 1) & 15, q = it & 1;
        const int chbase = h * 128 + q * 64;
#pragma unroll
        for (int i = 0; i < 4; ++i) {
            const int idx = tid + i * 512, row = idx >> 4, ch = idx & 15;
            *(uint4*)(Bl + row * 136 + ch * 8) = *(const uint4*)(p.W[W_LRU_G] + (size_t)(h * 256 + q * 128 + row) * 128 + ch * 8);
        }
        if (tid < 128) {
            CAR[tid] = 0.f;
            const int kch = h * 128 + tid;
#pragma unroll
            for (int j = 0; j < 4; ++j) CWL[j * 128 + tid] = p.in[I_LRU_CW][j * E + kch];
            CWL[4 * 128 + tid] = p.in[I_LRU_CB][kch];
        } else if (tid < 192) {
            const int cl = tid - 128, ch = chbase + cl;
            EPL[cl] = p.in[I_LRU_BA][ch]; EPL[64 + cl] = p.in[I_LRU_BX][ch]; EPL[128 + cl] = softplusf_(-p.in[I_LRU_LAM][ch]);
        }
        const int cgp = tid & 15, rg = tid >> 4;
        const int ntiles = sample ? 1 : 17;
        float hc = 0.f;
        uint4 ubuf[7];
        if (!sample) lru_uload(ubuf, U, bg, 0, rg, h, cgp);
        __syncthreads();
        for (int c = 0; c < ntiles; ++c) {
            const int nrows = sample ? 128 : (c < 16 ? 128 : 16);
#pragma unroll
            for (int ps = 0; ps < 2; ++ps) {
                const int lr = rg * 4 + ps * 2;
                if (lr < nrows) {
                    float uu[5][8];
#pragma unroll
                    for (int jj = 0; jj < 5; ++jj) {
                        uint4 raw = make_uint4(0u, 0u, 0u, 0u); bool have = true; float4 f0 = make_float4(0.f, 0.f, 0.f, 0.f), f1 = f0;
                        if (!sample) {
                            raw = ubuf[ps * 2 + jj];
                        } else {
                            const int sq = lr >> 3, ts = lr & 7, sb = bg * 16 + sq, ee = ts - 3 + jj;
                            if (ee >= 0) { raw = *(const uint4*)(U + (size_t)(RP + sb * 8 + ee) * E + h * 128 + cgp * 8); }
                            else { have = false; const float* s = p.in[I_ST_LRU_CONV] + ((size_t)sb * 3 + (3 + ee)) * E + h * 128 + cgp * 8; f0 = *(const float4*)s; f1 = *(const float4*)(s + 4); }
                        }
                        if (have) { f0.x = bflo(raw.x); f0.y = bfhi(raw.x); f0.z = bflo(raw.y); f0.w = bfhi(raw.y); f1.x = bflo(raw.z); f1.y = bfhi(raw.z); f1.z = bflo(raw.w); f1.w = bfhi(raw.w); }
                        uu[jj][0] = f0.x; uu[jj][1] = f0.y; uu[jj][2] = f0.z; uu[jj][3] = f0.w; uu[jj][4] = f1.x; uu[jj][5] = f1.y; uu[jj][6] = f1.z; uu[jj][7] = f1.w;
                    }
#pragma unroll
                    for (int rr = 0; rr < 2; ++rr) {
                        float xc[8];
#pragma unroll
                        for (int k = 0; k < 8; ++k) {
                            const int kc = cgp * 8 + k;
                            xc[k] = CWL[512 + kc] + CWL[kc] * uu[rr][k] + CWL[128 + kc] * uu[rr + 1][k] + CWL[256 + kc] * uu[rr + 2][k] + CWL[384 + kc] * uu[rr + 3][k];
                        }
                        uint4 o; o.x = pack2(xc[0], xc[1]); o.y = pack2(xc[2], xc[3]); o.z = pack2(xc[4], xc[5]); o.w = pack2(xc[6], xc[7]);
                        *(uint4*)(Al + (lr + rr) * 136 + cgp * 8) = o;
                    }
                } else {
#pragma unroll
                    for (int rr = 0; rr < 2; ++rr) *(uint4*)(Al + (lr + rr) * 136 + cgp * 8) = make_uint4(0u, 0u, 0u, 0u);
                }
            }
            __syncthreads();
            if (!sample && c + 1 < ntiles) lru_uload(ubuf, U, bg, c + 1, rg, h, cgp);
            f32x4 acc[2][4];
#pragma unroll
            for (int i = 0; i < 2; ++i)
#pragma unroll
                for (int j = 0; j < 4; ++j) acc[i][j] = (f32x4){0.f, 0.f, 0.f, 0.f};
#pragma unroll
            for (int kk = 0; kk < 4; ++kk) {
                bf16x8 af[2], bfr[4];
#pragma unroll
                for (int i = 0; i < 2; ++i) af[i] = *(const bf16x8*)(Al + (wm * 32 + i * 16 + l15) * 136 + kk * 32 + quad * 8);
#pragma unroll
                for (int j = 0; j < 4; ++j) bfr[j] = *(const bf16x8*)(Bl + (wn * 64 + j * 16 + l15) * 136 + kk * 32 + quad * 8);
#pragma unroll
                for (int i = 0; i < 2; ++i)
#pragma unroll
                    for (int j = 0; j < 4; ++j) acc[i][j] = mfma16(bfr[j], af[i], acc[i][j]);
            }
#pragma unroll
            for (int i = 0; i < 2; ++i) {
                const int row = wm * 32 + i * 16 + l15;
#pragma unroll
                for (int j = 0; j < 2; ++j) {
                    const int chl = wn * 32 + j * 16 + quad * 4;
                    const uint2 xr = *(const uint2*)(Al + row * 136 + q * 64 + chl);
                    const float xcv[4] = {bflo(xr.x), bfhi(xr.x), bflo(xr.y), bfhi(xr.y)};
                    f32x4 av, bv;
#pragma unroll
                    for (int e = 0; e < 4; ++e) {
                        const float gr = sigmoidf_(acc[i][j][e] + EPL[chl + e]), gi = sigmoidf_(acc[i][j + 2][e] + EPL[64 + chl + e]);
                        const float la = -8.0f * gr * EPL[128 + chl + e];
                        av[e] = __expf(la);
                        bv[e] = __builtin_amdgcn_sqrtf(fmaxf(1.0f - av[e] * av[e], 0.f)) * gi * xcv[e];
                    }
                    *(f32x4*)(SA + row * 64 + chl) = av;
                    *(f32x4*)(SB + row * 64 + chl) = bv;
                }
            }
            __syncthreads();
            const int ch = tid & 63, seg = tid >> 6;
            if (!sample) {
                float P = 1.f, H = 0.f;
#pragma unroll 4
                for (int rr = 0; rr < 16; ++rr) {
                    const int row = seg * 16 + rr;
                    if (row < nrows) { const float a = SA[row * 64 + ch], bx = SB[row * 64 + ch]; H = a * H + bx; P *= a; }
                }
                SEG[seg * 64 + ch] = P; SEG[512 + seg * 64 + ch] = H;
                __syncthreads();
                hc = CAR[(c & 1) * 64 + ch];
                for (int s2 = 0; s2 < seg; ++s2) hc = SEG[s2 * 64 + ch] * hc + SEG[512 + s2 * 64 + ch];
#pragma unroll
                for (int rr = 0; rr < 16; ++rr) {
                    const int row = seg * 16 + rr;
                    if (row < nrows) {
                        const float a = SA[row * 64 + ch], bx = SB[row * 64 + ch];
                        hc = a * hc + bx;
                        const size_t o = (size_t)(bg * SEQT + c * 128 + row) * E + chbase + ch;
                        Y[o] = f2bf(hc * bf2f(SG[o]));
                    }
                }
                if (seg == 7) CAR[((c + 1) & 1) * 64 + ch] = hc;
            } else {
#pragma unroll 1
                for (int sq = 0; sq < 2; ++sq) {
                    const int sb = bg * 16 + seg * 2 + sq;
                    float hh = p.in[I_ST_LRU_H][(size_t)sb * E + chbase + ch];
#pragma unroll 4
                    for (int t = 0; t < 8; ++t) {
                        const int row = seg * 16 + sq * 8 + t;
                        hh = SA[row * 64 + ch] * hh + SB[row * 64 + ch];
                        const size_t o = (size_t)(RP + sb * 8 + t) * E + chbase + ch;
                        Y[o] = f2bf(hh * bf2f(SG[o]));
                    }
                    p.out[O_S_LRU_H + (size_t)sb * E + chbase + ch] = hh;
                }
            }
        }
        if (!sample && (tid >> 6) == 7) p.out[O_P_LRU_H + (size_t)bg * E + chbase + (tid & 63)] = hc;
        __syncthreads();
    }
}

__device__ __forceinline__ void phase_s5(const Params& p, char* smem) {
    const int lane = opaque_tid() & 63, wave = opaque_tid() >> 6, l15 = lane & 15, quad = lane >> 4;
    float* BU = (float*)(smem + wave * 13312);
    bf16_t* XL = (bf16_t*)(smem + wave * 13312 + 8448);
    float* FL = (float*)(smem + wave * 13312 + 8448 + 4352);
    const bf16_t* U = p.ACT[0]; bf16_t* Y1 = p.ACT[2];
    const int slot4 = (wave & 3) * gridDim.x + blockIdx.x, nslots4 = 4 * gridDim.x;
    const int item_lo = wave < 4 ? 0 : 1024, item_hi = wave < 4 ? 1024 : 1024 + 16384;
    for (int item = item_lo + slot4; item < item_hi; item += nslots4) {
        const bool sample = item >= 1024;
        const int it = sample ? item - 1024 : item, b = it >> 7, g = it & 127;
        const int row0 = sample ? RP + b * 8 : b * SEQT, nsteps = sample ? 8 : SEQT;
        const int n = lane;
        const float dt = __expf(p.in[I_S5_LOGDT][g]);
        const float are = p.in[I_S5_ARE][g * 64 + n], aim = p.in[I_S5_AIM][g * 64 + n];
        const float mag = __expf(dt * are), ang = dt * aim;
        const float abr = mag * __cosf(ang), abi = mag * __sinf(ang);
        const float den = are * are + aim * aim;
        FL[n] = ((abr - 1.0f) * are + abi * aim) / den;
        FL[64 + n] = (abi * are - (abr - 1.0f) * aim) / den;
        wave_lds_sync();
        bf16x8 bbf[8];
#pragma unroll
        for (int grp = 0; grp < 4; ++grp) {
            bbf[grp] = (bf16x8){0, 0, 0, 0, 0, 0, 0, 0}; bbf[grp + 4] = bbf[grp];
            if (quad < 2) {
                const int np = grp * 16 + l15;
                const float fr_ = FL[np], fi_ = FL[64 + np];
                const float* br = p.in[I_S5_BRE] + ((size_t)g * 64 + np) * 16 + quad * 8;
                const float* bi = p.in[I_S5_BIM] + ((size_t)g * 64 + np) * 16 + quad * 8;
                const float4 r0 = *(const float4*)br, r1 = *(const float4*)(br + 4), i0 = *(const float4*)bi, i1 = *(const float4*)(bi + 4);
                const float rr[8] = {r0.x, r0.y, r0.z, r0.w, r1.x, r1.y, r1.z, r1.w}, ii[8] = {i0.x, i0.y, i0.z, i0.w, i1.x, i1.y, i1.z, i1.w};
#pragma unroll
                for (int k = 0; k < 8; ++k) { bbf[grp][k] = (short)f2bf(fr_ * rr[k] - fi_ * ii[k]); bbf[grp + 4][k] = (short)f2bf(fr_ * ii[k] + fi_ * rr[k]); }
            }
        }
        bf16x8 cf[4];
#pragma unroll
        for (int kb = 0; kb < 4; ++kb) {
            const float* src = (kb < 2 ? p.in[I_S5_CRE] : p.in[I_S5_CIM]) + ((size_t)g * 16 + l15) * 64 + (kb & 1) * 32 + quad * 8;
            const float sgn = kb < 2 ? 1.0f : -1.0f;
            const float4 c0 = *(const float4*)src, c1 = *(const float4*)(src + 4);
            cf[kb][0] = (short)f2bf(sgn * c0.x); cf[kb][1] = (short)f2bf(sgn * c0.y); cf[kb][2] = (short)f2bf(sgn * c0.z); cf[kb][3] = (short)f2bf(sgn * c0.w);
            cf[kb][4] = (short)f2bf(sgn * c1.x); cf[kb][5] = (short)f2bf(sgn * c1.y); cf[kb][6] = (short)f2bf(sgn * c1.z); cf[kb][7] = (short)f2bf(sgn * c1.w);
        }
        const float4 dd = *(const float4*)(p.in[I_S5_D] + g * 16 + quad * 4);
        float xr = 0.f, xi = 0.f;
        if (sample) { xr = p.in[I_ST_S5_RE][((size_t)b * 128 + g) * 64 + n]; xi = p.in[I_ST_S5_IM][((size_t)b * 128 + g) * 64 + n]; }
        uint4 ufn = make_uint4(0u, 0u, 0u, 0u); uint2 udn = make_uint2(0u, 0u);
        if (l15 < nsteps) {
            if (quad < 2) ufn = *(const uint4*)(U + (size_t)(row0 + l15) * E + g * 16 + quad * 8);
            udn = *(const uint2*)(U + (size_t)(row0 + l15) * E + g * 16 + quad * 4);
        }
        for (int tt = 0; tt < nsteps; tt += 16) {
            const int nv = min(16, nsteps - tt);
            const uint4 ufc = ufn; const uint2 udc = udn;
            ufn = make_uint4(0u, 0u, 0u, 0u); udn = make_uint2(0u, 0u);
            if (tt + 16 + l15 < nsteps) {
                if (quad < 2) ufn = *(const uint4*)(U + (size_t)(row0 + tt + 16 + l15) * E + g * 16 + quad * 8);
                udn = *(const uint2*)(U + (size_t)(row0 + tt + 16 + l15) * E + g * 16 + quad * 4);
            }
            bf16x8 uf;
            uf[0] = (short)(ufc.x & 0xffffu); uf[1] = (short)(ufc.x >> 16); uf[2] = (short)(ufc.y & 0xffffu); uf[3] = (short)(ufc.y >> 16);
            uf[4] = (short)(ufc.z & 0xffffu); uf[5] = (short)(ufc.z >> 16); uf[6] = (short)(ufc.w & 0xffffu); uf[7] = (short)(ufc.w >> 16);
#pragma unroll
            for (int blk = 0; blk < 8; ++blk) {
                const f32x4 r = mfma16(bbf[blk], uf, (f32x4){0.f, 0.f, 0.f, 0.f});
                *(f32x4*)(BU + l15 * 132 + blk * 16 + quad * 4) = r;
            }
            wave_lds_sync();
            float bur[16], bui[16];
#pragma unroll
            for (int t = 0; t < 16; ++t) { bur[t] = BU[t * 132 + n]; bui[t] = BU[t * 132 + 64 + n]; }
#pragma unroll
            for (int t = 0; t < 16; ++t) {
                if (t < nv) {
                    const float nxr = abr * xr - abi * xi + bur[t], nxi = abr * xi + abi * xr + bui[t];
                    xr = nxr; xi = nxi;
                }
                XL[t * 136 + n] = f2bf(xr); XL[t * 136 + 64 + n] = f2bf(xi);
            }
            wave_lds_sync();
            f32x4 acc = (f32x4){0.f, 0.f, 0.f, 0.f};
#pragma unroll
            for (int kb = 0; kb < 4; ++kb) {
                const bf16x8 xf = *(const bf16x8*)(XL + l15 * 136 + kb * 32 + quad * 8);
                acc = mfma16(cf[kb], xf, acc);
            }
            if (l15 < nv) {
                f32x4 y; y[0] = acc[0] + dd.x * bflo(udc.x); y[1] = acc[1] + dd.y * bfhi(udc.x); y[2] = acc[2] + dd.z * bflo(udc.y); y[3] = acc[3] + dd.w * bfhi(udc.y);
#pragma unroll
                for (int e = 0; e < 4; ++e) { const float v = y[e]; y[e] = 0.5f * v * (1.0f + tanhf_(0.7978845608028654f * (v + 0.044715f * v * v * v))); }
                *(uint2*)(Y1 + (size_t)(row0 + tt + l15) * E + g * 16 + quad * 4) = pack4(y);
            }
            wave_lds_sync();
        }
        float* o = p.out + (sample ? O_S_S5_RE : O_P_S5_RE) + ((size_t)b * 128 + g) * 64 + n;
        o[0] = xr;
        o[(sample ? O_S_S5_IM - O_S_S5_RE : O_P_S5_IM - O_P_S5_RE)] = xi;
    }
}

typedef float f32x2 __attribute__((ext_vector_type(2)));
__device__ __forceinline__ float half_sum(float v) {
#pragma unroll
    for (int o = 16; o > 0; o >>= 1) v += __shfl_xor(v, o, 64);
    return v;
}
__device__ __forceinline__ float dpp_sum8(float x) {
    x += __int_as_float(__builtin_amdgcn_mov_dpp(__float_as_int(x), 0xB1, 0xf, 0xf, true));
    x += __int_as_float(__builtin_amdgcn_mov_dpp(__float_as_int(x), 0x4E, 0xf, 0xf, true));
    x += __int_as_float(__builtin_amdgcn_mov_dpp(__float_as_int(x), 0x141, 0xf, 0xf, true));
    return x;
}
struct RwItem { int sample, b, h, row0, nsteps; };
__device__ __forceinline__ RwItem rw_decode(int item) {
    RwItem r; r.sample = item >= 256; const int it = r.sample ? item - 256 : item; r.b = it >> 5; r.h = it & 31;
    r.row0 = r.sample ? RP + r.b * 8 : r.b * SEQT; r.nsteps = r.sample ? 8 : SEQT; return r;
}
constexpr int RW_NIT = 256 + 4096;
struct RwTile { int item, tt, have; };
__device__ __forceinline__ RwTile rw_next(const RwTile& c) {
    RwTile n = c;
    if (!c.have) return n;
    const int nsteps = c.item >= 256 ? 8 : SEQT;
    n.tt = c.tt + 16;
    if (n.tt >= nsteps) { n.item = c.item + gridDim.x; n.tt = 0; n.have = n.item < RW_NIT; }
    return n;
}
struct RwPre { unsigned r2, k2, v2, d2, a2, g2; float2 kkp, kap, rkp, lnw, lnb; size_t o; int valid; };
struct RwEpi { unsigned g2; float2 lnw, lnb; size_t o; int valid; };
__device__ __forceinline__ void rw_load(RwPre& q, const Params& p, const RwTile& tl, int pt, int c2) {
    const RwItem it = rw_decode(tl.have ? tl.item : 0);
    const int chh = it.h * 64 + c2 * 2;
    q.valid = tl.have && (tl.tt + pt) < it.nsteps;
    q.o = (size_t)(it.row0 + tl.tt + pt) * E + chh;
    q.r2 = q.k2 = q.v2 = q.d2 = q.a2 = q.g2 = 0u;
    if (q.valid) {
        q.r2 = *(const unsigned*)(p.ACT[0] + q.o); q.k2 = *(const unsigned*)(p.ACT[1] + q.o); q.v2 = *(const unsigned*)(p.ACT[2] + q.o);
        q.g2 = *(const unsigned*)(p.ACT[3] + q.o); q.d2 = *(const unsigned*)(p.ACT[4] + q.o); q.a2 = *(const unsigned*)(p.ACT[5] + q.o);
    }
    q.kkp = *(const float2*)(p.in[I_RW_KK] + chh); q.kap = *(const float2*)(p.in[I_RW_KA] + chh); q.rkp = *(const float2*)(p.in[I_RW_RK] + chh);
    q.lnw = *(const float2*)(p.in[I_RW_LNW] + chh); q.lnb = *(const float2*)(p.in[I_RW_LNB] + chh);
}
__device__ __forceinline__ float row_sum16(float x) {
    x += __int_as_float(__builtin_amdgcn_mov_dpp(__float_as_int(x), 0xB1, 0xf, 0xf, true));
    x += __int_as_float(__builtin_amdgcn_mov_dpp(__float_as_int(x), 0x4E, 0xf, 0xf, true));
    x += __int_as_float(__builtin_amdgcn_mov_dpp(__float_as_int(x), 0x141, 0xf, 0xf, true));
    x += __int_as_float(__builtin_amdgcn_mov_dpp(__float_as_int(x), 0x140, 0xf, 0xf, true));
    return x;
}
__device__ __forceinline__ float half_sum32(float x) { x = row_sum16(x); return x + __shfl_xor(x, 16, 64); }
__device__ __forceinline__ void rw_store(const RwPre& q, float* VEC, float* VV, float* BON, int pt, int c2) {
    const float r0 = bflo(q.r2), r1 = bfhi(q.r2), k0 = bflo(q.k2), k1 = bfhi(q.k2), a0 = bflo(q.a2), a1 = bfhi(q.a2);
    const float w0 = __expf(-bflo(q.d2)), w1 = __expf(-bfhi(q.d2));
    float kk0 = k0 * q.kkp.x, kk1 = k1 * q.kkp.y;
    const float ss = half_sum32(kk0 * kk0 + kk1 * kk1);
    const float inv = rsqrtf(fmaxf(ss, 1e-24f));
    kk0 *= inv; kk1 *= inv;
    const float km0 = k0 * (1.0f + (a0 - 1.0f) * q.kap.x), km1 = k1 * (1.0f + (a1 - 1.0f) * q.kap.y);
    const float bon = half_sum32(r0 * km0 * q.rkp.x + r1 * km1 * q.rkp.y);
    float* ve = VEC + pt * 320 + c2 * 2;
    *(float2*)(ve) = make_float2(w0, w1);
    *(float2*)(ve + 64) = make_float2(-kk0, -kk1);
    *(float2*)(ve + 128) = make_float2(kk0 * a0, kk1 * a1);
    *(float2*)(ve + 192) = make_float2(km0, km1);
    *(float2*)(ve + 256) = make_float2(r0, r1);
    *(float2*)(VV + pt * 64 + c2 * 2) = make_float2(bflo(q.v2), bfhi(q.v2));
    if (c2 == 0) BON[pt] = bon;
}
__device__ __forceinline__ void rw_epilogue(const RwEpi& e, const Params& p, const float* VV, const float* BON, const float* YL, int pt, int c2) {
    const float2 yy = *(const float2*)(YL + pt * 64 + c2 * 2);
    const float mean = half_sum32(yy.x + yy.y) * (1.0f / 64.0f);
    const float d0 = yy.x - mean, d1 = yy.y - mean;
    const float var = half_sum32(d0 * d0 + d1 * d1) * (1.0f / 64.0f);
    const float rstd = rsqrtf(var + 64e-5f);
    if (e.valid) {
        const float2 v2 = *(const float2*)(VV + pt * 64 + c2 * 2);
        const float bon = BON[pt];
        const float o0 = (d0 * rstd * e.lnw.x + e.lnb.x + bon * v2.x) * bflo(e.g2);
        const float o1 = (d1 * rstd * e.lnw.y + e.lnb.y + bon * v2.y) * bfhi(e.g2);
        *(unsigned*)(p.ACT[6] + e.o) = pack2(o0, o1);
    }
}
__device__ __forceinline__ RwEpi rw_epi_of(const RwPre& q) { RwEpi e; e.g2 = q.g2; e.lnw = q.lnw; e.lnb = q.lnb; e.o = q.o; e.valid = q.valid; return e; }
struct RwVec { f32x4 w[2], a[2], b[2], k[2], r[2]; float2 vv; };
__device__ __forceinline__ void rw_vload(RwVec& q, const float* VEC, const float* VV, int t, int oct, int v0) {
    const float* ve = VEC + t * 320 + oct * 8;
    q.w[0] = *(const f32x4*)ve; q.w[1] = *(const f32x4*)(ve + 4);
    q.a[0] = *(const f32x4*)(ve + 64); q.a[1] = *(const f32x4*)(ve + 68);
    q.b[0] = *(const f32x4*)(ve + 128); q.b[1] = *(const f32x4*)(ve + 132);
    q.k[0] = *(const f32x4*)(ve + 192); q.k[1] = *(const f32x4*)(ve + 196);
    q.r[0] = *(const f32x4*)(ve + 256); q.r[1] = *(const f32x4*)(ve + 260);
    q.vv = *(const float2*)(VV + t * 64 + v0);
}
__device__ __forceinline__ void rw_step(f32x2 (&S)[2][4], const RwVec& q, float* YL, int t, int oct, int v0) {
    const f32x2 a0 = (f32x2){q.a[0][0], q.a[0][1]}, a1 = (f32x2){q.a[0][2], q.a[0][3]}, a2 = (f32x2){q.a[1][0], q.a[1][1]}, a3 = (f32x2){q.a[1][2], q.a[1][3]};
    const f32x2 sp0 = S[0][0] * a0 + S[0][1] * a1 + S[0][2] * a2 + S[0][3] * a3;
    const f32x2 sp1 = S[1][0] * a0 + S[1][1] * a1 + S[1][2] * a2 + S[1][3] * a3;
    const float sa0 = dpp_sum8(sp0[0] + sp0[1]), sa1 = dpp_sum8(sp1[0] + sp1[1]);
    const f32x2 w0 = (f32x2){q.w[0][0], q.w[0][1]}, w1 = (f32x2){q.w[0][2], q.w[0][3]}, w2 = (f32x2){q.w[1][0], q.w[1][1]}, w3 = (f32x2){q.w[1][2], q.w[1][3]};
    const f32x2 b0 = (f32x2){q.b[0][0], q.b[0][1]}, b1 = (f32x2){q.b[0][2], q.b[0][3]}, b2 = (f32x2){q.b[1][0], q.b[1][1]}, b3 = (f32x2){q.b[1][2], q.b[1][3]};
    const f32x2 k0 = (f32x2){q.k[0][0], q.k[0][1]}, k1 = (f32x2){q.k[0][2], q.k[0][3]}, k2 = (f32x2){q.k[1][0], q.k[1][1]}, k3 = (f32x2){q.k[1][2], q.k[1][3]};
    {
        const f32x2 sa2 = (f32x2){sa0, sa0}, vv2 = (f32x2){q.vv.x, q.vv.x};
        S[0][0] = S[0][0] * w0 + sa2 * b0 + vv2 * k0; S[0][1] = S[0][1] * w1 + sa2 * b1 + vv2 * k1;
        S[0][2] = S[0][2] * w2 + sa2 * b2 + vv2 * k2; S[0][3] = S[0][3] * w3 + sa2 * b3 + vv2 * k3;
    }
    {
        const f32x2 sa2 = (f32x2){sa1, sa1}, vv2 = (f32x2){q.vv.y, q.vv.y};
        S[1][0] = S[1][0] * w0 + sa2 * b0 + vv2 * k0; S[1][1] = S[1][1] * w1 + sa2 * b1 + vv2 * k1;
        S[1][2] = S[1][2] * w2 + sa2 * b2 + vv2 * k2; S[1][3] = S[1][3] * w3 + sa2 * b3 + vv2 * k3;
    }
    const f32x2 r0 = (f32x2){q.r[0][0], q.r[0][1]}, r1 = (f32x2){q.r[0][2], q.r[0][3]}, r2 = (f32x2){q.r[1][0], q.r[1][1]}, r3 = (f32x2){q.r[1][2], q.r[1][3]};
    const f32x2 yp0 = S[0][0] * r0 + S[0][1] * r1 + S[0][2] * r2 + S[0][3] * r3;
    const f32x2 yp1 = S[1][0] * r0 + S[1][1] * r1 + S[1][2] * r2 + S[1][3] * r3;
    const float y0 = dpp_sum8(yp0[0] + yp0[1]), y1 = dpp_sum8(yp1[0] + yp1[1]);
    if (oct == 0) *(float2*)(YL + t * 64 + v0) = make_float2(y0, y1);
}
__device__ __forceinline__ void phase_rwkv(const Params& p, char* smem) {
    constexpr int BUF_F = 16 * 5 * 64 + 16 * 64 + 64 + 16 * 64;
    float* base = (float*)smem;
    const int tid = opaque_tid(), lane = tid & 63, wave = tid >> 6;
    const bool scanner = wave < 4;
    const int oct = lane & 7, v0 = (wave & 3) * 16 + (lane >> 3) * 2;
    const int hid = tid & 255, pt0 = hid >> 5, c2 = hid & 31;
    RwTile tk; tk.item = blockIdx.x; tk.tt = 0; tk.have = blockIdx.x < RW_NIT;
    f32x2 S[2][4], Sn[2][4];
#pragma unroll
    for (int r = 0; r < 2; ++r)
#pragma unroll
        for (int i = 0; i < 4; ++i) { S[r][i] = (f32x2){0.f, 0.f}; Sn[r][i] = S[r][i]; }
    RwPre preN[2]; RwEpi epiP[2], epiC[2];
    epiP[0].valid = 0; epiP[1].valid = 0; epiP[0].o = 0; epiP[1].o = 0; epiP[0].g2 = 0; epiP[1].g2 = 0;
    epiP[0].lnw = epiP[0].lnb = epiP[1].lnw = epiP[1].lnb = make_float2(0.f, 0.f);
    epiC[0] = epiP[0]; epiC[1] = epiP[1];
    if (scanner) {
        const RwItem it = rw_decode(tk.have ? tk.item : 0);
        if (tk.have && it.sample) {
#pragma unroll
            for (int r = 0; r < 2; ++r) {
                const float* st = p.in[I_ST_RW_WKV] + (((size_t)it.b * 32 + it.h) * 64 + v0 + r) * 64 + oct * 8;
                const float4 s0 = *(const float4*)st, s1 = *(const float4*)(st + 4);
                Sn[r][0] = (f32x2){s0.x, s0.y}; Sn[r][1] = (f32x2){s0.z, s0.w}; Sn[r][2] = (f32x2){s1.x, s1.y}; Sn[r][3] = (f32x2){s1.z, s1.w};
            }
        }
    } else {
        RwPre pre0[2];
        rw_load(pre0[0], p, tk, pt0, c2); rw_load(pre0[1], p, tk, pt0 + 8, c2);
        const RwTile t1 = rw_next(tk);
        rw_load(preN[0], p, t1, pt0, c2); rw_load(preN[1], p, t1, pt0 + 8, c2);
        rw_store(pre0[0], base, base + 5120, base + 6144, pt0, c2); rw_store(pre0[1], base, base + 5120, base + 6144, pt0 + 8, c2);
        epiC[0] = rw_epi_of(pre0[0]); epiC[1] = rw_epi_of(pre0[1]);
    }
    __syncthreads();
    int kb = 0;
    bool first = true;
    while (tk.have) {
        const RwTile t1 = rw_next(tk);
        const int kn = kb == 2 ? 0 : kb + 1, kp = kb == 0 ? 2 : kb - 1;
        if (scanner) {
            const RwItem cur = rw_decode(tk.item);
            f32x2 Snn[2][4];
#pragma unroll
            for (int r = 0; r < 2; ++r)
#pragma unroll
                for (int i = 0; i < 4; ++i) Snn[r][i] = (f32x2){0.f, 0.f};
            if (t1.have && t1.tt == 0 && t1.item >= 256) {
                const RwItem nx = rw_decode(t1.item);
#pragma unroll
                for (int r = 0; r < 2; ++r) {
                    const float* st = p.in[I_ST_RW_WKV] + (((size_t)nx.b * 32 + nx.h) * 64 + v0 + r) * 64 + oct * 8;
                    const float4 s0 = *(const float4*)st, s1 = *(const float4*)(st + 4);
                    Snn[r][0] = (f32x2){s0.x, s0.y}; Snn[r][1] = (f32x2){s0.z, s0.w}; Snn[r][2] = (f32x2){s1.x, s1.y}; Snn[r][3] = (f32x2){s1.z, s1.w};
                }
            }
            if (tk.tt == 0) {
#pragma unroll
                for (int r = 0; r < 2; ++r)
#pragma unroll
                    for (int i = 0; i < 4; ++i) S[r][i] = Sn[r][i];
            }
            {
                const float* VEC = base + kb * BUF_F; const float* VV = VEC + 5120; float* YL = base + kb * BUF_F + 6144 + 64;
                const int nv = min(16, cur.nsteps - tk.tt);
                RwVec A, B;
                rw_vload(A, VEC, VV, 0, oct, v0);
                for (int t = 0; t < nv; t += 2) {
                    rw_vload(B, VEC, VV, t + 1, oct, v0);
                    rw_step(S, A, YL, t, oct, v0);
                    rw_vload(A, VEC, VV, t + 2, oct, v0);
                    rw_step(S, B, YL, t + 1, oct, v0);
                }
            }
            if (tk.tt + 16 >= cur.nsteps) {
#pragma unroll
                for (int r = 0; r < 2; ++r) {
                    float* dst = p.out + (cur.sample ? O_S_RW_WKV : O_P_RW_WKV) + (((size_t)cur.b * 32 + cur.h) * 64 + v0 + r) * 64 + oct * 8;
                    *(float4*)dst = make_float4(S[r][0][0], S[r][0][1], S[r][1][0], S[r][1][1]);
                    *(float4*)(dst + 4) = make_float4(S[r][2][0], S[r][2][1], S[r][3][0], S[r][3][1]);
                }
            }
            if (t1.tt == 0) {
#pragma unroll
                for (int r = 0; r < 2; ++r)
#pragma unroll
                    for (int i = 0; i < 4; ++i) Sn[r][i] = Snn[r][i];
            }
        } else {
            float* Bn = base + kn * BUF_F;
            rw_store(preN[0], Bn, Bn + 5120, Bn + 6144, pt0, c2); rw_store(preN[1], Bn, Bn + 5120, Bn + 6144, pt0 + 8, c2);
            RwEpi epiN[2]; epiN[0] = rw_epi_of(preN[0]); epiN[1] = rw_epi_of(preN[1]);
            const RwTile t2 = rw_next(t1);
            rw_load(preN[0], p, t2, pt0, c2); rw_load(preN[1], p, t2, pt0 + 8, c2);
            if (!first) {
                const float* Bp = base + kp * BUF_F;
                rw_epilogue(epiP[0], p, Bp + 5120, Bp + 6144, Bp + 6144 + 64, pt0, c2); rw_epilogue(epiP[1], p, Bp + 5120, Bp + 6144, Bp + 6144 + 64, pt0 + 8, c2);
            }
            epiP[0] = epiC[0]; epiP[1] = epiC[1]; epiC[0] = epiN[0]; epiC[1] = epiN[1];
        }
        __syncthreads();
        tk = t1; kb = kn; first = false;
    }
    if (!scanner && !first) {
        const int kp = kb == 0 ? 2 : kb - 1;
        const float* Bp = base + kp * BUF_F;
        rw_epilogue(epiP[0], p, Bp + 5120, Bp + 6144, Bp + 6144 + 64, pt0, c2); rw_epilogue(epiP[1], p, Bp + 5120, Bp + 6144, Bp + 6144 + 64, pt0 + 8, c2);
    }
}

__device__ __forceinline__ void ret_gload(uint4 (&qn)[4], uint4 (&kn)[4], uint4& vn, const bf16_t* Q, const bf16_t* Kg, const bf16_t* V,
                                          int row0, int c0, int nsteps, int h, int s, int tid, int lane, int wave) {
    const int Lv = min(64, nsteps - c0);
#pragma unroll
    for (int i4 = 0; i4 < 4; ++i4) {
        const int idx = tid + i4 * 512, row = idx >> 5, kc = (idx & 31) * 8;
        qn[i4] = make_uint4(0u, 0u, 0u, 0u); kn[i4] = qn[i4];
        if (row < Lv) qn[i4] = *(const uint4*)(Q + (size_t)(row0 + c0 + row) * D + h * 256 + kc);
        if (lane < Lv) kn[i4] = *(const uint4*)(Kg + (size_t)(row0 + c0 + lane) * D + h * 256 + (wave + i4 * 8) * 8);
    }
    vn = make_uint4(0u, 0u, 0u, 0u);
    if (lane < Lv) vn = *(const uint4*)(V + (size_t)(row0 + c0 + lane) * E + h * 512 + s * 64 + wave * 8);
}
__device__ __forceinline__ void phase_ret(const Params& p, char* smem) {
    bf16_t* Ql = (bf16_t*)smem;
    bf16_t* Kl = Ql + 64 * 264;
    bf16_t* VT = Kl + 256 * 72;
    bf16_t* Pl = VT + 64 * 72;
    bf16_t* ST = Pl + 64 * 72;
    const int tid = opaque_tid(), lane = tid & 63, wave = tid >> 6, l15 = lane & 15, quad = lane >> 4;
    const bf16_t* Q = p.ACT[0]; const bf16_t* Kg = p.ACT[1]; const bf16_t* V = p.ACT[2]; bf16_t* Y = p.ACT[4];
    for (int item = blockIdx.x; item < 256 + 4096; item += gridDim.x) {
        const bool sample = item >= 256;
        const int it = sample ? item - 256 : item, b = it >> 5, h = (it >> 3) & 3, s = it & 7;
        const int row0 = sample ? RP + b * 8 : b * SEQT, nsteps = sample ? 8 : SEQT;
        const float lg2 = log2f(1.0f - exp2f(-5.0f - (float)h));
        f32x4 accS[2][4];
        const size_t sbase = (((size_t)b * 4 + h) * 256 + wave * 32 + quad * 4) * 512 + s * 64 + l15;
#pragma unroll
        for (int i = 0; i < 2; ++i)
#pragma unroll
            for (int j = 0; j < 4; ++j) {
                if (sample) {
#pragma unroll
                    for (int e = 0; e < 4; ++e) accS[i][j][e] = p.in[I_ST_RET][sbase + (size_t)(i * 16 + e) * 512 + j * 16];
                } else accS[i][j] = (f32x4){0.f, 0.f, 0.f, 0.f};
            }
#pragma unroll
        for (int i = 0; i < 2; ++i)
#pragma unroll
            for (int j = 0; j < 4; ++j) *(uint2*)(ST + (j * 16 + l15) * 264 + wave * 32 + i * 16 + quad * 4) = pack4(accS[i][j]);
        uint4 qn[4], kn[4], vn;
        ret_gload(qn, kn, vn, Q, Kg, V, row0, 0, nsteps, h, s, tid, lane, wave);
        for (int c0 = 0; c0 < nsteps; c0 += 64) {
            const int Lv = min(64, nsteps - c0);
            uint4 kq[4];
#pragma unroll
            for (int i4 = 0; i4 < 4; ++i4) {
                const int idx = tid + i4 * 512, row = idx >> 5, kc = (idx & 31) * 8;
                kq[i4] = kn[i4];
                *(uint4*)(Ql + row * 264 + kc) = qn[i4];
                *(uint4*)(Kl + lane * 264 + (wave + i4 * 8) * 8) = kq[i4];
            }
            {
                const int row = lane, dvc = wave * 8; const uint4 vv = vn;
                VT[(dvc + 0) * 72 + row] = (bf16_t)(vv.x & 0xffffu); VT[(dvc + 1) * 72 + row] = (bf16_t)(vv.x >> 16);
                VT[(dvc + 2) * 72 + row] = (bf16_t)(vv.y & 0xffffu); VT[(dvc + 3) * 72 + row] = (bf16_t)(vv.y >> 16);
                VT[(dvc + 4) * 72 + row] = (bf16_t)(vv.z & 0xffffu); VT[(dvc + 5) * 72 + row] = (bf16_t)(vv.z >> 16);
                VT[(dvc + 6) * 72 + row] = (bf16_t)(vv.w & 0xffffu); VT[(dvc + 7) * 72 + row] = (bf16_t)(vv.w >> 16);
            }
            __syncthreads();
            if (c0 + 64 < nsteps) ret_gload(qn, kn, vn, Q, Kg, V, row0, c0 + 64, nsteps, h, s, tid, lane, wave);
            {
                const int ti = wave >> 1, t_abs = ti * 16 + l15;
#pragma unroll
                for (int s2 = 0; s2 < 2; ++s2) {
                    const int si = (wave & 1) * 2 + s2;
                    f32x4 acc = (f32x4){0.f, 0.f, 0.f, 0.f};
#pragma unroll
                    for (int kb = 0; kb < 8; ++kb) {
                        const bf16x8 kf = *(const bf16x8*)(Kl + (si * 16 + l15) * 264 + kb * 32 + quad * 8);
                        const bf16x8 qf = *(const bf16x8*)(Ql + (ti * 16 + l15) * 264 + kb * 32 + quad * 8);
                        acc = mfma16(kf, qf, acc);
                    }
                    f32x4 pv;
#pragma unroll
                    for (int e = 0; e < 4; ++e) { const int s_abs = si * 16 + quad * 4 + e; pv[e] = s_abs <= t_abs ? acc[e] * exp2f((float)(t_abs - s_abs) * lg2) : 0.f; }
                    *(uint2*)(Pl + t_abs * 72 + si * 16 + quad * 4) = pack4(pv);
                }
            }
            __syncthreads();
#pragma unroll
            for (int i4 = 0; i4 < 4; ++i4) {
                const int row = lane, kc = (wave + i4 * 8) * 8;
                const float wgt = row < Lv ? exp2f((float)(Lv - 1 - row) * lg2) : 0.f;
                const uint4 kv = kq[i4];
                Kl[(kc + 0) * 72 + row] = f2bf(bflo(kv.x) * wgt); Kl[(kc + 1) * 72 + row] = f2bf(bfhi(kv.x) * wgt);
                Kl[(kc + 2) * 72 + row] = f2bf(bflo(kv.y) * wgt); Kl[(kc + 3) * 72 + row] = f2bf(bfhi(kv.y) * wgt);
                Kl[(kc + 4) * 72 + row] = f2bf(bflo(kv.z) * wgt); Kl[(kc + 5) * 72 + row] = f2bf(bfhi(kv.z) * wgt);
                Kl[(kc + 6) * 72 + row] = f2bf(bflo(kv.w) * wgt); Kl[(kc + 7) * 72 + row] = f2bf(bfhi(kv.w) * wgt);
            }
            __syncthreads();
            {
                const int ti = wave >> 1, t_abs = ti * 16 + l15;
                const float dec = exp2f((float)(t_abs + 1) * lg2);
                float ssq = 0.f;
#pragma unroll
                for (int d2 = 0; d2 < 2; ++d2) {
                    const int dvt = (wave & 1) * 2 + d2;
                    f32x4 a1 = (f32x4){0.f, 0.f, 0.f, 0.f}, a2 = a1;
#pragma unroll
                    for (int kb = 0; kb < 2; ++kb) {
                        const bf16x8 vf = *(const bf16x8*)(VT + (dvt * 16 + l15) * 72 + kb * 32 + quad * 8);
                        const bf16x8 pf = *(const bf16x8*)(Pl + (ti * 16 + l15) * 72 + kb * 32 + quad * 8);
                        a1 = mfma16(vf, pf, a1);
                    }
#pragma unroll
                    for (int kb = 0; kb < 8; ++kb) {
                        const bf16x8 sf = *(const bf16x8*)(ST + (dvt * 16 + l15) * 264 + kb * 32 + quad * 8);
                        const bf16x8 qf = *(const bf16x8*)(Ql + (ti * 16 + l15) * 264 + kb * 32 + quad * 8);
                        a2 = mfma16(sf, qf, a2);
                    }
                    f32x4 yv;
#pragma unroll
                    for (int e = 0; e < 4; ++e) { yv[e] = a1[e] + dec * a2[e]; ssq += yv[e] * yv[e]; }
                    if (t_abs < Lv) {
                        const size_t yo = (size_t)(row0 + c0 + t_abs) * E + h * 512 + s * 64 + dvt * 16 + quad * 4;
                        const uint2 gg = *(const uint2*)(p.ACT[3] + yo);
                        yv[0] *= bflo(gg.x); yv[1] *= bfhi(gg.x); yv[2] *= bflo(gg.y); yv[3] *= bfhi(gg.y);
                        *(uint2*)(Y + yo) = pack4(yv);
                    }
                }
                ssq += __shfl_xor(ssq, 16, 64); ssq += __shfl_xor(ssq, 32, 64);
                if (quad == 0 && t_abs < Lv) p.SSP[(size_t)(row0 + c0 + t_abs) * 64 + h * 16 + s * 2 + (wave & 1)] = ssq;
            }
            {
                const float dL = exp2f((float)Lv * lg2);
#pragma unroll
                for (int i = 0; i < 2; ++i)
#pragma unroll
                    for (int j = 0; j < 4; ++j) accS[i][j] *= dL;
#pragma unroll
                for (int kb = 0; kb < 2; ++kb) {
                    bf16x8 kf[2], vf[4];
#pragma unroll
                    for (int i = 0; i < 2; ++i) kf[i] = *(const bf16x8*)(Kl + (wave * 32 + i * 16 + l15) * 72 + kb * 32 + quad * 8);
#pragma unroll
                    for (int j = 0; j < 4; ++j) vf[j] = *(const bf16x8*)(VT + (j * 16 + l15) * 72 + kb * 32 + quad * 8);
#pragma unroll
                    for (int i = 0; i < 2; ++i)
#pragma unroll
                        for (int j = 0; j < 4; ++j) accS[i][j] = mfma16(kf[i], vf[j], accS[i][j]);
                }
            }
            __syncthreads();
#pragma unroll
            for (int i = 0; i < 2; ++i)
#pragma unroll
                for (int j = 0; j < 4; ++j) *(uint2*)(ST + (j * 16 + l15) * 264 + wave * 32 + i * 16 + quad * 4) = pack4(accS[i][j]);
        }
        float* dst = p.out + (sample ? O_S_RET : O_P_RET);
#pragma unroll
        for (int i = 0; i < 2; ++i)
#pragma unroll
            for (int j = 0; j < 4; ++j)
#pragma unroll
                for (int e = 0; e < 4; ++e) dst[sbase + (size_t)(i * 16 + e) * 512 + j * 16] = accS[i][j][e];
        __syncthreads();
    }
}

#define XB_TMO      128
#define XB_XCNT(j)  (256  + 64 * (j))
#define XB_XSUB(j)  (1280 + 64 * (j))
#define XB_XGEN(j)  (2304 + 64 * (j))
#define XB_TOP      3328
#define XB_TOPGEN   3392
#define XCD_BAR_WORDS 3456
#define XB_SPIN_CAP (1u << 22)
__device__ __forceinline__ unsigned xb_ld(unsigned* p)              { return __hip_atomic_load(p, __ATOMIC_RELAXED, __HIP_MEMORY_SCOPE_AGENT); }
__device__ __forceinline__ unsigned xb_add(unsigned* p, unsigned v) { return __hip_atomic_fetch_add(p, v, __ATOMIC_RELAXED, __HIP_MEMORY_SCOPE_AGENT); }
__device__ __forceinline__ unsigned xb_xcc_id() { return (unsigned)__builtin_amdgcn_s_getreg((3 << 11) | 20) & 0xFu; }
#define XB_SPIN(cond, bar) do { unsigned _sp = 0; while (cond) { __builtin_amdgcn_s_sleep(1); \
    if ((++_sp & 255u) == 0u) { if (xb_ld(&(bar)[XB_TMO])) break; if (_sp > XB_SPIN_CAP) { atomicAdd(&(bar)[XB_TMO], 1u); break; } } } } while (0)
struct XcdBarrier { unsigned* bar; unsigned x; volatile LAS unsigned* st; };
__device__ __forceinline__ XcdBarrier xcd_barrier_post(unsigned* bar, volatile LAS unsigned* st) {
    XcdBarrier b; b.bar = bar; b.x = xb_xcc_id(); b.st = st;
    if (threadIdx.x == 0) st[3] = xb_add(&bar[XB_XCNT(b.x)], 1u);
    return b;
}
__device__ __forceinline__ void xcd_barrier_complete(unsigned* bar, unsigned x, unsigned& nloc, unsigned& nx) {
    const unsigned G = gridDim.x * gridDim.y * gridDim.z;
    unsigned sum, cnt, mine, sp = 0u;
    for (;;) {
        sum = 0u; cnt = 0u; mine = 0u;
#pragma unroll
        for (unsigned j = 0; j < 16; ++j) { const unsigned c = xb_ld(&bar[XB_XCNT(j)]); sum += c; cnt += (c > 0u) ? 1u : 0u; mine = (j == x) ? c : mine; }
        if (sum == G) break;
        __builtin_amdgcn_s_sleep(1);
        if ((++sp & 255u) == 0u) { if (xb_ld(&bar[XB_TMO])) break; if (sp > XB_SPIN_CAP) { atomicAdd(&bar[XB_TMO], 1u); break; } }
    }
    nloc = mine > 0u ? mine : 1u; nx = cnt > 0u ? cnt : 1u;
}
__device__ __forceinline__ void xcd_barrier(const XcdBarrier& b) {
    asm volatile("s_waitcnt vmcnt(0)" ::: "memory");
    __syncthreads();
    if (threadIdx.x == 0) {
        unsigned* bar = b.bar;
        __builtin_amdgcn_s_waitcnt(0);
        unsigned nloc = b.st[0], nx = b.st[1];
        if (nloc == 0u) { xcd_barrier_complete(bar, b.x, nloc, nx); b.st[0] = nloc; b.st[1] = nx; }
        const unsigned old = xb_add(&bar[XB_XSUB(b.x)], 1u);
        const unsigned gen = old / nloc;
        if (old + 1u == (gen + 1u) * nloc) {
            __builtin_amdgcn_fence(__ATOMIC_RELEASE, "agent");
            asm volatile("s_waitcnt vmcnt(0)" ::: "memory");
            const unsigned og = xb_add(&bar[XB_TOP], 1u);
            const unsigned tg = og / nx;
            if (og + 1u == (tg + 1u) * nx) xb_add(&bar[XB_TOPGEN], 1u);
            else XB_SPIN(xb_ld(&bar[XB_TOPGEN]) == tg, bar);
            __builtin_amdgcn_fence(__ATOMIC_ACQUIRE, "agent");
            xb_add(&bar[XB_XGEN(b.x)], 1u);
            asm volatile("s_waitcnt vmcnt(0)" ::: "memory");
        } else {
            XB_SPIN(xb_ld(&bar[XB_XGEN(b.x)]) == gen, bar);
            __builtin_amdgcn_fence(__ATOMIC_ACQUIRE, "agent");
            asm volatile("s_waitcnt vmcnt(0)" ::: "memory");
        }
    }
    __syncthreads();
}

__global__ void __launch_bounds__(NTHREADS) fwd_megakernel(Params p) {
    extern __shared__ __attribute__((aligned(16))) char smem[];
    cg::grid_group grid = cg::this_grid();
    volatile LAS unsigned* xst = (volatile LAS unsigned*)(smem + LDS_BYTES - 16);
    if (threadIdx.x < 4) xst[threadIdx.x] = threadIdx.x == 2 ? blockIdx.x : 0u;
    __syncthreads();
    const XcdBarrier xb = xcd_barrier_post(p.bar, xst);
    phase_prep(p, smem);
    phase_norm(p, 0, 0, p.X, p.X);
    grid.sync();
    if (threadIdx.x == 0) {
        bool even = gridDim.x == 256;
        for (int j = 0; j < 8; ++j) even = even && xb_ld(&p.bar[XB_XCNT(j)]) == 32u;
        if (even) xst[2] = xb.x + 8u * xst[3];
    }
    __syncthreads();
    phase_gemm_inproj(p, smem, W_LRU_IN, true);
    xcd_barrier(xb);
    phase_lru(p, smem);
    xcd_barrier(xb);
    phase_gemm_out(p, smem, W_LRU_OUT, p.ACT[2]);
    xcd_barrier(xb);
    phase_norm(p, 1, 1, p.X, p.X);
    xcd_barrier(xb);
    phase_gemm_inproj(p, smem, W_S5_IN, false);
    xcd_barrier(xb);
    phase_s5(p, smem);
    xcd_barrier(xb);
    phase_gemm_glu(p, smem);
    xcd_barrier(xb);
    phase_gemm_out(p, smem, W_S5_OUT, p.ACT[3]);
    xcd_barrier(xb);
    phase_norm_rwkv(p, p.X, p.X2);
    xcd_barrier(xb);
    phase_gemm_rwkv_in(p, smem);
    xcd_barrier(xb);
    phase_gemm_lora2(p, smem);
    xcd_barrier(xb);
    phase_rwkv(p, smem);
    xcd_barrier(xb);
    phase_gemm_out(p, smem, W_RW_OUT, p.ACT[6]);
    xcd_barrier(xb);
    phase_norm(p, 1, 3, p.X2, p.X2);
    xcd_barrier(xb);
    phase_gemm_ret_in(p, smem);
    xcd_barrier(xb);
    phase_ret(p, smem);
    xcd_barrier(xb);
    phase_gemm_ret_out(p, smem);
    xcd_barrier(xb);
    phase_norm(p, 3, 4, p.X2, p.X2);
}

extern "C" void kernel_launch(void* const* d_in, const int* in_sizes, int n_in, void* d_out, int out_size, void* d_ws, size_t ws_size, hipStream_t stream) {
    static int grid_blocks = 0;
    if (!grid_blocks) {
        int dev = 0, cus = 0, per_cu = 0;
        hipGetDevice(&dev);
        hipDeviceGetAttribute(&cus, hipDeviceAttributeMultiprocessorCount, dev);
        hipFuncSetAttribute((const void*)fwd_megakernel, hipFuncAttributeMaxDynamicSharedMemorySize, LDS_BYTES);
        hipOccupancyMaxActiveBlocksPerMultiprocessor(&per_cu, fwd_megakernel, NTHREADS, LDS_BYTES);
        if (per_cu < 1) per_cu = 1;
        if (per_cu > 1) per_cu = 1;
        grid_blocks = cus * per_cu;
    }
    Params p{};
    for (int i = 0; i < N_IN; ++i) p.in[i] = (const float*)d_in[i];
    p.out = (float*)d_out;
    char* ws = (char*)d_ws;
    size_t off = 0;
    auto take = [&](size_t bytes) { char* r = ws + off; off += (bytes + 255) & ~(size_t)255; return r; };
    p.X = (float*)take((size_t)RPAD * D * 4);
    p.Z = (float*)take((size_t)RPAD * D * 4);
    p.XN = (bf16_t*)take((size_t)RPAD * D * 2);
    p.XM = (bf16_t*)take((size_t)6 * RPAD * D * 2);
    p.X2 = (float*)take((size_t)RPAD * D * 4);
    for (int i = 0; i < 7; ++i) p.ACT[i] = (bf16_t*)take((size_t)RPAD * E * 2);
    p.L1 = (bf16_t*)take((size_t)RPAD * 128 * 2);
    p.SSP = (float*)take((size_t)R * 64 * 4);
    for (int j = 0; j < N_W; ++j) p.W[j] = (bf16_t*)take((size_t)w_rows(j) * w_k(j) * 2);
    p.bar = (unsigned*)take(XCD_BAR_WORDS * 4);
    if (off > ws_size) { fprintf(stderr, "workspace too small: need %zu have %zu\n", off, ws_size); return; }
    hipMemsetAsync(p.bar, 0, XCD_BAR_WORDS * 4, stream);
    void* args[] = {&p};
    hipError_t e = hipLaunchCooperativeKernel((const void*)fwd_megakernel, dim3(grid_blocks), dim3(NTHREADS), args, LDS_BYTES, stream);
    if (e != hipSuccess) fprintf(stderr, "cooperative launch failed: %s (grid %d)\n", hipGetErrorString(e), grid_blocks);
}
```

```cpp
#include <hip/hip_runtime.h>
#include <hip/hip_cooperative_groups.h>
#include <cstdio>
namespace cg = cooperative_groups;

typedef unsigned short bf16_t;
typedef short bf16x8 __attribute__((ext_vector_type(8)));
typedef float f32x4 __attribute__((ext_vector_type(4)));

constexpr int D = 1024, E = 2048, NB = 8, SEQT = 2064, NSB = 128, DSEQ = 8;
constexpr int RP = NB * SEQT;
constexpr int R = RP + NSB * DSEQ;
constexpr int MT = R / 128;
constexpr int RPAD = 17664;
constexpr int NTHREADS = 512;
constexpr int LDS_BYTES = 147456;
constexpr float EPS = 1e-6f;

constexpr size_t O_YP = 0;
constexpr size_t O_YS = O_YP + (size_t)NB * 2048 * D;
constexpr size_t O_P_LRU_CONV = O_YS + (size_t)NSB * DSEQ * D;
constexpr size_t O_P_LRU_H = O_P_LRU_CONV + (size_t)NB * 3 * E;
constexpr size_t O_P_S5_RE = O_P_LRU_H + (size_t)NB * E;
constexpr size_t O_P_S5_IM = O_P_S5_RE + (size_t)NB * 128 * 64;
constexpr size_t O_P_RW_SHIFT = O_P_S5_IM + (size_t)NB * 128 * 64;
constexpr size_t O_P_RW_WKV = O_P_RW_SHIFT + (size_t)NB * D;
constexpr size_t O_P_RET = O_P_RW_WKV + (size_t)NB * 32 * 64 * 64;
constexpr size_t O_S_LRU_CONV = O_P_RET + (size_t)NB * 4 * 256 * 512;
constexpr size_t O_S_LRU_H = O_S_LRU_CONV + (size_t)NSB * 3 * E;
constexpr size_t O_S_S5_RE = O_S_LRU_H + (size_t)NSB * E;
constexpr size_t O_S_S5_IM = O_S_S5_RE + (size_t)NSB * 128 * 64;
constexpr size_t O_S_RW_SHIFT = O_S_S5_IM + (size_t)NSB * 128 * 64;
constexpr size_t O_S_RW_WKV = O_S_RW_SHIFT + (size_t)NSB * D;
constexpr size_t O_S_RET = O_S_RW_WKV + (size_t)NSB * 32 * 64 * 64;

enum { I_XP = 0, I_XS, I_ST_LRU_CONV, I_ST_LRU_H, I_ST_S5_RE, I_ST_S5_IM, I_ST_RW_SHIFT, I_ST_RW_WKV, I_ST_RET, I_META,
       I_NPRE, I_NPOST, I_LRU_WIN, I_LRU_CW, I_LRU_CB, I_LRU_WA, I_LRU_BA, I_LRU_WX, I_LRU_BX, I_LRU_LAM, I_LRU_WOUT,
       I_S5_WIN, I_S5_LOGDT, I_S5_ARE, I_S5_AIM, I_S5_BRE, I_S5_BIM, I_S5_CRE, I_S5_CIM, I_S5_D, I_S5_GLUW, I_S5_GLUB, I_S5_WOUT,
       I_RW_MU, I_RW_WR, I_RW_WK, I_RW_WV, I_RW_WG, I_RW_W0, I_RW_W1, I_RW_W2, I_RW_A0, I_RW_A1, I_RW_A2, I_RW_KK, I_RW_KA,
       I_RW_RK, I_RW_LNW, I_RW_LNB, I_RW_WO, I_RT_WQ, I_RT_WK, I_RT_WV, I_RT_WG, I_RT_WO, N_IN };

enum { W_LRU_IN = 0, W_LRU_G, W_LRU_OUT, W_S5_IN, W_S5_GLU, W_S5_OUT, W_RW_IN, W_RW_L2, W_RW_OUT, W_RT_IN, W_RT_OUT, N_W };
__host__ __device__ constexpr int w_rows(int j) { return j == W_LRU_IN ? 4096 : j == W_LRU_G ? 4096 : j == W_LRU_OUT ? 1024 : j == W_S5_IN ? 4096 : j == W_S5_GLU ? 2048 :
                                 j == W_S5_OUT ? 1024 : j == W_RW_IN ? 8704 : j == W_RW_L2 ? 4096 : j == W_RW_OUT ? 1024 : j == W_RT_IN ? 6144 : 1024; }
__host__ __device__ constexpr int w_k(int j) { return j == W_LRU_IN ? 1024 : j == W_LRU_G ? 128 : j == W_LRU_OUT ? 2048 : j == W_S5_IN ? 1024 : j == W_S5_GLU ? 2048 :
                              j == W_S5_OUT ? 2048 : j == W_RW_IN ? 1024 : j == W_RW_L2 ? 64 : j == W_RW_OUT ? 2048 : j == W_RT_IN ? 1024 : 2048; }

struct Params {
    const float* in[N_IN];
    float* out;
    float* X; float* Z;
    bf16_t* XN; bf16_t* XM;
    float* X2;
    bf16_t* ACT[7];
    bf16_t* L1;
    float* SSP;
    bf16_t* W[N_W];
    unsigned* bar;
};

#define LAS __attribute__((address_space(3)))
typedef float cvt_f32x2 __attribute__((ext_vector_type(2)));
typedef __bf16 cvt_bf16x2 __attribute__((ext_vector_type(2)));
__device__ __forceinline__ unsigned pack2(float a, float b) { const cvt_f32x2 v = {a, b}; const cvt_bf16x2 h = __builtin_convertvector(v, cvt_bf16x2); return __builtin_bit_cast(unsigned, h); }
__device__ __forceinline__ bf16_t f2bf(float f) { return (bf16_t)(pack2(f, f) & 0xffffu); }
__device__ __forceinline__ float bf2f(bf16_t h) { return __uint_as_float(((unsigned)h) << 16); }
__device__ __forceinline__ float bflo(unsigned u) { return __uint_as_float(u << 16); }
__device__ __forceinline__ float bfhi(unsigned u) { return __uint_as_float(u & 0xffff0000u); }
__device__ __forceinline__ float rcpf_(float x) { return __builtin_amdgcn_rcpf(x); }
__device__ __forceinline__ float sigmoidf_(float x) { return rcpf_(1.0f + __expf(-x)); }
__device__ __forceinline__ float siluf_(float x) { return x * rcpf_(1.0f + __expf(-x)); }
__device__ __forceinline__ float tanhf_(float x) { return 1.0f - 2.0f * rcpf_(1.0f + __expf(2.0f * x)); }
__device__ __forceinline__ float softplusf_(float y) { return fmaxf(y, 0.0f) + __logf(1.0f + __expf(-fabsf(y))); }
__device__ __forceinline__ float wave_sum(float v) {
#pragma unroll
    for (int o = 32; o > 0; o >>= 1) v += __shfl_xor(v, o, 64);
    return v;
}
__device__ __forceinline__ void wave_lds_sync() { asm volatile("s_waitcnt lgkmcnt(0)" ::: "memory"); }
__device__ __forceinline__ f32x4 mfma16(bf16x8 a, bf16x8 b, f32x4 c) { return __builtin_amdgcn_mfma_f32_16x16x32_bf16(a, b, c, 0, 0, 0); }
__device__ __forceinline__ int opaque_tid() { int t = threadIdx.x; asm volatile("" : "+v"(t)); return t; }
__device__ __forceinline__ uint2 pack4(f32x4 v) { uint2 r; r.x = pack2(v[0], v[1]); r.y = pack2(v[2], v[3]); return r; }

__device__ __forceinline__ void phase_norm(const Params& p, int mode, int layer, const float* Xs, float* Xd) {
    const int lane = opaque_tid() & 63, wave = opaque_tid() >> 6;
    const int gw = blockIdx.x * 8 + wave, nw = gridDim.x * 8;
    for (int r = gw; r < R; r += nw) {
        const bool prompt = r < RP;
        const int b = prompt ? r / SEQT : (r - RP) / DSEQ;
        const int t = prompt ? r % SEQT : (r - RP) % DSEQ;
        float4 x[4];
        if (mode == 0) {
            const float* src = prompt ? (t < 16 ? p.in[I_META] + (size_t)t * D : p.in[I_XP] + ((size_t)b * 2048 + (t - 16)) * D)
                                      : p.in[I_XS] + (size_t)(r - RP) * D;
#pragma unroll
            for (int k = 0; k < 4; ++k) x[k] = *(const float4*)(src + k * 256 + lane * 4);
        } else {
            float4 z[4]; float ss = 0.f;
#pragma unroll
            for (int k = 0; k < 4; ++k) {
                x[k] = *(const float4*)(Xs + (size_t)r * D + k * 256 + lane * 4);
                z[k] = *(const float4*)(p.Z + (size_t)r * D + k * 256 + lane * 4);
                ss += z[k].x * z[k].x + z[k].y * z[k].y + z[k].z * z[k].z + z[k].w * z[k].w;
            }
            ss = wave_sum(ss);
            const float rs = rsqrtf(ss * (1.0f / D) + EPS);
            const float* gp = p.in[I_NPOST] + (size_t)(layer - 1) * D;
#pragma unroll
            for (int k = 0; k < 4; ++k) {
                const float4 g = *(const float4*)(gp + k * 256 + lane * 4);
                x[k].x += z[k].x * rs * g.x; x[k].y += z[k].y * rs * g.y; x[k].z += z[k].z * rs * g.z; x[k].w += z[k].w * rs * g.w;
            }
        }
        if (mode == 3) {
            if (prompt) {
                if (t >= 16) {
                    float* dst = p.out + O_YP + ((size_t)b * 2048 + (t - 16)) * D;
#pragma unroll
                    for (int k = 0; k < 4; ++k) *(float4*)(dst + k * 256 + lane * 4) = x[k];
                }
            } else {
                float* dst = p.out + O_YS + (size_t)(r - RP) * D;
#pragma unroll
                for (int k = 0; k < 4; ++k) *(float4*)(dst + k * 256 + lane * 4) = x[k];
            }
            continue;
        }
        float ss2 = 0.f;
#pragma unroll
        for (int k = 0; k < 4; ++k) {
            *(float4*)(Xd + (size_t)r * D + k * 256 + lane * 4) = x[k];
            ss2 += x[k].x * x[k].x + x[k].y * x[k].y + x[k].z * x[k].z + x[k].w * x[k].w;
        }
        ss2 = wave_sum(ss2);
        const float rs2 = rsqrtf(ss2 * (1.0f / D) + EPS);
        const float* gq = p.in[I_NPRE] + (size_t)layer * D;
#pragma unroll
        for (int k = 0; k < 4; ++k) {
            const float4 g = *(const float4*)(gq + k * 256 + lane * 4);
            uint2 pk; pk.x = pack2(x[k].x * rs2 * g.x, x[k].y * rs2 * g.y); pk.y = pack2(x[k].z * rs2 * g.z, x[k].w * rs2 * g.w);
            *(uint2*)(p.XN + (size_t)r * D + k * 256 + lane * 4) = pk;
        }
    }
}
__device__ __forceinline__ void phase_norm_rwkv(const Params& p, const float* Xs, float* Xd) {
    const int lane = opaque_tid() & 63, wave = opaque_tid() >> 6;
    const int gw = blockIdx.x * 8 + wave, nw = gridDim.x * 8;
    const float* gp = p.in[I_NPOST] + (size_t)1 * D;
    const float* gq = p.in[I_NPRE] + (size_t)2 * D;
    for (int r0 = gw * 9; r0 < R; r0 += nw * 9) {
    float4 prev[4];
#pragma unroll
    for (int k = 0; k < 4; ++k) prev[k] = make_float4(0.f, 0.f, 0.f, 0.f);
    for (int rr = -1; rr < 9; ++rr) {
        const int r = r0 + rr;
        if (r < 0 || r >= R) continue;
        const bool prompt = r < RP;
        const int b = prompt ? r / SEQT : (r - RP) / DSEQ;
        const int t = prompt ? r % SEQT : (r - RP) % DSEQ;
        const int tlast = prompt ? SEQT - 1 : DSEQ - 1;
        if (rr < 0 && t == tlast) continue;
        float4 x[4], z[4]; float ss = 0.f;
#pragma unroll
        for (int k = 0; k < 4; ++k) {
            x[k] = *(const float4*)(Xs + (size_t)r * D + k * 256 + lane * 4);
            z[k] = *(const float4*)(p.Z + (size_t)r * D + k * 256 + lane * 4);
            ss += z[k].x * z[k].x + z[k].y * z[k].y + z[k].z * z[k].z + z[k].w * z[k].w;
        }
        ss = wave_sum(ss);
        const float rs = rsqrtf(ss * (1.0f / D) + EPS);
        float ss2 = 0.f;
#pragma unroll
        for (int k = 0; k < 4; ++k) {
            const float4 g = *(const float4*)(gp + k * 256 + lane * 4);
            x[k].x += z[k].x * rs * g.x; x[k].y += z[k].y * rs * g.y; x[k].z += z[k].z * rs * g.z; x[k].w += z[k].w * rs * g.w;
            ss2 += x[k].x * x[k].x + x[k].y * x[k].y + x[k].z * x[k].z + x[k].w * x[k].w;
        }
        ss2 = wave_sum(ss2);
        const float rs2 = rsqrtf(ss2 * (1.0f / D) + EPS);
        float4 xn[4];
#pragma unroll
        for (int k = 0; k < 4; ++k) {
            const float4 g = *(const float4*)(gq + k * 256 + lane * 4);
            xn[k].x = x[k].x * rs2 * g.x; xn[k].y = x[k].y * rs2 * g.y; xn[k].z = x[k].z * rs2 * g.z; xn[k].w = x[k].w * rs2 * g.w;
        }
        if (rr >= 0) {
            if (t == 0) {
#pragma unroll
                for (int k = 0; k < 4; ++k) prev[k] = prompt ? make_float4(0.f, 0.f, 0.f, 0.f) : *(const float4*)(p.in[I_ST_RW_SHIFT] + (size_t)b * D + k * 256 + lane * 4);
            }
#pragma unroll
            for (int k = 0; k < 4; ++k) {
                const int c = k * 256 + lane * 4;
                *(float4*)(Xd + (size_t)r * D + c) = x[k];
                if (t == tlast) *(float4*)(p.out + (prompt ? O_P_RW_SHIFT : O_S_RW_SHIFT) + (size_t)b * D + c) = xn[k];
                const float4 dx = make_float4(prev[k].x - xn[k].x, prev[k].y - xn[k].y, prev[k].z - xn[k].z, prev[k].w - xn[k].w);
#pragma unroll
                for (int j = 0; j < 6; ++j) {
                    const int mi = j == 0 ? 0 : j == 1 ? 2 : j == 2 ? 3 : j == 3 ? 5 : j == 4 ? 1 : 4;
                    const float4 m = *(const float4*)(p.in[I_RW_MU] + mi * D + c);
                    uint2 pk; pk.x = pack2(xn[k].x + dx.x * m.x, xn[k].y + dx.y * m.y); pk.y = pack2(xn[k].z + dx.z * m.z, xn[k].w + dx.w * m.w);
                    *(uint2*)(p.XM + ((size_t)j * RPAD + r) * D + c) = pk;
                }
            }
        }
#pragma unroll
        for (int k = 0; k < 4; ++k) prev[k] = xn[k];
    }
    }
}

__device__ __forceinline__ const float* wsrc(const Params& p, int job, int nd, int& stride) {
    switch (job) {
    case W_LRU_IN: stride = 4096; return p.in[I_LRU_WIN] + nd;
    case W_LRU_G: {
        const int h = nd >> 8, q = (nd >> 7) & 1, pp = nd & 127, wn = pp >> 6, part = (pp >> 5) & 1, chl = wn * 32 + (pp & 31);
        stride = 128; return (part ? p.in[I_LRU_WX] : p.in[I_LRU_WA]) + (size_t)h * 128 * 128 + q * 64 + chl;
    }
    case W_LRU_OUT: stride = 1024; return p.in[I_LRU_WOUT] + nd;
    case W_S5_IN: stride = 4096; return p.in[I_S5_WIN] + nd;
    case W_S5_GLU: stride = 2048; return p.in[I_S5_GLUW] + nd;
    case W_S5_OUT: stride = 1024; return p.in[I_S5_WOUT] + nd;
    case W_RW_IN: {
        if (nd < 8192) { stride = 2048; const int w = nd >> 11; const float* s = w == 0 ? p.in[I_RW_WR] : w == 1 ? p.in[I_RW_WK] : w == 2 ? p.in[I_RW_WV] : p.in[I_RW_WG]; return s + (nd & 2047); }
        stride = 64;
        if (nd < 8448) { const int c = nd - 8192; return c < 64 ? p.in[I_RW_W1] + c : nullptr; }
        const int c = nd - 8448; return c < 64 ? p.in[I_RW_A1] + c : nullptr;
    }
    case W_RW_L2: stride = 2048; return nd < 2048 ? p.in[I_RW_W2] + nd : p.in[I_RW_A2] + (nd - 2048);
    case W_RW_OUT: stride = 1024; return p.in[I_RW_WO] + nd;
    case W_RT_IN: {
        if (nd < 2048) {
            stride = 1024; return (nd < 1024 ? p.in[I_RT_WQ] : p.in[I_RT_WK]) + (nd & 1023);
        }
        stride = 2048; return nd < 4096 ? p.in[I_RT_WV] + (nd - 2048) : p.in[I_RT_WG] + (nd - 4096);
    }
    default: stride = 1024; return p.in[I_RT_WO] + nd;
    }
}

__device__ __forceinline__ void phase_prep(const Params& p, char* smem) {
    float* tile = (float*)smem;
    const int tid = opaque_tid();
    int total = 0;
#pragma unroll
    for (int j = 0; j < N_W; ++j) total += (w_rows(j) / 64) * (w_k(j) / 64);
    for (int ti = blockIdx.x; ti < total; ti += gridDim.x) {
        int job = 0, rem = ti;
#pragma unroll
        for (int j = 0; j < N_W; ++j) { const int n = (w_rows(j) / 64) * (w_k(j) / 64); if (job == j && rem >= n) { rem -= n; job = j + 1; } }
        int K = 0;
#pragma unroll
        for (int j = 0; j < N_W; ++j) if (job == j) K = w_k(j);
        const int kt = K / 64, nt0 = rem / kt, kt0 = rem % kt;
        const int n0 = nt0 * 64, k0 = kt0 * 64;
        {
            const int nc = (tid & 15) * 4; int stride;
            const float* s = wsrc(p, job, n0 + nc, stride);
#pragma unroll
            for (int ps = 0; ps < 2; ++ps) {
                const int kr = (tid >> 4) + ps * 32;
                float4 v = make_float4(0.f, 0.f, 0.f, 0.f);
                if (s) v = *(const float4*)(s + (size_t)(k0 + kr) * stride);
                tile[kr * 65 + nc + 0] = v.x; tile[kr * 65 + nc + 1] = v.y; tile[kr * 65 + nc + 2] = v.z; tile[kr * 65 + nc + 3] = v.w;
            }
        }
        __syncthreads();
        {
            const int n = tid >> 3, kc = (tid & 7) * 8;
            uint4 o;
            o.x = pack2(tile[(kc + 0) * 65 + n], tile[(kc + 1) * 65 + n]);
            o.y = pack2(tile[(kc + 2) * 65 + n], tile[(kc + 3) * 65 + n]);
            o.z = pack2(tile[(kc + 4) * 65 + n], tile[(kc + 5) * 65 + n]);
            o.w = pack2(tile[(kc + 6) * 65 + n], tile[(kc + 7) * 65 + n]);
            *(uint4*)(p.W[job] + (size_t)(n0 + n) * K + k0 + kc) = o;
        }
        __syncthreads();
    }
}

__device__ __forceinline__ int swz(int row, int chunk) { return row * 64 + ((chunk ^ (row & 7)) << 3); }

template <class AL, class EP>
__device__ __forceinline__ void gemm_tile(char* smem, AL& al, const bf16_t* __restrict__ Bt, int ldb, int K, EP& ep) {
    bf16_t* As = (bf16_t*)smem;
    bf16_t* Bs = As + 2 * 128 * 64;
    const int tid = opaque_tid(), lane = tid & 63, wave = tid >> 6, wm = wave >> 2, wn = wave & 3, l15 = lane & 15, quad = lane >> 4;
    f32x4 acc[4][4];
#pragma unroll
    for (int i = 0; i < 4; ++i)
#pragma unroll
        for (int j = 0; j < 4; ++j) acc[i][j] = (f32x4){0.f, 0.f, 0.f, 0.f};
    uint4 ra[2], rb[4];
    const int lrow = tid >> 3, lch = tid & 7;
    const int nk = K >> 6;
#pragma unroll
    for (int it = 0; it < 2; ++it) ra[it] = al.load(it, lrow + it * 64, lch * 8);
#pragma unroll
    for (int it = 0; it < 4; ++it) rb[it] = *(const uint4*)(Bt + (size_t)(lrow + it * 64) * ldb + lch * 8);
#pragma unroll
    for (int it = 0; it < 2; ++it) *(uint4*)(As + swz(lrow + it * 64, lch)) = ra[it];
#pragma unroll
    for (int it = 0; it < 4; ++it) *(uint4*)(Bs + swz(lrow + it * 64, lch)) = rb[it];
    __syncthreads();
    for (int kt = 0; kt < nk; ++kt) {
        const int cur = kt & 1;
        const bool more = kt + 1 < nk;
        if (more) {
            const int k0 = (kt + 1) << 6;
#pragma unroll
            for (int it = 0; it < 2; ++it) ra[it] = al.load(it, lrow + it * 64, k0 + lch * 8);
#pragma unroll
            for (int it = 0; it < 4; ++it) rb[it] = *(const uint4*)(Bt + (size_t)(lrow + it * 64) * ldb + k0 + lch * 8);
        }
        const bf16_t* Ac = As + cur * 128 * 64;
        const bf16_t* Bc = Bs + cur * 256 * 64;
#pragma unroll
        for (int kk = 0; kk < 2; ++kk) {
            bf16x8 af[4], bfr[4];
#pragma unroll
            for (int i = 0; i < 4; ++i) af[i] = *(const bf16x8*)(Ac + swz(wm * 64 + i * 16 + l15, kk * 4 + quad));
#pragma unroll
            for (int j = 0; j < 4; ++j) bfr[j] = *(const bf16x8*)(Bc + swz(wn * 64 + j * 16 + l15, kk * 4 + quad));
#pragma unroll
            for (int i = 0; i < 4; ++i)
#pragma unroll
                for (int j = 0; j < 4; ++j) acc[i][j] = mfma16(bfr[j], af[i], acc[i][j]);
        }
        if (more) {
            bf16_t* An = As + (cur ^ 1) * 128 * 64;
            bf16_t* Bn = Bs + (cur ^ 1) * 256 * 64;
#pragma unroll
            for (int it = 0; it < 2; ++it) *(uint4*)(An + swz(lrow + it * 64, lch)) = ra[it];
#pragma unroll
            for (int it = 0; it < 4; ++it) *(uint4*)(Bn + swz(lrow + it * 64, lch)) = rb[it];
        }
        __syncthreads();
    }
    ep(acc, wm * 64 + l15, wn * 64 + quad * 4);
}

struct ALPlain {
    const bf16_t* A; int lda;
    __device__ __forceinline__ uint4 load(int, int row, int k) const { return *(const uint4*)(A + (size_t)row * lda + k); }
};
struct ALRet {
    const bf16_t* y; const bf16_t* g; const float* ssp;
    float sc[2];
    __device__ __forceinline__ uint4 load(int it, int row, int k) {
        if ((k & 511) < 64) {
            const float* s = ssp + (size_t)row * 64 + (k >> 9) * 16;
            const float4 a = *(const float4*)s, b = *(const float4*)(s + 4), c = *(const float4*)(s + 8), d = *(const float4*)(s + 12);
            const float tot = a.x + a.y + a.z + a.w + b.x + b.y + b.z + b.w + c.x + c.y + c.z + c.w + d.x + d.y + d.z + d.w;
            sc[it] = rsqrtf(tot * (1.0f / 512.0f) + EPS);
        }
        const float f = sc[it];
        const uint4 a = *(const uint4*)(y + (size_t)row * E + k);
        const uint4 gg = *(const uint4*)(g + (size_t)row * E + k);
        uint4 o;
        o.x = pack2(bflo(a.x) * f * bflo(gg.x), bfhi(a.x) * f * bfhi(gg.x));
        o.y = pack2(bflo(a.y) * f * bflo(gg.y), bfhi(a.y) * f * bfhi(gg.y));
        o.z = pack2(bflo(a.z) * f * bflo(gg.z), bfhi(a.z) * f * bfhi(gg.z));
        o.w = pack2(bflo(a.w) * f * bflo(gg.w), bfhi(a.w) * f * bfhi(gg.w));
        return o;
    }
};

struct OpZ {
    float* Z;
    __device__ __forceinline__ int row_ctx(int) const { return 0; }
    __device__ __forceinline__ void operator()(int row, int col, f32x4 v, int) const { *(f32x4*)(Z + (size_t)row * D + col) = v; }
    __device__ __forceinline__ void call8(int row, int col, f32x4 a, f32x4 b, int c) const { (*this)(row, col, a, c); (*this)(row, col + 4, b, c); }
};
struct OpInProj {
    bf16_t* U; bf16_t* SG; float* out; bool lru;
    __device__ __forceinline__ float* row_ctx(int row) const {
        if (!lru || row >= R) return nullptr;
        const bool prompt = row < RP;
        const int b = prompt ? row / SEQT : (row - RP) / DSEQ;
        const int t = prompt ? row % SEQT : (row - RP) % DSEQ;
        const int tl = t - (prompt ? SEQT - 3 : DSEQ - 3);
        return tl >= 0 ? out + (prompt ? O_P_LRU_CONV : O_S_LRU_CONV) + ((size_t)b * 3 + tl) * E : nullptr;
    }
    __device__ __forceinline__ void call8(int row, int col, f32x4 a, f32x4 b, float* crow) const {
        if (col >= E) {
#pragma unroll
            for (int e = 0; e < 4; ++e) { a[e] = siluf_(a[e]); b[e] = siluf_(b[e]); }
            const uint2 lo = pack4(a), hi = pack4(b);
            *(uint4*)(SG + (size_t)row * E + col - E) = make_uint4(lo.x, lo.y, hi.x, hi.y);
        } else {
            const uint2 lo = pack4(a), hi = pack4(b);
            *(uint4*)(U + (size_t)row * E + col) = make_uint4(lo.x, lo.y, hi.x, hi.y);
            if (crow) { *(f32x4*)(crow + col) = a; *(f32x4*)(crow + col + 4) = b; }
        }
    }
    __device__ __forceinline__ void operator()(int row, int col, f32x4 v, float* crow) const {
        if (col >= E) {
            v[0] = siluf_(v[0]); v[1] = siluf_(v[1]); v[2] = siluf_(v[2]); v[3] = siluf_(v[3]);
            *(uint2*)(SG + (size_t)row * E + col - E) = pack4(v);
        } else {
            *(uint2*)(U + (size_t)row * E + col) = pack4(v);
            if (crow) *(f32x4*)(crow + col) = v;
        }
    }
};
struct OpGlu {
    const bf16_t* Y1; const bf16_t* SG; bf16_t* Y2; const float* bias;
    __device__ __forceinline__ void call8(int row, int col, f32x4 a, f32x4 b, int c) const { (*this)(row, col, a, c); (*this)(row, col + 4, b, c); }
    __device__ __forceinline__ int row_ctx(int) const { return 0; }
    __device__ __forceinline__ void operator()(int row, int col, f32x4 v, int) const {
        const float4 bb = *(const float4*)(bias + col);
        const size_t o = (size_t)row * E + col;
        const uint2 y1 = *(const uint2*)(Y1 + o), sg = *(const uint2*)(SG + o);
        v[0] = bflo(y1.x) * sigmoidf_(v[0] + bb.x) * bflo(sg.x);
        v[1] = bfhi(y1.x) * sigmoidf_(v[1] + bb.y) * bfhi(sg.x);
        v[2] = bflo(y1.y) * sigmoidf_(v[2] + bb.z) * bflo(sg.y);
        v[3] = bfhi(y1.y) * sigmoidf_(v[3] + bb.w) * bfhi(sg.y);
        *(uint2*)(Y2 + o) = pack4(v);
    }
};
struct OpRwkvIn {
    bf16_t* d0; bf16_t* d1; bf16_t* d2; bf16_t* d3; bf16_t* L1;
    __device__ __forceinline__ void call8(int row, int col, f32x4 a, f32x4 b, int c) const { (*this)(row, col, a, c); (*this)(row, col + 4, b, c); }
    __device__ __forceinline__ int row_ctx(int) const { return 0; }
    __device__ __forceinline__ void operator()(int row, int col, f32x4 v, int) const {
        if (col < 8192) {
            const int reg = col >> 11;
            if (reg == 3) { v[0] = siluf_(v[0]); v[1] = siluf_(v[1]); v[2] = siluf_(v[2]); v[3] = siluf_(v[3]); }
            bf16_t* dst = reg == 0 ? d0 : reg == 1 ? d1 : reg == 2 ? d2 : d3;
            *(uint2*)(dst + (size_t)row * E + (col & 2047)) = pack4(v);
        } else {
            const int cc = col - 8192, part = cc >> 8, c = cc & 255;
            if (c < 64) {
                if (part == 0) { v[0] = tanhf_(v[0]); v[1] = tanhf_(v[1]); v[2] = tanhf_(v[2]); v[3] = tanhf_(v[3]); }
                *(uint2*)(L1 + (size_t)row * 128 + part * 64 + c) = pack4(v);
            }
        }
    }
};
struct OpLora2 {
    bf16_t* DL; bf16_t* AA; const float* w0; const float* a0;
    __device__ __forceinline__ void call8(int row, int col, f32x4 a, f32x4 b, int c) const { (*this)(row, col, a, c); (*this)(row, col + 4, b, c); }
    __device__ __forceinline__ int row_ctx(int) const { return 0; }
    __device__ __forceinline__ void operator()(int row, int col, f32x4 v, int) const {
        const bool isw = col < E; const int c = col & 2047;
        const float4 bb = *(const float4*)((isw ? w0 : a0) + c);
        v[0] += bb.x; v[1] += bb.y; v[2] += bb.z; v[3] += bb.w;
#pragma unroll
        for (int e = 0; e < 4; ++e) v[e] = isw ? __expf(-softplusf_(-v[e]) - 0.5f) : sigmoidf_(v[e]);
        *(uint2*)((isw ? DL : AA) + (size_t)row * E + c) = pack4(v);
    }
};

template <class Op> struct OldEpi {
    Op op; int m0, n0;
    __device__ __forceinline__ void operator()(f32x4 (&acc)[4][4], int r0, int c0) const {
#pragma unroll
        for (int i = 0; i < 4; ++i) {
            const auto ctx = op.row_ctx(m0 + r0 + i * 16);
#pragma unroll
            for (int j = 0; j < 4; ++j) op(m0 + r0 + i * 16, n0 + c0 + j * 16, acc[i][j], ctx);
        }
    }
};

namespace pg8 {
constexpr int BM = 256, BK = 64, HALF = 128, HTB = HALF * BK * 2, STAGE_BYTES = 8 * HTB, NXCD = 8, WGM = 8;
__device__ __forceinline__ int lds_byte(int r, int c) { const int st = (r >> 4) * 2 + (c >> 5), rr = r & 15, cc = c & 31, ob = rr * 64 + cc * 2; return st * 1024 + (ob ^ (((ob >> 9) & 1) << 5)); }
__device__ __forceinline__ void stage_rc(int b, int& Rr, int& C) { const int st = b / 1024, sb = b % 1024, swz = sb ^ (((sb >> 9) & 1) << 5); Rr = (st >> 1) * 16 + swz / 64; C = (st & 1) * 32 + (swz % 64) / 2; }
__device__ __forceinline__ int perm32(int rho) { const int n = rho >> 4, i = rho & 15; return 8 * (i >> 2) + 4 * n + (i & 3); }
struct Unit { int pm, pn; };
struct Gemm { const bf16_t* A; const bf16_t* Bt; int M, N, K; size_t a_sel_bytes; };
__device__ __forceinline__ size_t a_sel(const Gemm& g, int pn) { const int sgrp = pn >> 3; return g.a_sel_bytes * (size_t)((sgrp < 4 ? sgrp : 4) + (pn == 33 ? 1 : 0)); }
struct StaticOrder {
    int nM, nN, nwg, G, c;
    __device__ void init(int M, int N, int G_, int c_) { nM = M / BM; nN = N / BM; nwg = nM * nN; G = G_; c = c_; }
    __device__ bool next(int i, Unit& u) const {
        const long L = (long)i * G + c; if (L >= nwg) return false;
        int wgid = (int)L; { const int q = nwg / NXCD, r = nwg % NXCD, xcd = wgid % NXCD, off = wgid / NXCD; wgid = (xcd < r ? xcd * (q + 1) : r * (q + 1) + (xcd - r) * q) + off; }
        const int nig = WGM * nN, gid = wgid / nig, fm = gid * WGM, gsz = (nM - fm) < WGM ? (nM - fm) : WGM;
        u.pm = fm + ((wgid % nig) % gsz); u.pn = (wgid % nig) / gsz; return true;
    }
};
template <class Epi>
__device__ __forceinline__ void gemm_phase(LAS unsigned char* lds, const Gemm g, const StaticOrder& S, const Epi& Ep) {
    const int tid = opaque_tid(), wid = __builtin_amdgcn_readfirstlane(tid >> 6), lane = tid & 63, wr = wid >> 2, wc = wid & 3, fr = lane & 15, fq = lane >> 4;
    const int K = g.K, nt = K / BK;
    unsigned voffA[2], voffB[2];
#pragma unroll
    for (int i = 0; i < 2; ++i) { int Rr, C; stage_rc(tid * 16 + i * 8192, Rr, C); const int Rb = Epi::PERM ? ((Rr & ~31) + perm32(Rr & 31)) : Rr;
        voffA[i] = (unsigned)(Rr * K + C) * 2u; voffB[i] = (unsigned)(Rb * K + C) * 2u; }
    const size_t kstep = (size_t)(BK * 2);
    const size_t hstep = (size_t)HALF * K * 2;
    const size_t tstep = 2 * hstep;
    const unsigned ldsw = (unsigned)wid * 1024u;
    const int aoff = lds_byte(wr * 64 + fr, fq * 8), boff = lds_byte(wc * 32 + fr, fq * 8);
#define PG8_SA(b, h) (((b) * 2 + (h)) * HTB)
#define PG8_SB(b, h) ((4 + (b) * 2 + (h)) * HTB)
#define PG8_STAGE(bufoff, gbase, voff) do { _Pragma("unroll") for (int _i = 0; _i < 2; ++_i) \
        __builtin_amdgcn_global_load_lds((const unsigned*)((const char*)(gbase) + (voff)[_i]), (LAS unsigned*)(lds + (bufoff) + ldsw + _i * 8192), 16, 0, 0); } while (0)
#define PG8_LDA(dst, b, h) do { _Pragma("unroll") for (int m = 0; m < 4; ++m) _Pragma("unroll") for (int k = 0; k < 2; ++k) dst[m][k] = *(const LAS bf16x8*)(lds + PG8_SA(b, h) + aoff + m * 2048 + k * 1024); } while (0)
#define PG8_LDB(dst, b, h) do { _Pragma("unroll") for (int n = 0; n < 2; ++n) _Pragma("unroll") for (int k = 0; k < 2; ++k) dst[n][k] = *(const LAS bf16x8*)(lds + PG8_SB(b, h) + boff + n * 2048 + k * 1024); } while (0)
#define PG8_MMA(ai, bj, At, Bt) do { __builtin_amdgcn_s_setprio(1); _Pragma("unroll") for (int m = 0; m < 4; ++m) _Pragma("unroll") for (int n = 0; n < 2; ++n) _Pragma("unroll") for (int k = 0; k < 2; ++k) \
        acc[ai][bj][m][n] = __builtin_amdgcn_mfma_f32_16x16x32_bf16(Bt[n][k], At[m][k], acc[ai][bj][m][n], 0, 0, 0); __builtin_amdgcn_s_setprio(0); } while (0)
#define PG8_WAIT_V(n) asm volatile("s_waitcnt vmcnt(" #n ")" ::: "memory")
#define PG8_WAIT_L(n) asm volatile("s_waitcnt lgkmcnt(" #n ")" ::: "memory")
#define PG8_BAR __builtin_amdgcn_s_barrier()
#define PG8_SCHED __builtin_amdgcn_sched_barrier(0)
    Unit cur, nxt; int ui = 0;
    if (!S.next(0, cur)) return;
    f32x4 acc[2][2][4][2];
#pragma unroll
    for (int a = 0; a < 2; ++a)
#pragma unroll
        for (int b = 0; b < 2; ++b)
#pragma unroll
            for (int m = 0; m < 4; ++m)
#pragma unroll
                for (int n = 0; n < 2; ++n) acc[a][b][m][n] = (f32x4){0.f, 0.f, 0.f, 0.f};
    bf16x8 At[4][2], B0[2][2], B1[2][2];
    const char* cA = (const char*)g.A + a_sel(g, cur.pn) + (size_t)cur.pm * tstep; const char* cB = (const char*)g.Bt + (size_t)cur.pn * tstep;
    PG8_STAGE(PG8_SB(0, 0), cB, voffB); PG8_STAGE(PG8_SA(0, 0), cA, voffA); PG8_STAGE(PG8_SB(0, 1), cB + hstep, voffB); PG8_STAGE(PG8_SA(0, 1), cA + hstep, voffA);
    if (wr == 1) PG8_BAR;
    PG8_WAIT_V(4); PG8_BAR;
    PG8_STAGE(PG8_SB(1, 0), cB + kstep, voffB); PG8_STAGE(PG8_SA(1, 0), cA + kstep, voffA); PG8_STAGE(PG8_SB(1, 1), cB + hstep + kstep, voffB);
    PG8_WAIT_V(6); PG8_BAR;
    for (;;) {
        const bool has_next = S.next(ui + 1, nxt);
        const char* nA = has_next ? (const char*)g.A + a_sel(g, nxt.pn) + (size_t)nxt.pm * tstep : cA; const char* nB = has_next ? (const char*)g.Bt + (size_t)nxt.pn * tstep : cB;
        for (int t = 0; t < nt; t += 2) {
            const bool last = (t == nt - 2);
            const char* a1 = cA + (size_t)(t + 1) * kstep;
            const char* a2 = last ? nA : cA + (size_t)(t + 2) * kstep; const char* b2 = last ? nB : cB + (size_t)(t + 2) * kstep;
            const char* a3 = a2 + kstep; const char* b3 = b2 + kstep;
            PG8_LDB(B0, 0, 0); PG8_SCHED; PG8_LDA(At, 0, 0); PG8_STAGE(PG8_SA(1, 1), a1 + hstep, voffA);
            PG8_WAIT_L(8); PG8_BAR; PG8_WAIT_L(0); PG8_MMA(0, 0, At, B0); PG8_BAR; PG8_SCHED;
            PG8_LDB(B1, 0, 1); PG8_STAGE(PG8_SB(0, 0), b2, voffB);
            PG8_BAR; PG8_WAIT_L(0); PG8_MMA(0, 1, At, B1); PG8_BAR;
            PG8_LDA(At, 0, 1); PG8_STAGE(PG8_SA(0, 0), a2, voffA);
            PG8_BAR; PG8_WAIT_L(0); PG8_MMA(1, 0, At, B0); PG8_BAR; PG8_SCHED;
            PG8_STAGE(PG8_SB(0, 1), b2 + hstep, voffB);
            PG8_WAIT_V(6); PG8_BAR; PG8_MMA(1, 1, At, B1); PG8_BAR;
            PG8_LDB(B0, 1, 0); PG8_SCHED; PG8_LDA(At, 1, 0); PG8_STAGE(PG8_SA(0, 1), a2 + hstep, voffA);
            PG8_WAIT_L(8); PG8_BAR; PG8_WAIT_L(0); PG8_MMA(0, 0, At, B0); PG8_BAR; PG8_SCHED;
            PG8_LDB(B1, 1, 1); PG8_STAGE(PG8_SB(1, 0), b3, voffB);
            PG8_BAR; PG8_WAIT_L(0); PG8_MMA(0, 1, At, B1); PG8_BAR;
            PG8_LDA(At, 1, 1); PG8_STAGE(PG8_SA(1, 0), a3, voffA);
            PG8_BAR; PG8_WAIT_L(0); PG8_MMA(1, 0, At, B0); PG8_BAR; PG8_SCHED;
            PG8_STAGE(PG8_SB(1, 1), b3 + hstep, voffB);
            PG8_WAIT_V(6); PG8_BAR; PG8_MMA(1, 1, At, B1); PG8_BAR;
            if constexpr (Epi::HEAD_RESCALE) {
                if ((t & 7) == 6 && !last) {
                    const LAS float* sc = (const LAS float*)(lds + 131072) + (ui & 1) * 1024 + (t >> 3);
#pragma unroll
                    for (int ai = 0; ai < 2; ++ai)
#pragma unroll
                        for (int m = 0; m < 4; ++m) {
                            const int r = ai * 128 + wr * 64 + m * 16 + fr;
                            const float ratio = sc[r * 4] * __builtin_amdgcn_rcpf(sc[r * 4 + 1]);
#pragma unroll
                            for (int bj = 0; bj < 2; ++bj)
#pragma unroll
                                for (int n = 0; n < 2; ++n) acc[ai][bj][m][n] *= ratio;
                        }
                }
            }
        }
        if constexpr (Epi::HEAD_RESCALE) Ep.call_ui(acc, cur, ui, wr, wc, fr, fq, lds);
        else Ep(acc, cur, wr, wc, fr, fq);
        if (!has_next) break;
#pragma unroll
        for (int a = 0; a < 2; ++a)
#pragma unroll
            for (int b = 0; b < 2; ++b)
#pragma unroll
                for (int m = 0; m < 4; ++m)
#pragma unroll
                    for (int n = 0; n < 2; ++n) acc[a][b][m][n] = (f32x4){0.f, 0.f, 0.f, 0.f};
        cur = nxt; cA = nA; cB = nB; ++ui;
    }
    PG8_WAIT_V(0);
    if (wr == 0) PG8_BAR;
    PG8_BAR;
#undef PG8_SA
#undef PG8_SB
#undef PG8_STAGE
#undef PG8_LDA
#undef PG8_LDB
#undef PG8_MMA
#undef PG8_WAIT_V
#undef PG8_WAIT_L
#undef PG8_BAR
#undef PG8_SCHED
}
}

template <class Op, bool PERM_> struct Pg8Epi {
    static constexpr bool PERM = PERM_, HEAD_RESCALE = false;
    Op op;
    __device__ __forceinline__ void operator()(const f32x4 (&acc)[2][2][4][2], const pg8::Unit& u, int wr, int wc, int fr, int fq) const {
#pragma unroll
        for (int ai = 0; ai < 2; ++ai)
#pragma unroll
            for (int m = 0; m < 4; ++m) {
                const int row = u.pm * 256 + ai * 128 + wr * 64 + m * 16 + fr;
                const auto ctx = op.row_ctx(row);
#pragma unroll
                for (int bj = 0; bj < 2; ++bj) {
                    if (PERM) op.call8(row, u.pn * 256 + bj * 128 + wc * 32 + fq * 8, acc[ai][bj][m][0], acc[ai][bj][m][1], ctx);
                    else {
#pragma unroll
                        for (int n = 0; n < 2; ++n) op(row, u.pn * 256 + bj * 128 + wc * 32 + n * 16 + fq * 4, acc[ai][bj][m][n], ctx);
                    }
                }
            }
    }
};
struct Pg8EpiRetIn {
    static constexpr bool PERM = true, HEAD_RESCALE = false;
    bf16_t* Q; bf16_t* Kk; bf16_t* V; bf16_t* G;
    __device__ __forceinline__ void operator()(const f32x4 (&acc)[2][2][4][2], const pg8::Unit& u, int wr, int wc, int fr, int fq) const {
        const int nt = u.pn;
        float invf[2][4];
#pragma unroll
        for (int n = 0; n < 2; ++n)
#pragma unroll
            for (int e = 0; e < 4; ++e) invf[n][e] = __builtin_amdgcn_exp2f(-(float)(wc * 32 + fq * 8 + n * 4 + e) * (13.287712379549449f / 128.0f)) * 0.15915494309189535f;
#pragma unroll
        for (int ai = 0; ai < 2; ++ai)
#pragma unroll
            for (int m = 0; m < 4; ++m) {
                const int row = u.pm * 256 + ai * 128 + wr * 64 + m * 16 + fr;
                if (nt >= 8) {
#pragma unroll
                    for (int bj = 0; bj < 2; ++bj)
#pragma unroll
                        for (int n = 0; n < 2; ++n) {
                            f32x4 v = acc[ai][bj][m][n];
                            if (nt >= 16) { v[0] = siluf_(v[0]); v[1] = siluf_(v[1]); v[2] = siluf_(v[2]); v[3] = siluf_(v[3]); }
                            *(uint2*)((nt >= 16 ? G : V) + (size_t)row * E + (nt & 7) * 256 + bj * 128 + wc * 32 + fq * 8 + n * 4) = pack4(v);
                        }
                } else {
                    const int h = nt & 3;
                    const float scl = nt >= 4 ? 0.0625f : 1.0f;
                    bf16_t* dst = nt >= 4 ? Kk : Q;
                    const float pos = (float)(row < RP ? row % SEQT : 16384 + (row - RP) % DSEQ);
#pragma unroll
                    for (int n = 0; n < 2; ++n) {
                        const int d1 = wc * 32 + fq * 8 + n * 4;
                        f32x4 o1, o2;
#pragma unroll
                        for (int e = 0; e < 4; ++e) {
                            const float rev = __builtin_amdgcn_fractf(pos * invf[n][e]);
                            const float sn = __builtin_amdgcn_sinf(rev), cs = __builtin_amdgcn_cosf(rev);
                            const float x1 = acc[ai][0][m][n][e], x2 = acc[ai][1][m][n][e];
                            o1[e] = (x1 * cs - x2 * sn) * scl; o2[e] = (x2 * cs + x1 * sn) * scl;
                        }
                        *(uint2*)(dst + (size_t)row * D + h * 256 + d1) = pack4(o1);
                        *(uint2*)(dst + (size_t)row * D + h * 256 + 128 + d1) = pack4(o2);
                    }
                }
            }
    }
};

struct Pg8EpiRetOut {
    static constexpr bool PERM = false, HEAD_RESCALE = true;
    float* Z;
    __device__ __forceinline__ void call_ui(const f32x4 (&acc)[2][2][4][2], const pg8::Unit& u, int ui, int wr, int wc, int fr, int fq, LAS unsigned char* lds) const {
        const LAS float* sc = (const LAS float*)(lds + 131072) + (ui & 1) * 1024 + 3;
#pragma unroll
        for (int ai = 0; ai < 2; ++ai)
#pragma unroll
            for (int m = 0; m < 4; ++m) {
                const int r = ai * 128 + wr * 64 + m * 16 + fr;
                const float s3 = sc[r * 4];
                float* rp = Z + (size_t)(u.pm * 256 + r) * D + u.pn * 256 + wc * 32 + fq * 4;
#pragma unroll
                for (int bj = 0; bj < 2; ++bj)
#pragma unroll
                    for (int n = 0; n < 2; ++n) *(f32x4*)(rp + bj * 128 + n * 16) = acc[ai][bj][m][n] * s3;
            }
    }
};
template <class Epi>
__device__ __forceinline__ void run_pg8(char* smem, const bf16_t* A, const bf16_t* Bt, int N, int K, const Epi& ep, size_t a_sel_bytes = 0) {
    const int slot = (int)((volatile LAS unsigned*)(smem + LDS_BYTES - 16))[2];
    pg8::StaticOrder so; so.init(RPAD, N, gridDim.x, slot);
    pg8::Gemm g{A, Bt, RPAD, N, K, a_sel_bytes};
    pg8::gemm_phase((LAS unsigned char*)smem, g, so, ep);
}
__device__ __forceinline__ void phase_gemm_inproj(const Params& p, char* smem, int wj, bool lru) {
    Pg8Epi<OpInProj, true> ep{{p.ACT[0], p.ACT[1], p.out, lru}};
    run_pg8(smem, p.XN, p.W[wj], 4096, D, ep);
}
__device__ __forceinline__ void phase_gemm_out(const Params& p, char* smem, int wj, const bf16_t* Y) {
    Pg8Epi<OpZ, false> ep{{p.Z}};
    run_pg8(smem, Y, p.W[wj], D, E, ep);
}
__device__ __forceinline__ void phase_gemm_glu(const Params& p, char* smem) {
    Pg8Epi<OpGlu, true> ep{{p.ACT[2], p.ACT[1], p.ACT[3], p.in[I_S5_GLUB]}};
    run_pg8(smem, p.ACT[2], p.W[W_S5_GLU], E, E, ep);
}
__device__ __forceinline__ void phase_gemm_rwkv_in(const Params& p, char* smem) {
    Pg8Epi<OpRwkvIn, true> ep{{p.ACT[0], p.ACT[1], p.ACT[2], p.ACT[3], p.L1}};
    run_pg8(smem, p.XM, p.W[W_RW_IN], 8704, D, ep, (size_t)RPAD * D * 2);
}
__device__ __forceinline__ void phase_gemm_lora2(const Params& p, char* smem) {
    for (int tile = blockIdx.x; tile < MT * 16; tile += gridDim.x) {
        const int nt = tile / MT, mt = tile % MT;
        ALPlain al{p.L1 + (size_t)mt * 128 * 128 + (nt < 8 ? 0 : 64), 128};
        OldEpi<OpLora2> ep{{p.ACT[4], p.ACT[5], p.in[I_RW_W0], p.in[I_RW_A0]}, mt * 128, nt * 256};
        gemm_tile(smem, al, p.W[W_RW_L2] + (size_t)nt * 256 * 64, 64, 64, ep);
    }
}
__device__ __forceinline__ void phase_gemm_ret_in(const Params& p, char* smem) {
    Pg8EpiRetIn ep{p.ACT[0], p.ACT[1], p.ACT[2], p.ACT[3]};
    run_pg8(smem, p.XN, p.W[W_RT_IN], 6144, D, ep);
}
__device__ __forceinline__ void phase_gemm_ret_out(const Params& p, char* smem) {
    const int slot = (int)((volatile LAS unsigned*)(smem + LDS_BYTES - 16))[2];
    pg8::StaticOrder so; so.init(RPAD, D, gridDim.x, slot);
    {
        float* sc = (float*)(smem + 131072);
        const int tid = opaque_tid(), r = tid >> 1, h0 = (tid & 1) * 2;
#pragma unroll
        for (int ui = 0; ui < 2; ++ui) {
            pg8::Unit u;
            if (so.next(ui, u)) {
                const int row = u.pm * 256 + r;
#pragma unroll
                for (int hh = 0; hh < 2; ++hh) {
                    float scale = 1.0f;
                    if (row < R) {
                        const float* q = p.SSP + (size_t)row * 64 + (h0 + hh) * 16;
                        const float4 a = *(const float4*)q, b = *(const float4*)(q + 4), c = *(const float4*)(q + 8), d = *(const float4*)(q + 12);
                        const float tot = a.x + a.y + a.z + a.w + b.x + b.y + b.z + b.w + c.x + c.y + c.z + c.w + d.x + d.y + d.z + d.w;
                        scale = rsqrtf(tot * (1.0f / 512.0f) + EPS);
                    }
                    sc[ui * 1024 + r * 4 + h0 + hh] = scale;
                }
            }
        }
    }
    __syncthreads();
    pg8::Gemm g{p.ACT[4], p.W[W_RT_OUT], RPAD, D, E, 0};
    Pg8EpiRetOut ep{p.Z};
    pg8::gemm_phase((LAS unsigned char*)smem, g, so, ep);
}

__device__ __forceinline__ void lru_uload(uint4 (&ubuf)[7], const bf16_t* U, int bg, int c, int rg, int h, int cgp) {
    const int nrows = c < 16 ? 128 : 16;
    const int lr = rg * 4;
#pragma unroll
    for (int jj = 0; jj < 7; ++jj) {
        const int tt = c * 128 + lr - 3 + jj;
        ubuf[jj] = make_uint4(0u, 0u, 0u, 0u);
        if (lr < nrows && tt >= 0) ubuf[jj] = *(const uint4*)(U + (size_t)(bg * SEQT + tt) * E + h * 128 + cgp * 8);
    }
}
__device__ __forceinline__ void phase_lru(const Params& p, char* smem) {
    bf16_t* Al = (bf16_t*)smem;
    bf16_t* Bl = Al + 128 * 136;
    float* SA = (float*)(smem + 2 * 128 * 136 * 2);
    float* SB = SA + 128 * 64;
    float* SEG = SB + 128 * 64;
    float* CAR = SEG + 2 * 8 * 64;
    float* CWL = CAR + 128;
    float* EPL = CWL + 640;
    const int tid = opaque_tid(), lane = tid & 63, wave = tid >> 6, l15 = lane & 15, quad = lane >> 4;
    const int wm = wave >> 1, wn = wave & 1;
    const bf16_t* U = p.ACT[0]; const bf16_t* SG = p.ACT[1]; bf16_t* Y = p.ACT[2];
    for (int item = blockIdx.x; item < 512; item += gridDim.x) {
        const bool sample = item >= 256;
        const int it = item & 255, bg = it >> 5, h = (it >> 1) & 15, q = it & 1;
        const int chbase = h * 128 + q * 64;
#pragma unroll
        for (int i = 0; i < 4; ++i) {
            const int idx = tid + i * 512, row = idx >> 4, ch = idx & 15;
            *(uint4*)(Bl + row * 136 + ch * 8) = *(const uint4*)(p.W[W_LRU_G] + (size_t)(h * 256 + q * 128 + row) * 128 + ch * 8);
        }
        if (tid < 128) {
            CAR[tid] = 0.f;
            const int kch = h * 128 + tid;
#pragma unroll
            for (int j = 0; j < 4; ++j) CWL[j * 128 + tid] = p.in[I_LRU_CW][j * E + kch];
            CWL[4 * 128 + tid] = p.in[I_LRU_CB][kch];
        } else if (tid < 192) {
            const int cl = tid - 128, ch = chbase + cl;
            EPL[cl] = p.in[I_LRU_BA][ch]; EPL[64 + cl] = p.in[I_LRU_BX][ch]; EPL[128 + cl] = softplusf_(-p.in[I_LRU_LAM][ch]);
        }
        const int cgp = tid & 15, rg = tid >> 4;
        const int ntiles = sample ? 1 : 17;
        float hc = 0.f;
        uint4 ubuf[7];
        if (!sample) lru_uload(ubuf, U, bg, 0, rg, h, cgp);
        __syncthreads();
        for (int c = 0; c < ntiles; ++c) {
            const int nrows = sample ? 128 : (c < 16 ? 128 : 16);
#pragma unroll
            for (int ps = 0; ps < 2; ++ps) {
                const int lr = rg * 4 + ps * 2;
                if (lr < nrows) {
                    float uu[5][8];
#pragma unroll
                    for (int jj = 0; jj < 5; ++jj) {
                        uint4 raw = make_uint4(0u, 0u, 0u, 0u); bool have = true; float4 f0 = make_float4(0.f, 0.f, 0.f, 0.f), f1 = f0;
                        if (!sample) {
                            raw = ubuf[ps * 2 + jj];
                        } else {
                            const int sq = lr >> 3, ts = lr & 7, sb = bg * 16 + sq, ee = ts - 3 + jj;
                            if (ee >= 0) { raw = *(const uint4*)(U + (size_t)(RP + sb * 8 + ee) * E + h * 128 + cgp * 8); }
                            else { have = false; const float* s = p.in[I_ST_LRU_CONV] + ((size_t)sb * 3 + (3 + ee)) * E + h * 128 + cgp * 8; f0 = *(const float4*)s; f1 = *(const float4*)(s + 4); }
                        }
                        if (have) { f0.x = bflo(raw.x); f0.y = bfhi(raw.x); f0.z = bflo(raw.y); f0.w = bfhi(raw.y); f1.x = bflo(raw.z); f1.y = bfhi(raw.z); f1.z = bflo(raw.w); f1.w = bfhi(raw.w); }
                        uu[jj][0] = f0.x; uu[jj][1] = f0.y; uu[jj][2] = f0.z; uu[jj][3] = f0.w; uu[jj][4] = f1.x; uu[jj][5] = f1.y; uu[jj][6] = f1.z; uu[jj][7] = f1.w;
                    }
#pragma unroll
                    for (int rr = 0; rr < 2; ++rr) {
                        float xc[8];
#pragma unroll
                        for (int k = 0; k < 8; ++k) {
                            const int kc = cgp * 8 + k;
                            xc[k] = CWL[512 + kc] + CWL[kc] * uu[rr][k] + CWL[128 + kc] * uu[rr + 1][k] + CWL[256 + kc] * uu[rr + 2][k] + CWL[384 + kc] * uu[rr + 3][k];
                        }
                        uint4 o; o.x = pack2(xc[0], xc[1]); o.y = pack2(xc[2], xc[3]); o.z = pack2(xc[4], xc[5]); o.w = pack2(xc[6], xc[7]);
                        *(uint4*)(Al + (lr + rr) * 136 + cgp * 8) = o;
                    }
                } else {
#pragma unroll
                    for (int rr = 0; rr < 2; ++rr) *(uint4*)(Al + (lr + rr) * 136 + cgp * 8) = make_uint4(0u, 0u, 0u, 0u);
                }
            }
            __syncthreads();
            if (!sample && c + 1 < ntiles) lru_uload(ubuf, U, bg, c + 1, rg, h, cgp);
            f32x4 acc[2][4];
#pragma unroll
            for (int i = 0; i < 2; ++i)
#pragma unroll
                for (int j = 0; j < 4; ++j) acc[i][j] = (f32x4){0.f, 0.f, 0.f, 0.f};
#pragma unroll
            for (int kk = 0; kk < 4; ++kk) {
                bf16x8 af[2], bfr[4];
#pragma unroll
                for (int i = 0; i < 2; ++i) af[i] = *(const bf16x8*)(Al + (wm * 32 + i * 16 + l15) * 136 + kk * 32 + quad * 8);
#pragma unroll
                for (int j = 0; j < 4; ++j) bfr[j] = *(const bf16x8*)(Bl + (wn * 64 + j * 16 + l15) * 136 + kk * 32 + quad * 8);
#pragma unroll
                for (int i = 0; i < 2; ++i)
#pragma unroll
                    for (int j = 0; j < 4; ++j) acc[i][j] = mfma16(bfr[j], af[i], acc[i][j]);
            }
#pragma unroll
            for (int i = 0; i < 2; ++i) {
                const int row = wm * 32 + i * 16 + l15;
#pragma unroll
                for (int j = 0; j < 2; ++j) {
                    const int chl = wn * 32 + j * 16 + quad * 4;
                    const uint2 xr = *(const uint2*)(Al + row * 136 + q * 64 + chl);
                    const float xcv[4] = {bflo(xr.x), bfhi(xr.x), bflo(xr.y), bfhi(xr.y)};
                    f32x4 av, bv;
#pragma unroll
                    for (int e = 0; e < 4; ++e) {
                        const float gr = sigmoidf_(acc[i][j][e] + EPL[chl + e]), gi = sigmoidf_(acc[i][j + 2][e] + EPL[64 + chl + e]);
                        const float la = -8.0f * gr * EPL[128 + chl + e];
                        av[e] = __expf(la);
                        bv[e] = __builtin_amdgcn_sqrtf(fmaxf(1.0f - av[e] * av[e], 0.f)) * gi * xcv[e];
                    }
                    *(f32x4*)(SA + row * 64 + chl) = av;
                    *(f32x4*)(SB + row * 64 + chl) = bv;
                }
            }
            __syncthreads();
            const int ch = tid & 63, seg = tid >> 6;
            if (!sample) {
                float P = 1.f, H = 0.f;
#pragma unroll 4
                for (int rr = 0; rr < 16; ++rr) {
                    const int row = seg * 16 + rr;
                    if (row < nrows) { const float a = SA[row * 64 + ch], bx = SB[row * 64 + ch]; H = a * H + bx; P *= a; }
                }
                SEG[seg * 64 + ch] = P; SEG[512 + seg * 64 + ch] = H;
                __syncthreads();
                hc = CAR[(c & 1) * 64 + ch];
                for (int s2 = 0; s2 < seg; ++s2) hc = SEG[s2 * 64 + ch] * hc + SEG[512 + s2 * 64 + ch];
#pragma unroll
                for (int rr = 0; rr < 16; ++rr) {
                    const int row = seg * 16 + rr;
                    if (row < nrows) {
                        const float a = SA[row * 64 + ch], bx = SB[row * 64 + ch];
                        hc = a * hc + bx;
                        const size_t o = (size_t)(bg * SEQT + c * 128 + row) * E + chbase + ch;
                        Y[o] = f2bf(hc * bf2f(SG[o]));
                    }
                }
                if (seg == 7) CAR[((c + 1) & 1) * 64 + ch] = hc;
            } else {
#pragma unroll 1
                for (int sq = 0; sq < 2; ++sq) {
                    const int sb = bg * 16 + seg * 2 + sq;
                    float hh = p.in[I_ST_LRU_H][(size_t)sb * E + chbase + ch];
#pragma unroll 4
                    for (int t = 0; t < 8; ++t) {
                        const int row = seg * 16 + sq * 8 + t;
                        hh = SA[row * 64 + ch] * hh + SB[row * 64 + ch];
                        const size_t o = (size_t)(RP + sb * 8 + t) * E + chbase + ch;
                        Y[o] = f2bf(hh * bf2f(SG[o]));
                    }
                    p.out[O_S_LRU_H + (size_t)sb * E + chbase + ch] = hh;
                }
            }
        }
        if (!sample && (tid >> 6) == 7) p.out[O_P_LRU_H + (size_t)bg * E + chbase + (tid & 63)] = hc;
        __syncthreads();
    }
}

__device__ __forceinline__ void phase_s5(const Params& p, char* smem) {
    const int lane = opaque_tid() & 63, wave = opaque_tid() >> 6, l15 = lane & 15, quad = lane >> 4;
    float* BU = (float*)(smem + wave * 13312);
    bf16_t* XL = (bf16_t*)(smem + wave * 13312 + 8448);
    float* FL = (float*)(smem + wave * 13312 + 8448 + 4352);
    const bf16_t* U = p.ACT[0]; bf16_t* Y1 = p.ACT[2];
    const int slot4 = (wave & 3) * gridDim.x + blockIdx.x, nslots4 = 4 * gridDim.x;
    const int item_lo = wave < 4 ? 0 : 1024, item_hi = wave < 4 ? 1024 : 1024 + 16384;
    for (int item = item_lo + slot4; item < item_hi; item += nslots4) {
        const bool sample = item >= 1024;
        const int it = sample ? item - 1024 : item, b = it >> 7, g = it & 127;
        const int row0 = sample ? RP + b * 8 : b * SEQT, nsteps = sample ? 8 : SEQT;
        const int n = lane;
        const float dt = __expf(p.in[I_S5_LOGDT][g]);
        const float are = p.in[I_S5_ARE][g * 64 + n], aim = p.in[I_S5_AIM][g * 64 + n];
        const float mag = __expf(dt * are), ang = dt * aim;
        const float abr = mag * __cosf(ang), abi = mag * __sinf(ang);
        const float den = are * are + aim * aim;
        FL[n] = ((abr - 1.0f) * are + abi * aim) / den;
        FL[64 + n] = (abi * are - (abr - 1.0f) * aim) / den;
        wave_lds_sync();
        bf16x8 bbf[8];
#pragma unroll
        for (int grp = 0; grp < 4; ++grp) {
            bbf[grp] = (bf16x8){0, 0, 0, 0, 0, 0, 0, 0}; bbf[grp + 4] = bbf[grp];
            if (quad < 2) {
                const int np = grp * 16 + l15;
                const float fr_ = FL[np], fi_ = FL[64 + np];
                const float* br = p.in[I_S5_BRE] + ((size_t)g * 64 + np) * 16 + quad * 8;
                const float* bi = p.in[I_S5_BIM] + ((size_t)g * 64 + np) * 16 + quad * 8;
                const float4 r0 = *(const float4*)br, r1 = *(const float4*)(br + 4), i0 = *(const float4*)bi, i1 = *(const float4*)(bi + 4);
                const float rr[8] = {r0.x, r0.y, r0.z, r0.w, r1.x, r1.y, r1.z, r1.w}, ii[8] = {i0.x, i0.y, i0.z, i0.w, i1.x, i1.y, i1.z, i1.w};
#pragma unroll
                for (int k = 0; k < 8; ++k) { bbf[grp][k] = (short)f2bf(fr_ * rr[k] - fi_ * ii[k]); bbf[grp + 4][k] = (short)f2bf(fr_ * ii[k] + fi_ * rr[k]); }
            }
        }
        bf16x8 cf[4];
#pragma unroll
        for (int kb = 0; kb < 4; ++kb) {
            const float* src = (kb < 2 ? p.in[I_S5_CRE] : p.in[I_S5_CIM]) + ((size_t)g * 16 + l15) * 64 + (kb & 1) * 32 + quad * 8;
            const float sgn = kb < 2 ? 1.0f : -1.0f;
            const float4 c0 = *(const float4*)src, c1 = *(const float4*)(src + 4);
            cf[kb][0] = (short)f2bf(sgn * c0.x); cf[kb][1] = (short)f2bf(sgn * c0.y); cf[kb][2] = (short)f2bf(sgn * c0.z); cf[kb][3] = (short)f2bf(sgn * c0.w);
            cf[kb][4] = (short)f2bf(sgn * c1.x); cf[kb][5] = (short)f2bf(sgn * c1.y); cf[kb][6] = (short)f2bf(sgn * c1.z); cf[kb][7] = (short)f2bf(sgn * c1.w);
        }
        const float4 dd = *(const float4*)(p.in[I_S5_D] + g * 16 + quad * 4);
        float xr = 0.f, xi = 0.f;
        if (sample) { xr = p.in[I_ST_S5_RE][((size_t)b * 128 + g) * 64 + n]; xi = p.in[I_ST_S5_IM][((size_t)b * 128 + g) * 64 + n]; }
        uint4 ufn = make_uint4(0u, 0u, 0u, 0u); uint2 udn = make_uint2(0u, 0u);
        if (l15 < nsteps) {
            if (quad < 2) ufn = *(const uint4*)(U + (size_t)(row0 + l15) * E + g * 16 + quad * 8);
            udn = *(const uint2*)(U + (size_t)(row0 + l15) * E + g * 16 + quad * 4);
        }
        for (int tt = 0; tt < nsteps; tt += 16) {
            const int nv = min(16, nsteps - tt);
            const uint4 ufc = ufn; const uint2 udc = udn;
            ufn = make_uint4(0u, 0u, 0u, 0u); udn = make_uint2(0u, 0u);
            if (tt + 16 + l15 < nsteps) {
                if (quad < 2) ufn = *(const uint4*)(U + (size_t)(row0 + tt + 16 + l15) * E + g * 16 + quad * 8);
                udn = *(const uint2*)(U + (size_t)(row0 + tt + 16 + l15) * E + g * 16 + quad * 4);
            }
            bf16x8 uf;
            uf[0] = (short)(ufc.x & 0xffffu); uf[1] = (short)(ufc.x >> 16); uf[2] = (short)(ufc.y & 0xffffu); uf[3] = (short)(ufc.y >> 16);
            uf[4] = (short)(ufc.z & 0xffffu); uf[5] = (short)(ufc.z >> 16); uf[6] = (short)(ufc.w & 0xffffu); uf[7] = (short)(ufc.w >> 16);
#pragma unroll
            for (int blk = 0; blk < 8; ++blk) {
                const f32x4 r = mfma16(bbf[blk], uf, (f32x4){0.f, 0.f, 0.f, 0.f});
                *(f32x4*)(BU + l15 * 132 + blk * 16 + quad * 4) = r;
            }
            wave_lds_sync();
            float bur[16], bui[16];
#pragma unroll
            for (int t = 0; t < 16; ++t) { bur[t] = BU[t * 132 + n]; bui[t] = BU[t * 132 + 64 + n]; }
#pragma unroll
            for (int t = 0; t < 16; ++t) {
                if (t < nv) {
                    const float nxr = abr * xr - abi * xi + bur[t], nxi = abr * xi + abi * xr + bui[t];
                    xr = nxr; xi = nxi;
                }
                XL[t * 136 + n] = f2bf(xr); XL[t * 136 + 64 + n] = f2bf(xi);
            }
            wave_lds_sync();
            f32x4 acc = (f32x4){0.f, 0.f, 0.f, 0.f};
#pragma unroll
            for (int kb = 0; kb < 4; ++kb) {
                const bf16x8 xf = *(const bf16x8*)(XL + l15 * 136 + kb * 32 + quad * 8);
                acc = mfma16(cf[kb], xf, acc);
            }
            if (l15 < nv) {
                f32x4 y; y[0] = acc[0] + dd.x * bflo(udc.x); y[1] = acc[1] + dd.y * bfhi(udc.x); y[2] = acc[2] + dd.z * bflo(udc.y); y[3] = acc[3] + dd.w * bfhi(udc.y);
#pragma unroll
                for (int e = 0; e < 4; ++e) { const float v = y[e]; y[e] = 0.5f * v * (1.0f + tanhf_(0.7978845608028654f * (v + 0.044715f * v * v * v))); }
                *(uint2*)(Y1 + (size_t)(row0 + tt + l15) * E + g * 16 + quad * 4) = pack4(y);
            }
            wave_lds_sync();
        }
        float* o = p.out + (sample ? O_S_S5_RE : O_P_S5_RE) + ((size_t)b * 128 + g) * 64 + n;
        o[0] = xr;
        o[(sample ? O_S_S5_IM - O_S_S5_RE : O_P_S5_IM - O_P_S5_RE)] = xi;
    }
}

typedef float f32x2 __attribute__((ext_vector_type(2)));
__device__ __forceinline__ float half_sum(float v) {
#pragma unroll
    for (int o = 16; o > 0; o >>= 1) v += __shfl_xor(v, o, 64);
    return v;
}
__device__ __forceinline__ float dpp_sum8(float x) {
    x += __int_as_float(__builtin_amdgcn_mov_dpp(__float_as_int(x), 0xB1, 0xf, 0xf, true));
    x += __int_as_float(__builtin_amdgcn_mov_dpp(__float_as_int(x), 0x4E, 0xf, 0xf, true));
    x += __int_as_float(__builtin_amdgcn_mov_dpp(__float_as_int(x), 0x141, 0xf, 0xf, true));
    return x;
}
struct RwItem { int sample, b, h, row0, nsteps; };
__device__ __forceinline__ RwItem rw_decode(int item) {
    RwItem r; r.sample = item >= 256; const int it = r.sample ? item - 256 : item; r.b = it >> 5; r.h = it & 31;
    r.row0 = r.sample ? RP + r.b * 8 : r.b * SEQT; r.nsteps = r.sample ? 8 : SEQT; return r;
}
constexpr int RW_NIT = 256 + 4096;
struct RwTile { int item, tt, have; };
__device__ __forceinline__ RwTile rw_next(const RwTile& c) {
    RwTile n = c;
    if (!c.have) return n;
    const int nsteps = c.item >= 256 ? 8 : SEQT;
    n.tt = c.tt + 16;
    if (n.tt >= nsteps) { n.item = c.item + gridDim.x; n.tt = 0; n.have = n.item < RW_NIT; }
    return n;
}
struct RwPre { unsigned r2, k2, v2, d2, a2, g2; float2 kkp, kap, rkp, lnw, lnb; size_t o; int valid; };
struct RwEpi { unsigned g2; float2 lnw, lnb; size_t o; int valid; };
__device__ __forceinline__ void rw_load(RwPre& q, const Params& p, const RwTile& tl, int pt, int c2) {
    const RwItem it = rw_decode(tl.have ? tl.item : 0);
    const int chh = it.h * 64 + c2 * 2;
    q.valid = tl.have && (tl.tt + pt) < it.nsteps;
    q.o = (size_t)(it.row0 + tl.tt + pt) * E + chh;
    q.r2 = q.k2 = q.v2 = q.d2 = q.a2 = q.g2 = 0u;
    if (q.valid) {
        q.r2 = *(const unsigned*)(p.ACT[0] + q.o); q.k2 = *(const unsigned*)(p.ACT[1] + q.o); q.v2 = *(const unsigned*)(p.ACT[2] + q.o);
        q.g2 = *(const unsigned*)(p.ACT[3] + q.o); q.d2 = *(const unsigned*)(p.ACT[4] + q.o); q.a2 = *(const unsigned*)(p.ACT[5] + q.o);
    }
    q.kkp = *(const float2*)(p.in[I_RW_KK] + chh); q.kap = *(const float2*)(p.in[I_RW_KA] + chh); q.rkp = *(const float2*)(p.in[I_RW_RK] + chh);
    q.lnw = *(const float2*)(p.in[I_RW_LNW] + chh); q.lnb = *(const float2*)(p.in[I_RW_LNB] + chh);
}
__device__ __forceinline__ float row_sum16(float x) {
    x += __int_as_float(__builtin_amdgcn_mov_dpp(__float_as_int(x), 0xB1, 0xf, 0xf, true));
    x += __int_as_float(__builtin_amdgcn_mov_dpp(__float_as_int(x), 0x4E, 0xf, 0xf, true));
    x += __int_as_float(__builtin_amdgcn_mov_dpp(__float_as_int(x), 0x141, 0xf, 0xf, true));
    x += __int_as_float(__builtin_amdgcn_mov_dpp(__float_as_int(x), 0x140, 0xf, 0xf, true));
    return x;
}
__device__ __forceinline__ float half_sum32(float x) { x = row_sum16(x); return x + __shfl_xor(x, 16, 64); }
__device__ __forceinline__ void rw_store(const RwPre& q, float* VEC, float* VV, float* BON, int pt, int c2) {
    const float r0 = bflo(q.r2), r1 = bfhi(q.r2), k0 = bflo(q.k2), k1 = bfhi(q.k2), a0 = bflo(q.a2), a1 = bfhi(q.a2);
    const float w0 = __expf(-bflo(q.d2)), w1 = __expf(-bfhi(q.d2));
    float kk0 = k0 * q.kkp.x, kk1 = k1 * q.kkp.y;
    const float ss = half_sum32(kk0 * kk0 + kk1 * kk1);
    const float inv = rsqrtf(fmaxf(ss, 1e-24f));
    kk0 *= inv; kk1 *= inv;
    const float km0 = k0 * (1.0f + (a0 - 1.0f) * q.kap.x), km1 = k1 * (1.0f + (a1 - 1.0f) * q.kap.y);
    const float bon = half_sum32(r0 * km0 * q.rkp.x + r1 * km1 * q.rkp.y);
    float* ve = VEC + pt * 320 + c2 * 2;
    *(float2*)(ve) = make_float2(w0, w1);
    *(float2*)(ve + 64) = make_float2(-kk0, -kk1);
    *(float2*)(ve + 128) = make_float2(kk0 * a0, kk1 * a1);
    *(float2*)(ve + 192) = make_float2(km0, km1);
    *(float2*)(ve + 256) = make_float2(r0, r1);
    *(float2*)(VV + pt * 64 + c2 * 2) = make_float2(bflo(q.v2), bfhi(q.v2));
    if (c2 == 0) BON[pt] = bon;
}
__device__ __forceinline__ void rw_epilogue(const RwEpi& e, const Params& p, const float* VV, const float* BON, const float* YL, int pt, int c2) {
    const float2 yy = *(const float2*)(YL + pt * 64 + c2 * 2);
    const float mean = half_sum32(yy.x + yy.y) * (1.0f / 64.0f);
    const float d0 = yy.x - mean, d1 = yy.y - mean;
    const float var = half_sum32(d0 * d0 + d1 * d1) * (1.0f / 64.0f);
    const float rstd = rsqrtf(var + 64e-5f);
    if (e.valid) {
        const float2 v2 = *(const float2*)(VV + pt * 64 + c2 * 2);
        const float bon = BON[pt];
        const float o0 = (d0 * rstd * e.lnw.x + e.lnb.x + bon * v2.x) * bflo(e.g2);
        const float o1 = (d1 * rstd * e.lnw.y + e.lnb.y + bon * v2.y) * bfhi(e.g2);
        *(unsigned*)(p.ACT[6] + e.o) = pack2(o0, o1);
    }
}
__device__ __forceinline__ RwEpi rw_epi_of(const RwPre& q) { RwEpi e; e.g2 = q.g2; e.lnw = q.lnw; e.lnb = q.lnb; e.o = q.o; e.valid = q.valid; return e; }
struct RwVec { f32x4 w[2], a[2], b[2], k[2], r[2]; float2 vv; };
__device__ __forceinline__ void rw_vload(RwVec& q, const float* VEC, const float* VV, int t, int oct, int v0) {
    const float* ve = VEC + t * 320 + oct * 8;
    q.w[0] = *(const f32x4*)ve; q.w[1] = *(const f32x4*)(ve + 4);
    q.a[0] = *(const f32x4*)(ve + 64); q.a[1] = *(const f32x4*)(ve + 68);
    q.b[0] = *(const f32x4*)(ve + 128); q.b[1] = *(const f32x4*)(ve + 132);
    q.k[0] = *(const f32x4*)(ve + 192); q.k[1] = *(const f32x4*)(ve + 196);
    q.r[0] = *(const f32x4*)(ve + 256); q.r[1] = *(const f32x4*)(ve + 260);
    q.vv = *(const float2*)(VV + t * 64 + v0);
}
__device__ __forceinline__ void rw_step(f32x2 (&S)[2][4], const RwVec& q, float* YL, int t, int oct, int v0) {
    const f32x2 a0 = (f32x2){q.a[0][0], q.a[0][1]}, a1 = (f32x2){q.a[0][2], q.a[0][3]}, a2 = (f32x2){q.a[1][0], q.a[1][1]}, a3 = (f32x2){q.a[1][2], q.a[1][3]};
    const f32x2 sp0 = S[0][0] * a0 + S[0][1] * a1 + S[0][2] * a2 + S[0][3] * a3;
    const f32x2 sp1 = S[1][0] * a0 + S[1][1] * a1 + S[1][2] * a2 + S[1][3] * a3;
    const float sa0 = dpp_sum8(sp0[0] + sp0[1]), sa1 = dpp_sum8(sp1[0] + sp1[1]);
    const f32x2 w0 = (f32x2){q.w[0][0], q.w[0][1]}, w1 = (f32x2){q.w[0][2], q.w[0][3]}, w2 = (f32x2){q.w[1][0], q.w[1][1]}, w3 = (f32x2){q.w[1][2], q.w[1][3]};
    const f32x2 b0 = (f32x2){q.b[0][0], q.b[0][1]}, b1 = (f32x2){q.b[0][2], q.b[0][3]}, b2 = (f32x2){q.b[1][0], q.b[1][1]}, b3 = (f32x2){q.b[1][2], q.b[1][3]};
    const f32x2 k0 = (f32x2){q.k[0][0], q.k[0][1]}, k1 = (f32x2){q.k[0][2], q.k[0][3]}, k2 = (f32x2){q.k[1][0], q.k[1][1]}, k3 = (f32x2){q.k[1][2], q.k[1][3]};
    {
        const f32x2 sa2 = (f32x2){sa0, sa0}, vv2 = (f32x2){q.vv.x, q.vv.x};
        S[0][0] = S[0][0] * w0 + sa2 * b0 + vv2 * k0; S[0][1] = S[0][1] * w1 + sa2 * b1 + vv2 * k1;
        S[0][2] = S[0][2] * w2 + sa2 * b2 + vv2 * k2; S[0][3] = S[0][3] * w3 + sa2 * b3 + vv2 * k3;
    }
    {
        const f32x2 sa2 = (f32x2){sa1, sa1}, vv2 = (f32x2){q.vv.y, q.vv.y};
        S[1][0] = S[1][0] * w0 + sa2 * b0 + vv2 * k0; S[1][1] = S[1][1] * w1 + sa2 * b1 + vv2 * k1;
        S[1][2] = S[1][2] * w2 + sa2 * b2 + vv2 * k2; S[1][3] = S[1][3] * w3 + sa2 * b3 + vv2 * k3;
    }
    const f32x2 r0 = (f32x2){q.r[0][0], q.r[0][1]}, r1 = (f32x2){q.r[0][2], q.r[0][3]}, r2 = (f32x2){q.r[1][0], q.r[1][1]}, r3 = (f32x2){q.r[1][2], q.r[1][3]};
    const f32x2 yp0 = S[0][0] * r0 + S[0][1] * r1 + S[0][2] * r2 + S[0][3] * r3;
    const f32x2 yp1 = S[1][0] * r0 + S[1][1] * r1 + S[1][2] * r2 + S[1][3] * r3;
    const float y0 = dpp_sum8(yp0[0] + yp0[1]), y1 = dpp_sum8(yp1[0] + yp1[1]);
    if (oct == 0) *(float2*)(YL + t * 64 + v0) = make_float2(y0, y1);
}
__device__ __forceinline__ void phase_rwkv(const Params& p, char* smem) {
    constexpr int BUF_F = 16 * 5 * 64 + 16 * 64 + 64 + 16 * 64;
    float* base = (float*)smem;
    const int tid = opaque_tid(), lane = tid & 63, wave = tid >> 6;
    const bool scanner = wave < 4;
    const int oct = lane & 7, v0 = (wave & 3) * 16 + (lane >> 3) * 2;
    const int hid = tid & 255, pt0 = hid >> 5, c2 = hid & 31;
    RwTile tk; tk.item = blockIdx.x; tk.tt = 0; tk.have = blockIdx.x < RW_NIT;
    f32x2 S[2][4], Sn[2][4];
#pragma unroll
    for (int r = 0; r < 2; ++r)
#pragma unroll
        for (int i = 0; i < 4; ++i) { S[r][i] = (f32x2){0.f, 0.f}; Sn[r][i] = S[r][i]; }
    RwPre preN[2]; RwEpi epiP[2], epiC[2];
    epiP[0].valid = 0; epiP[1].valid = 0; epiP[0].o = 0; epiP[1].o = 0; epiP[0].g2 = 0; epiP[1].g2 = 0;
    epiP[0].lnw = epiP[0].lnb = epiP[1].lnw = epiP[1].lnb = make_float2(0.f, 0.f);
    epiC[0] = epiP[0]; epiC[1] = epiP[1];
    if (scanner) {
        const RwItem it = rw_decode(tk.have ? tk.item : 0);
        if (tk.have && it.sample) {
#pragma unroll
            for (int r = 0; r < 2; ++r) {
                const float* st = p.in[I_ST_RW_WKV] + (((size_t)it.b * 32 + it.h) * 64 + v0 + r) * 64 + oct * 8;
                const float4 s0 = *(const float4*)st, s1 = *(const float4*)(st + 4);
                Sn[r][0] = (f32x2){s0.x, s0.y}; Sn[r][1] = (f32x2){s0.z, s0.w}; Sn[r][2] = (f32x2){s1.x, s1.y}; Sn[r][3] = (f32x2){s1.z, s1.w};
            }
        }
    } else {
        RwPre pre0[2];
        rw_load(pre0[0], p, tk, pt0, c2); rw_load(pre0[1], p, tk, pt0 + 8, c2);
        const RwTile t1 = rw_next(tk);
        rw_load(preN[0], p, t1, pt0, c2); rw_load(preN[1], p, t1, pt0 + 8, c2);
        rw_store(pre0[0], base, base + 5120, base + 6144, pt0, c2); rw_store(pre0[1], base, base + 5120, base + 6144, pt0 + 8, c2);
        epiC[0] = rw_epi_of(pre0[0]); epiC[1] = rw_epi_of(pre0[1]);
    }
    __syncthreads();
    int kb = 0;
    bool first = true;
    while (tk.have) {
        const RwTile t1 = rw_next(tk);
        const int kn = kb == 2 ? 0 : kb + 1, kp = kb == 0 ? 2 : kb - 1;
        if (scanner) {
            const RwItem cur = rw_decode(tk.item);
            f32x2 Snn[2][4];
#pragma unroll
            for (int r = 0; r < 2; ++r)
#pragma unroll
                for (int i = 0; i < 4; ++i) Snn[r][i] = (f32x2){0.f, 0.f};
            if (t1.have && t1.tt == 0 && t1.item >= 256) {
                const RwItem nx = rw_decode(t1.item);
#pragma unroll
                for (int r = 0; r < 2; ++r) {
                    const float* st = p.in[I_ST_RW_WKV] + (((size_t)nx.b * 32 + nx.h) * 64 + v0 + r) * 64 + oct * 8;
                    const float4 s0 = *(const float4*)st, s1 = *(const float4*)(st + 4);
                    Snn[r][0] = (f32x2){s0.x, s0.y}; Snn[r][1] = (f32x2){s0.z, s0.w}; Snn[r][2] = (f32x2){s1.x, s1.y}; Snn[r][3] = (f32x2){s1.z, s1.w};
                }
            }
            if (tk.tt == 0) {
#pragma unroll
                for (int r = 0; r < 2; ++r)
#pragma unroll
                    for (int i = 0; i < 4; ++i) S[r][i] = Sn[r][i];
            }
            {
                const float* VEC = base + kb * BUF_F; const float* VV = VEC + 5120; float* YL = base + kb * BUF_F + 6144 + 64;
                const int nv = min(16, cur.nsteps - tk.tt);
                RwVec A, B;
                rw_vload(A, VEC, VV, 0, oct, v0);
                for (int t = 0; t < nv; t += 2) {
                    rw_vload(B, VEC, VV, t + 1, oct, v0);
                    rw_step(S, A, YL, t, oct, v0);
                    rw_vload(A, VEC, VV, t + 2, oct, v0);
                    rw_step(S, B, YL, t + 1, oct, v0);
                }
            }
            if (tk.tt + 16 >= cur.nsteps) {
#pragma unroll
                for (int r = 0; r < 2; ++r) {
                    float* dst = p.out + (cur.sample ? O_S_RW_WKV : O_P_RW_WKV) + (((size_t)cur.b * 32 + cur.h) * 64 + v0 + r) * 64 + oct * 8;
                    *(float4*)dst = make_float4(S[r][0][0], S[r][0][1], S[r][1][0], S[r][1][1]);
                    *(float4*)(dst + 4) = make_float4(S[r][2][0], S[r][2][1], S[r][3][0], S[r][3][1]);
                }
            }
            if (t1.tt == 0) {
#pragma unroll
                for (int r = 0; r < 2; ++r)
#pragma unroll
                    for (int i = 0; i < 4; ++i) Sn[r][i] = Snn[r][i];
            }
        } else {
            float* Bn = base + kn * BUF_F;
            rw_store(preN[0], Bn, Bn + 5120, Bn + 6144, pt0, c2); rw_store(preN[1], Bn, Bn + 5120, Bn + 6144, pt0 + 8, c2);
            RwEpi epiN[2]; epiN[0] = rw_epi_of(preN[0]); epiN[1] = rw_epi_of(preN[1]);
            const RwTile t2 = rw_next(t1);
            rw_load(preN[0], p, t2, pt0, c2); rw_load(preN[1], p, t2, pt0 + 8, c2);
            if (!first) {
                const float* Bp = base + kp * BUF_F;
                rw_epilogue(epiP[0], p, Bp + 5120, Bp + 6144, Bp + 6144 + 64, pt0, c2); rw_epilogue(epiP[1], p, Bp + 5120, Bp + 6144, Bp + 6144 + 64, pt0 + 8, c2);
            }
            epiP[0] = epiC[0]; epiP[1] = epiC[1]; epiC[0] = epiN[0]; epiC[1] = epiN[1];
        }
        __syncthreads();
        tk = t1; kb = kn; first = false;
    }
    if (!scanner && !first) {
        const int kp = kb == 0 ? 2 : kb - 1;
        const float* Bp = base + kp * BUF_F;
        rw_epilogue(epiP[0], p, Bp + 5120, Bp + 6144, Bp + 6144 + 64, pt0, c2); rw_epilogue(epiP[1], p, Bp + 5120, Bp + 6144, Bp + 6144 + 64, pt0 + 8, c2);
    }
}

__device__ __forceinline__ void ret_gload(uint4 (&qn)[4], uint4 (&kn)[4], uint4& vn, const bf16_t* Q, const bf16_t* Kg, const bf16_t* V,
                                          int row0, int c0, int nsteps, int h, int s, int tid, int lane, int wave) {
    const int Lv = min(64, nsteps - c0);
#pragma unroll
    for (int i4 = 0; i4 < 4; ++i4) {
        const int idx = tid + i4 * 512, row = idx >> 5, kc = (idx & 31) * 8;
        qn[i4] = make_uint4(0u, 0u, 0u, 0u); kn[i4] = qn[i4];
        if (row < Lv) qn[i4] = *(const uint4*)(Q + (size_t)(row0 + c0 + row) * D + h * 256 + kc);
        if (lane < Lv) kn[i4] = *(const uint4*)(Kg + (size_t)(row0 + c0 + lane) * D + h * 256 + (wave + i4 * 8) * 8);
    }
    vn = make_uint4(0u, 0u, 0u, 0u);
    if (lane < Lv) vn = *(const uint4*)(V + (size_t)(row0 + c0 + lane) * E + h * 512 + s * 64 + wave * 8);
}
__device__ __forceinline__ void phase_ret(const Params& p, char* smem) {
    bf16_t* Ql = (bf16_t*)smem;
    bf16_t* Kl = Ql + 64 * 264;
    bf16_t* VT = Kl + 256 * 72;
    bf16_t* Pl = VT + 64 * 72;
    bf16_t* ST = Pl + 64 * 72;
    const int tid = opaque_tid(), lane = tid & 63, wave = tid >> 6, l15 = lane & 15, quad = lane >> 4;
    const bf16_t* Q = p.ACT[0]; const bf16_t* Kg = p.ACT[1]; const bf16_t* V = p.ACT[2]; bf16_t* Y = p.ACT[4];
    for (int item = blockIdx.x; item < 256 + 4096; item += gridDim.x) {
        const bool sample = item >= 256;
        const int it = sample ? item - 256 : item, b = it >> 5, h = (it >> 3) & 3, s = it & 7;
        const int row0 = sample ? RP + b * 8 : b * SEQT, nsteps = sample ? 8 : SEQT;
        const float lg2 = log2f(1.0f - exp2f(-5.0f - (float)h));
        f32x4 accS[2][4];
        const size_t sbase = (((size_t)b * 4 + h) * 256 + wave * 32 + quad * 4) * 512 + s * 64 + l15;
#pragma unroll
        for (int i = 0; i < 2; ++i)
#pragma unroll
            for (int j = 0; j < 4; ++j) {
                if (sample) {
#pragma unroll
                    for (int e = 0; e < 4; ++e) accS[i][j][e] = p.in[I_ST_RET][sbase + (size_t)(i * 16 + e) * 512 + j * 16];
                } else accS[i][j] = (f32x4){0.f, 0.f, 0.f, 0.f};
            }
#pragma unroll
        for (int i = 0; i < 2; ++i)
#pragma unroll
            for (int j = 0; j < 4; ++j) *(uint2*)(ST + (j * 16 + l15) * 264 + wave * 32 + i * 16 + quad * 4) = pack4(accS[i][j]);
        uint4 qn[4], kn[4], vn;
        ret_gload(qn, kn, vn, Q, Kg, V, row0, 0, nsteps, h, s, tid, lane, wave);
        for (int c0 = 0; c0 < nsteps; c0 += 64) {
            const int Lv = min(64, nsteps - c0);
            uint4 kq[4];
#pragma unroll
            for (int i4 = 0; i4 < 4; ++i4) {
                const int idx = tid + i4 * 512, row = idx >> 5, kc = (idx & 31) * 8;
                kq[i4] = kn[i4];
                *(uint4*)(Ql + row * 264 + kc) = qn[i4];
                *(uint4*)(Kl + lane * 264 + (wave + i4 * 8) * 8) = kq[i4];
            }
            {
                const int row = lane, dvc = wave * 8; const uint4 vv = vn;
                VT[(dvc + 0) * 72 + row] = (bf16_t)(vv.x & 0xffffu); VT[(dvc + 1) * 72 + row] = (bf16_t)(vv.x >> 16);
                VT[(dvc + 2) * 72 + row] = (bf16_t)(vv.y & 0xffffu); VT[(dvc + 3) * 72 + row] = (bf16_t)(vv.y >> 16);
                VT[(dvc + 4) * 72 + row] = (bf16_t)(vv.z & 0xffffu); VT[(dvc + 5) * 72 + row] = (bf16_t)(vv.z >> 16);
                VT[(dvc + 6) * 72 + row] = (bf16_t)(vv.w & 0xffffu); VT[(dvc + 7) * 72 + row] = (bf16_t)(vv.w >> 16);
            }
            __syncthreads();
            if (c0 + 64 < nsteps) ret_gload(qn, kn, vn, Q, Kg, V, row0, c0 + 64, nsteps, h, s, tid, lane, wave);
            uint2 gpre[2];
#pragma unroll
            for (int d2 = 0; d2 < 2; ++d2)
                gpre[d2] = *(const uint2*)(p.ACT[3] + (size_t)(row0 + c0 + (wave >> 1) * 16 + l15) * E + h * 512 + s * 64 + ((wave & 1) * 2 + d2) * 16 + quad * 4);
            {
                const int ti = wave >> 1, t_abs = ti * 16 + l15;
#pragma unroll
                for (int s2 = 0; s2 < 2; ++s2) {
                    const int si = (wave & 1) * 2 + s2;
                    f32x4 acc = (f32x4){0.f, 0.f, 0.f, 0.f};
#pragma unroll
                    for (int kb = 0; kb < 8; ++kb) {
                        const bf16x8 kf = *(const bf16x8*)(Kl + (si * 16 + l15) * 264 + kb * 32 + quad * 8);
                        const bf16x8 qf = *(const bf16x8*)(Ql + (ti * 16 + l15) * 264 + kb * 32 + quad * 8);
                        acc = mfma16(kf, qf, acc);
                    }
                    f32x4 pv;
#pragma unroll
                    for (int e = 0; e < 4; ++e) { const int s_abs = si * 16 + quad * 4 + e; pv[e] = s_abs <= t_abs ? acc[e] * exp2f((float)(t_abs - s_abs) * lg2) : 0.f; }
                    *(uint2*)(Pl + t_abs * 72 + si * 16 + quad * 4) = pack4(pv);
                }
            }
            __syncthreads();
#pragma unroll
            for (int i4 = 0; i4 < 4; ++i4) {
                const int row = lane, kc = (wave + i4 * 8) * 8;
                const float wgt = row < Lv ? exp2f((float)(Lv - 1 - row) * lg2) : 0.f;
                const uint4 kv = kq[i4];
                Kl[(kc + 0) * 72 + row] = f2bf(bflo(kv.x) * wgt); Kl[(kc + 1) * 72 + row] = f2bf(bfhi(kv.x) * wgt);
                Kl[(kc + 2) * 72 + row] = f2bf(bflo(kv.y) * wgt); Kl[(kc + 3) * 72 + row] = f2bf(bfhi(kv.y) * wgt);
                Kl[(kc + 4) * 72 + row] = f2bf(bflo(kv.z) * wgt); Kl[(kc + 5) * 72 + row] = f2bf(bfhi(kv.z) * wgt);
                Kl[(kc + 6) * 72 + row] = f2bf(bflo(kv.w) * wgt); Kl[(kc + 7) * 72 + row] = f2bf(bfhi(kv.w) * wgt);
            }
            __syncthreads();
            {
                const int ti = wave >> 1, t_abs = ti * 16 + l15;
                const float dec = exp2f((float)(t_abs + 1) * lg2);
                float ssq = 0.f;
#pragma unroll
                for (int d2 = 0; d2 < 2; ++d2) {
                    const int dvt = (wave & 1) * 2 + d2;
                    f32x4 a1 = (f32x4){0.f, 0.f, 0.f, 0.f}, a2 = a1;
#pragma unroll
                    for (int kb = 0; kb < 2; ++kb) {
                        const bf16x8 vf = *(const bf16x8*)(VT + (dvt * 16 + l15) * 72 + kb * 32 + quad * 8);
                        const bf16x8 pf = *(const bf16x8*)(Pl + (ti * 16 + l15) * 72 + kb * 32 + quad * 8);
                        a1 = mfma16(vf, pf, a1);
                    }
#pragma unroll
                    for (int kb = 0; kb < 8; ++kb) {
                        const bf16x8 sf = *(const bf16x8*)(ST + (dvt * 16 + l15) * 264 + kb * 32 + quad * 8);
                        const bf16x8 qf = *(const bf16x8*)(Ql + (ti * 16 + l15) * 264 + kb * 32 + quad * 8);
                        a2 = mfma16(sf, qf, a2);
                    }
                    f32x4 yv;
#pragma unroll
                    for (int e = 0; e < 4; ++e) { yv[e] = a1[e] + dec * a2[e]; ssq += yv[e] * yv[e]; }
                    if (t_abs < Lv) {
                        const size_t yo = (size_t)(row0 + c0 + t_abs) * E + h * 512 + s * 64 + dvt * 16 + quad * 4;
                        const uint2 gg = gpre[d2];
                        yv[0] *= bflo(gg.x); yv[1] *= bfhi(gg.x); yv[2] *= bflo(gg.y); yv[3] *= bfhi(gg.y);
                        *(uint2*)(Y + yo) = pack4(yv);
                    }
                }
                ssq += __shfl_xor(ssq, 16, 64); ssq += __shfl_xor(ssq, 32, 64);
                if (quad == 0 && t_abs < Lv) p.SSP[(size_t)(row0 + c0 + t_abs) * 64 + h * 16 + s * 2 + (wave & 1)] = ssq;
            }
            {
                const float dL = exp2f((float)Lv * lg2);
#pragma unroll
                for (int i = 0; i < 2; ++i)
#pragma unroll
                    for (int j = 0; j < 4; ++j) accS[i][j] *= dL;
#pragma unroll
                for (int kb = 0; kb < 2; ++kb) {
                    bf16x8 kf[2], vf[4];
#pragma unroll
                    for (int i = 0; i < 2; ++i) kf[i] = *(const bf16x8*)(Kl + (wave * 32 + i * 16 + l15) * 72 + kb * 32 + quad * 8);
#pragma unroll
                    for (int j = 0; j < 4; ++j) vf[j] = *(const bf16x8*)(VT + (j * 16 + l15) * 72 + kb * 32 + quad * 8);
#pragma unroll
                    for (int i = 0; i < 2; ++i)
#pragma unroll
                        for (int j = 0; j < 4; ++j) accS[i][j] = mfma16(kf[i], vf[j], accS[i][j]);
                }
            }
            __syncthreads();
#pragma unroll
            for (int i = 0; i < 2; ++i)
#pragma unroll
                for (int j = 0; j < 4; ++j) *(uint2*)(ST + (j * 16 + l15) * 264 + wave * 32 + i * 16 + quad * 4) = pack4(accS[i][j]);
        }
        float* dst = p.out + (sample ? O_S_RET : O_P_RET);
#pragma unroll
        for (int i = 0; i < 2; ++i)
#pragma unroll
            for (int j = 0; j < 4; ++j)
#pragma unroll
                for (int e = 0; e < 4; ++e) dst[sbase + (size_t)(i * 16 + e) * 512 + j * 16] = accS[i][j][e];
        __syncthreads();
    }
}

#define XB_TMO      128
#define XB_XCNT(j)  (256  + 64 * (j))
#define XB_XSUB(j)  (1280 + 64 * (j))
#define XB_XGEN(j)  (2304 + 64 * (j))
#define XB_TOP      3328
#define XB_TOPGEN   3392
#define XCD_BAR_WORDS 3456
#define XB_SPIN_CAP (1u << 22)
__device__ __forceinline__ unsigned xb_ld(unsigned* p)              { return __hip_atomic_load(p, __ATOMIC_RELAXED, __HIP_MEMORY_SCOPE_AGENT); }
__device__ __forceinline__ unsigned xb_add(unsigned* p, unsigned v) { return __hip_atomic_fetch_add(p, v, __ATOMIC_RELAXED, __HIP_MEMORY_SCOPE_AGENT); }
__device__ __forceinline__ unsigned xb_xcc_id() { return (unsigned)__builtin_amdgcn_s_getreg((3 << 11) | 20) & 0xFu; }
#define XB_SPIN(cond, bar) do { unsigned _sp = 0; while (cond) { __builtin_amdgcn_s_sleep(1); \
    if ((++_sp & 255u) == 0u) { if (xb_ld(&(bar)[XB_TMO])) break; if (_sp > XB_SPIN_CAP) { atomicAdd(&(bar)[XB_TMO], 1u); break; } } } } while (0)
struct XcdBarrier { unsigned* bar; unsigned x; volatile LAS unsigned* st; };
__device__ __forceinline__ XcdBarrier xcd_barrier_post(unsigned* bar, volatile LAS unsigned* st) {
    XcdBarrier b; b.bar = bar; b.x = xb_xcc_id(); b.st = st;
    if (threadIdx.x == 0) st[3] = xb_add(&bar[XB_XCNT(b.x)], 1u);
    return b;
}
__device__ __forceinline__ void xcd_barrier_complete(unsigned* bar, unsigned x, unsigned& nloc, unsigned& nx) {
    const unsigned G = gridDim.x * gridDim.y * gridDim.z;
    unsigned sum, cnt, mine, sp = 0u;
    for (;;) {
        sum = 0u; cnt = 0u; mine = 0u;
#pragma unroll
        for (unsigned j = 0; j < 16; ++j) { const unsigned c = xb_ld(&bar[XB_XCNT(j)]); sum += c; cnt += (c > 0u) ? 1u : 0u; mine = (j == x) ? c : mine; }
        if (sum == G) break;
        __builtin_amdgcn_s_sleep(1);
        if ((++sp & 255u) == 0u) { if (xb_ld(&bar[XB_TMO])) break; if (sp > XB_SPIN_CAP) { atomicAdd(&bar[XB_TMO], 1u); break; } }
    }
    nloc = mine > 0u ? mine : 1u; nx = cnt > 0u ? cnt : 1u;
}
__device__ __forceinline__ void xcd_barrier(const XcdBarrier& b) {
    asm volatile("s_waitcnt vmcnt(0)" ::: "memory");
    __syncthreads();
    if (threadIdx.x == 0) {
        unsigned* bar = b.bar;
        __builtin_amdgcn_s_waitcnt(0);
        unsigned nloc = b.st[0], nx = b.st[1];
        if (nloc == 0u) { xcd_barrier_complete(bar, b.x, nloc, nx); b.st[0] = nloc; b.st[1] = nx; }
        const unsigned old = xb_add(&bar[XB_XSUB(b.x)], 1u);
        const unsigned gen = old / nloc;
        if (old + 1u == (gen + 1u) * nloc) {
            __builtin_amdgcn_fence(__ATOMIC_RELEASE, "agent");
            asm volatile("s_waitcnt vmcnt(0)" ::: "memory");
            const unsigned og = xb_add(&bar[XB_TOP], 1u);
            const unsigned tg = og / nx;
            if (og + 1u == (tg + 1u) * nx) xb_add(&bar[XB_TOPGEN], 1u);
            else XB_SPIN(xb_ld(&bar[XB_TOPGEN]) == tg, bar);
            __builtin_amdgcn_fence(__ATOMIC_ACQUIRE, "agent");
            xb_add(&bar[XB_XGEN(b.x)], 1u);
            asm volatile("s_waitcnt vmcnt(0)" ::: "memory");
        } else {
            XB_SPIN(xb_ld(&bar[XB_XGEN(b.x)]) == gen, bar);
            __builtin_amdgcn_fence(__ATOMIC_ACQUIRE, "agent");
            asm volatile("s_waitcnt vmcnt(0)" ::: "memory");
        }
    }
    __syncthreads();
}

__global__ void __launch_bounds__(NTHREADS) fwd_megakernel(Params p) {
    extern __shared__ __attribute__((aligned(16))) char smem[];
    cg::grid_group grid = cg::this_grid();
    volatile LAS unsigned* xst = (volatile LAS unsigned*)(smem + LDS_BYTES - 16);
    if (threadIdx.x < 4) xst[threadIdx.x] = threadIdx.x == 2 ? blockIdx.x : 0u;
    __syncthreads();
    const XcdBarrier xb = xcd_barrier_post(p.bar, xst);
    phase_prep(p, smem);
    phase_norm(p, 0, 0, p.X, p.X);
    grid.sync();
    if (threadIdx.x == 0) {
        bool even = gridDim.x == 256;
        for (int j = 0; j < 8; ++j) even = even && xb_ld(&p.bar[XB_XCNT(j)]) == 32u;
        if (even) xst[2] = xb.x + 8u * xst[3];
    }
    __syncthreads();
    phase_gemm_inproj(p, smem, W_LRU_IN, true);
    xcd_barrier(xb);
    phase_lru(p, smem);
    xcd_barrier(xb);
    phase_gemm_out(p, smem, W_LRU_OUT, p.ACT[2]);
    xcd_barrier(xb);
    phase_norm(p, 1, 1, p.X, p.X);
    xcd_barrier(xb);
    phase_gemm_inproj(p, smem, W_S5_IN, false);
    xcd_barrier(xb);
    phase_s5(p, smem);
    xcd_barrier(xb);
    phase_gemm_glu(p, smem);
    xcd_barrier(xb);
    phase_gemm_out(p, smem, W_S5_OUT, p.ACT[3]);
    xcd_barrier(xb);
    phase_norm_rwkv(p, p.X, p.X2);
    xcd_barrier(xb);
    phase_gemm_rwkv_in(p, smem);
    xcd_barrier(xb);
    phase_gemm_lora2(p, smem);
    xcd_barrier(xb);
    phase_rwkv(p, smem);
    xcd_barrier(xb);
    phase_gemm_out(p, smem, W_RW_OUT, p.ACT[6]);
    xcd_barrier(xb);
    phase_norm(p, 1, 3, p.X2, p.X2);
    xcd_barrier(xb);
    phase_gemm_ret_in(p, smem);
    xcd_barrier(xb);
    phase_ret(p, smem);
    xcd_barrier(xb);
    phase_gemm_ret_out(p, smem);
    xcd_barrier(xb);
    phase_norm(p, 3, 4, p.X2, p.X2);
}

extern "C" void kernel_launch(void* const* d_in, const int* in_sizes, int n_in, void* d_out, int out_size, void* d_ws, size_t ws_size, hipStream_t stream) {
    static int grid_blocks = 0;
    if (!grid_blocks) {
        int dev = 0, cus = 0, per_cu = 0;
        hipGetDevice(&dev);
        hipDeviceGetAttribute(&cus, hipDeviceAttributeMultiprocessorCount, dev);
        hipFuncSetAttribute((const void*)fwd_megakernel, hipFuncAttributeMaxDynamicSharedMemorySize, LDS_BYTES);
        hipOccupancyMaxActiveBlocksPerMultiprocessor(&per_cu, fwd_megakernel, NTHREADS, LDS_BYTES);
        if (per_cu < 1) per_cu = 1;
        if (per_cu > 1) per_cu = 1;
        grid_blocks = cus * per_cu;
    }
    Params p{};
    for (int i = 0; i < N_IN; ++i) p.in[i] = (const float*)d_in[i];
    p.out = (float*)d_out;
    char* ws = (char*)d_ws;
    size_t off = 0;
    auto take = [&](size_t bytes) { char* r = ws + off; off += (bytes + 255) & ~(size_t)255; return r; };
    p.X = (float*)take((size_t)RPAD * D * 4);
    p.Z = (float*)take((size_t)RPAD * D * 4);
    p.XN = (bf16_t*)take((size_t)RPAD * D * 2);
    p.XM = (bf16_t*)take((size_t)6 * RPAD * D * 2);
    p.X2 = (float*)take((size_t)RPAD * D * 4);
    for (int i = 0; i < 7; ++i) p.ACT[i] = (bf16_t*)take((size_t)RPAD * E * 2);
    p.L1 = (bf16_t*)take((size_t)RPAD * 128 * 2);
    p.SSP = (float*)take((size_t)R * 64 * 4);
    for (int j = 0; j < N_W; ++j) p.W[j] = (bf16_t*)take((size_t)w_rows(j) * w_k(j) * 2);
    p.bar = (unsigned*)take(XCD_BAR_WORDS * 4);
    if (off > ws_size) { fprintf(stderr, "workspace too small: need %zu have %zu\n", off, ws_size); return; }
    hipMemsetAsync(p.bar, 0, XCD_BAR_WORDS * 4, stream);
    void* args[] = {&p};
    hipError_t e = hipLaunchCooperativeKernel((const void*)fwd_megakernel, dim3(grid_blocks), dim3(NTHREADS), args, LDS_BYTES, stream);
    if (e != hipSuccess) fprintf(stderr, "cooperative launch failed: %s (grid %d)\n", hipGetErrorString(e), grid_blocks);
}
```

```cpp
#include <hip/hip_runtime.h>
#include <hip/hip_cooperative_groups.h>
#include <cstdio>
namespace cg = cooperative_groups;

typedef unsigned short bf16_t;
typedef short bf16x8 __attribute__((ext_vector_type(8)));
typedef float f32x4 __attribute__((ext_vector_type(4)));

constexpr int D = 1024, E = 2048, NB = 8, SEQT = 2064, NSB = 128, DSEQ = 8;
constexpr int RP = NB * SEQT;
constexpr int R = RP + NSB * DSEQ;
constexpr int MT = R / 128;
constexpr int RPAD = 17664;
constexpr int NTHREADS = 512;
constexpr int LDS_BYTES = 147456;
constexpr float EPS = 1e-6f;

constexpr size_t O_YP = 0;
constexpr size_t O_YS = O_YP + (size_t)NB * 2048 * D;
constexpr size_t O_P_LRU_CONV = O_YS + (size_t)NSB * DSEQ * D;
constexpr size_t O_P_LRU_H = O_P_LRU_CONV + (size_t)NB * 3 * E;
constexpr size_t O_P_S5_RE = O_P_LRU_H + (size_t)NB * E;
constexpr size_t O_P_S5_IM = O_P_S5_RE + (size_t)NB * 128 * 64;
constexpr size_t O_P_RW_SHIFT = O_P_S5_IM + (size_t)NB * 128 * 64;
constexpr size_t O_P_RW_WKV = O_P_RW_SHIFT + (size_t)NB * D;
constexpr size_t O_P_RET = O_P_RW_WKV + (size_t)NB * 32 * 64 * 64;
constexpr size_t O_S_LRU_CONV = O_P_RET + (size_t)NB * 4 * 256 * 512;
constexpr size_t O_S_LRU_H = O_S_LRU_CONV + (size_t)NSB * 3 * E;
constexpr size_t O_S_S5_RE = O_S_LRU_H + (size_t)NSB * E;
constexpr size_t O_S_S5_IM = O_S_S5_RE + (size_t)NSB * 128 * 64;
constexpr size_t O_S_RW_SHIFT = O_S_S5_IM + (size_t)NSB * 128 * 64;
constexpr size_t O_S_RW_WKV = O_S_RW_SHIFT + (size_t)NSB * D;
constexpr size_t O_S_RET = O_S_RW_WKV + (size_t)NSB * 32 * 64 * 64;

enum { I_XP = 0, I_XS, I_ST_LRU_CONV, I_ST_LRU_H, I_ST_S5_RE, I_ST_S5_IM, I_ST_RW_SHIFT, I_ST_RW_WKV, I_ST_RET, I_META,
       I_NPRE, I_NPOST, I_LRU_WIN, I_LRU_CW, I_LRU_CB, I_LRU_WA, I_LRU_BA, I_LRU_WX, I_LRU_BX, I_LRU_LAM, I_LRU_WOUT,
       I_S5_WIN, I_S5_LOGDT, I_S5_ARE, I_S5_AIM, I_S5_BRE, I_S5_BIM, I_S5_CRE, I_S5_CIM, I_S5_D, I_S5_GLUW, I_S5_GLUB, I_S5_WOUT,
       I_RW_MU, I_RW_WR, I_RW_WK, I_RW_WV, I_RW_WG, I_RW_W0, I_RW_W1, I_RW_W2, I_RW_A0, I_RW_A1, I_RW_A2, I_RW_KK, I_RW_KA,
       I_RW_RK, I_RW_LNW, I_RW_LNB, I_RW_WO, I_RT_WQ, I_RT_WK, I_RT_WV, I_RT_WG, I_RT_WO, N_IN };

enum { W_LRU_IN = 0, W_LRU_G, W_LRU_OUT, W_S5_IN, W_S5_GLU, W_S5_OUT, W_RW_IN, W_RW_L2, W_RW_OUT, W_RT_IN, W_RT_OUT, N_W };
__host__ __device__ constexpr int w_rows(int j) { return j == W_LRU_IN ? 4096 : j == W_LRU_G ? 4096 : j == W_LRU_OUT ? 1024 : j == W_S5_IN ? 4096 : j == W_S5_GLU ? 2048 :
                                 j == W_S5_OUT ? 1024 : j == W_RW_IN ? 8704 : j == W_RW_L2 ? 4096 : j == W_RW_OUT ? 1024 : j == W_RT_IN ? 6144 : 1024; }
__host__ __device__ constexpr int w_k(int j) { return j == W_LRU_IN ? 1024 : j == W_LRU_G ? 128 : j == W_LRU_OUT ? 2048 : j == W_S5_IN ? 1024 : j == W_S5_GLU ? 2048 :
                              j == W_S5_OUT ? 2048 : j == W_RW_IN ? 1024 : j == W_RW_L2 ? 64 : j == W_RW_OUT ? 2048 : j == W_RT_IN ? 1024 : 2048; }

struct Params {
    const float* in[N_IN];
    float* out;
    float* X; float* Z;
    bf16_t* XN; bf16_t* XM;
    float* X2;
    bf16_t* ACT[7];
    bf16_t* L1;
    float* SSP;
    bf16_t* W[N_W];
    unsigned* bar;
};

#define LAS __attribute__((address_space(3)))
typedef float cvt_f32x2 __attribute__((ext_vector_type(2)));
typedef __bf16 cvt_bf16x2 __attribute__((ext_vector_type(2)));
__device__ __forceinline__ unsigned pack2(float a, float b) { const cvt_f32x2 v = {a, b}; const cvt_bf16x2 h = __builtin_convertvector(v, cvt_bf16x2); return __builtin_bit_cast(unsigned, h); }
__device__ __forceinline__ bf16_t f2bf(float f) { return (bf16_t)(pack2(f, f) & 0xffffu); }
__device__ __forceinline__ float bf2f(bf16_t h) { return __uint_as_float(((unsigned)h) << 16); }
__device__ __forceinline__ float bflo(unsigned u) { return __uint_as_float(u << 16); }
__device__ __forceinline__ float bfhi(unsigned u) { return __uint_as_float(u & 0xffff0000u); }
__device__ __forceinline__ float rcpf_(float x) { return __builtin_amdgcn_rcpf(x); }
__device__ __forceinline__ float sigmoidf_(float x) { return rcpf_(1.0f + __expf(-x)); }
__device__ __forceinline__ float siluf_(float x) { return x * rcpf_(1.0f + __expf(-x)); }
__device__ __forceinline__ float tanhf_(float x) { return 1.0f - 2.0f * rcpf_(1.0f + __expf(2.0f * x)); }
__device__ __forceinline__ float softplusf_(float y) { return fmaxf(y, 0.0f) + __logf(1.0f + __expf(-fabsf(y))); }
__device__ __forceinline__ float wave_sum(float v) {
#pragma unroll
    for (int o = 32; o > 0; o >>= 1) v += __shfl_xor(v, o, 64);
    return v;
}
__device__ __forceinline__ void wave_lds_sync() { asm volatile("s_waitcnt lgkmcnt(0)" ::: "memory"); }
__device__ __forceinline__ f32x4 mfma16(bf16x8 a, bf16x8 b, f32x4 c) { return __builtin_amdgcn_mfma_f32_16x16x32_bf16(a, b, c, 0, 0, 0); }
__device__ __forceinline__ int opaque_tid() { int t = threadIdx.x; asm volatile("" : "+v"(t)); return t; }
__device__ __forceinline__ uint2 pack4(f32x4 v) { uint2 r; r.x = pack2(v[0], v[1]); r.y = pack2(v[2], v[3]); return r; }

__device__ __forceinline__ void phase_norm(const Params& p, int mode, int layer, const float* Xs, float* Xd) {
    const int lane = opaque_tid() & 63, wave = opaque_tid() >> 6;
    const int gw = blockIdx.x * 8 + wave, nw = gridDim.x * 8;
    for (int r = gw; r < R; r += nw) {
        const bool prompt = r < RP;
        const int b = prompt ? r / SEQT : (r - RP) / DSEQ;
        const int t = prompt ? r % SEQT : (r - RP) % DSEQ;
        float4 x[4];
        if (mode == 0) {
            const float* src = prompt ? (t < 16 ? p.in[I_META] + (size_t)t * D : p.in[I_XP] + ((size_t)b * 2048 + (t - 16)) * D)
                                      : p.in[I_XS] + (size_t)(r - RP) * D;
#pragma unroll
            for (int k = 0; k < 4; ++k) x[k] = *(const float4*)(src + k * 256 + lane * 4);
        } else {
            float4 z[4]; float ss = 0.f;
#pragma unroll
            for (int k = 0; k < 4; ++k) {
                x[k] = *(const float4*)(Xs + (size_t)r * D + k * 256 + lane * 4);
                z[k] = *(const float4*)(p.Z + (size_t)r * D + k * 256 + lane * 4);
                ss += z[k].x * z[k].x + z[k].y * z[k].y + z[k].z * z[k].z + z[k].w * z[k].w;
            }
            ss = wave_sum(ss);
            const float rs = rsqrtf(ss * (1.0f / D) + EPS);
            const float* gp = p.in[I_NPOST] + (size_t)(layer - 1) * D;
#pragma unroll
            for (int k = 0; k < 4; ++k) {
                const float4 g = *(const float4*)(gp + k * 256 + lane * 4);
                x[k].x += z[k].x * rs * g.x; x[k].y += z[k].y * rs * g.y; x[k].z += z[k].z * rs * g.z; x[k].w += z[k].w * rs * g.w;
            }
        }
        if (mode == 3) {
            if (prompt) {
                if (t >= 16) {
                    float* dst = p.out + O_YP + ((size_t)b * 2048 + (t - 16)) * D;
#pragma unroll
                    for (int k = 0; k < 4; ++k) *(float4*)(dst + k * 256 + lane * 4) = x[k];
                }
            } else {
                float* dst = p.out + O_YS + (size_t)(r - RP) * D;
#pragma unroll
                for (int k = 0; k < 4; ++k) *(float4*)(dst + k * 256 + lane * 4) = x[k];
            }
            continue;
        }
        float ss2 = 0.f;
#pragma unroll
        for (int k = 0; k < 4; ++k) {
            *(float4*)(Xd + (size_t)r * D + k * 256 + lane * 4) = x[k];
            ss2 += x[k].x * x[k].x + x[k].y * x[k].y + x[k].z * x[k].z + x[k].w * x[k].w;
        }
        ss2 = wave_sum(ss2);
        const float rs2 = rsqrtf(ss2 * (1.0f / D) + EPS);
        const float* gq = p.in[I_NPRE] + (size_t)layer * D;
#pragma unroll
        for (int k = 0; k < 4; ++k) {
            const float4 g = *(const float4*)(gq + k * 256 + lane * 4);
            uint2 pk; pk.x = pack2(x[k].x * rs2 * g.x, x[k].y * rs2 * g.y); pk.y = pack2(x[k].z * rs2 * g.z, x[k].w * rs2 * g.w);
            *(uint2*)(p.XN + (size_t)r * D + k * 256 + lane * 4) = pk;
        }
    }
}
__device__ __forceinline__ void phase_norm_rwkv(const Params& p, const float* Xs, float* Xd) {
    const int lane = opaque_tid() & 63, wave = opaque_tid() >> 6;
    const int gw = blockIdx.x * 8 + wave, nw = gridDim.x * 8;
    const float* gp = p.in[I_NPOST] + (size_t)1 * D;
    const float* gq = p.in[I_NPRE] + (size_t)2 * D;
    for (int r0 = gw * 9; r0 < R; r0 += nw * 9) {
    float4 prev[4];
#pragma unroll
    for (int k = 0; k < 4; ++k) prev[k] = make_float4(0.f, 0.f, 0.f, 0.f);
    for (int rr = -1; rr < 9; ++rr) {
        const int r = r0 + rr;
        if (r < 0 || r >= R) continue;
        const bool prompt = r < RP;
        const int b = prompt ? r / SEQT : (r - RP) / DSEQ;
        const int t = prompt ? r % SEQT : (r - RP) % DSEQ;
        const int tlast = prompt ? SEQT - 1 : DSEQ - 1;
        if (rr < 0 && t == tlast) continue;
        float4 x[4], z[4]; float ss = 0.f;
#pragma unroll
        for (int k = 0; k < 4; ++k) {
            x[k] = *(const float4*)(Xs + (size_t)r * D + k * 256 + lane * 4);
            z[k] = *(const float4*)(p.Z + (size_t)r * D + k * 256 + lane * 4);
            ss += z[k].x * z[k].x + z[k].y * z[k].y + z[k].z * z[k].z + z[k].w * z[k].w;
        }
        ss = wave_sum(ss);
        const float rs = rsqrtf(ss * (1.0f / D) + EPS);
        float ss2 = 0.f;
#pragma unroll
        for (int k = 0; k < 4; ++k) {
            const float4 g = *(const float4*)(gp + k * 256 + lane * 4);
            x[k].x += z[k].x * rs * g.x; x[k].y += z[k].y * rs * g.y; x[k].z += z[k].z * rs * g.z; x[k].w += z[k].w * rs * g.w;
            ss2 += x[k].x * x[k].x + x[k].y * x[k].y + x[k].z * x[k].z + x[k].w * x[k].w;
        }
        ss2 = wave_sum(ss2);
        const float rs2 = rsqrtf(ss2 * (1.0f / D) + EPS);
        float4 xn[4];
#pragma unroll
        for (int k = 0; k < 4; ++k) {
            const float4 g = *(const float4*)(gq + k * 256 + lane * 4);
            xn[k].x = x[k].x * rs2 * g.x; xn[k].y = x[k].y * rs2 * g.y; xn[k].z = x[k].z * rs2 * g.z; xn[k].w = x[k].w * rs2 * g.w;
        }
        if (rr >= 0) {
            if (t == 0) {
#pragma unroll
                for (int k = 0; k < 4; ++k) prev[k] = prompt ? make_float4(0.f, 0.f, 0.f, 0.f) : *(const float4*)(p.in[I_ST_RW_SHIFT] + (size_t)b * D + k * 256 + lane * 4);
            }
#pragma unroll
            for (int k = 0; k < 4; ++k) {
                const int c = k * 256 + lane * 4;
                *(float4*)(Xd + (size_t)r * D + c) = x[k];
                if (t == tlast) *(float4*)(p.out + (prompt ? O_P_RW_SHIFT : O_S_RW_SHIFT) + (size_t)b * D + c) = xn[k];
                const float4 dx = make_float4(prev[k].x - xn[k].x, prev[k].y - xn[k].y, prev[k].z - xn[k].z, prev[k].w - xn[k].w);
#pragma unroll
                for (int j = 0; j < 6; ++j) {
                    const int mi = j == 0 ? 0 : j == 1 ? 2 : j == 2 ? 3 : j == 3 ? 5 : j == 4 ? 1 : 4;
                    const float4 m = *(const float4*)(p.in[I_RW_MU] + mi * D + c);
                    uint2 pk; pk.x = pack2(xn[k].x + dx.x * m.x, xn[k].y + dx.y * m.y); pk.y = pack2(xn[k].z + dx.z * m.z, xn[k].w + dx.w * m.w);
                    *(uint2*)(p.XM + ((size_t)j * RPAD + r) * D + c) = pk;
                }
            }
        }
#pragma unroll
        for (int k = 0; k < 4; ++k) prev[k] = xn[k];
    }
    }
}

__device__ __forceinline__ const float* wsrc(const Params& p, int job, int nd, int& stride) {
    switch (job) {
    case W_LRU_IN: stride = 4096; return p.in[I_LRU_WIN] + nd;
    case W_LRU_G: {
        const int h = nd >> 8, q = (nd >> 7) & 1, pp = nd & 127, wn = pp >> 6, part = (pp >> 5) & 1, chl = wn * 32 + (pp & 31);
        stride = 128; return (part ? p.in[I_LRU_WX] : p.in[I_LRU_WA]) + (size_t)h * 128 * 128 + q * 64 + chl;
    }
    case W_LRU_OUT: stride = 1024; return p.in[I_LRU_WOUT] + nd;
    case W_S5_IN: stride = 4096; return p.in[I_S5_WIN] + nd;
    case W_S5_GLU: stride = 2048; return p.in[I_S5_GLUW] + nd;
    case W_S5_OUT: stride = 1024; return p.in[I_S5_WOUT] + nd;
    case W_RW_IN: {
        if (nd < 8192) { stride = 2048; const int w = nd >> 11; const float* s = w == 0 ? p.in[I_RW_WR] : w == 1 ? p.in[I_RW_WK] : w == 2 ? p.in[I_RW_WV] : p.in[I_RW_WG]; return s + (nd & 2047); }
        stride = 64;
        if (nd < 8448) { const int c = nd - 8192; return c < 64 ? p.in[I_RW_W1] + c : nullptr; }
        const int c = nd - 8448; return c < 64 ? p.in[I_RW_A1] + c : nullptr;
    }
    case W_RW_L2: stride = 2048; return nd < 2048 ? p.in[I_RW_W2] + nd : p.in[I_RW_A2] + (nd - 2048);
    case W_RW_OUT: stride = 1024; return p.in[I_RW_WO] + nd;
    case W_RT_IN: {
        if (nd < 2048) {
            stride = 1024; return (nd < 1024 ? p.in[I_RT_WQ] : p.in[I_RT_WK]) + (nd & 1023);
        }
        stride = 2048; return nd < 4096 ? p.in[I_RT_WV] + (nd - 2048) : p.in[I_RT_WG] + (nd - 4096);
    }
    default: stride = 1024; return p.in[I_RT_WO] + nd;
    }
}

__device__ __forceinline__ void phase_prep(const Params& p, char* smem) {
    float* tile = (float*)smem;
    const int tid = opaque_tid();
    int total = 0;
#pragma unroll
    for (int j = 0; j < N_W; ++j) total += (w_rows(j) / 64) * (w_k(j) / 64);
    for (int ti = blockIdx.x; ti < total; ti += gridDim.x) {
        int job = 0, rem = ti;
#pragma unroll
        for (int j = 0; j < N_W; ++j) { const int n = (w_rows(j) / 64) * (w_k(j) / 64); if (job == j && rem >= n) { rem -= n; job = j + 1; } }
        int K = 0;
#pragma unroll
        for (int j = 0; j < N_W; ++j) if (job == j) K = w_k(j);
        const int kt = K / 64, nt0 = rem / kt, kt0 = rem % kt;
        const int n0 = nt0 * 64, k0 = kt0 * 64;
        {
            const int nc = (tid & 15) * 4; int stride;
            const float* s = wsrc(p, job, n0 + nc, stride);
#pragma unroll
            for (int ps = 0; ps < 2; ++ps) {
                const int kr = (tid >> 4) + ps * 32;
                float4 v = make_float4(0.f, 0.f, 0.f, 0.f);
                if (s) v = *(const float4*)(s + (size_t)(k0 + kr) * stride);
                tile[kr * 65 + nc + 0] = v.x; tile[kr * 65 + nc + 1] = v.y; tile[kr * 65 + nc + 2] = v.z; tile[kr * 65 + nc + 3] = v.w;
            }
        }
        __syncthreads();
        {
            const int n = tid >> 3, kc = (tid & 7) * 8;
            uint4 o;
            o.x = pack2(tile[(kc + 0) * 65 + n], tile[(kc + 1) * 65 + n]);
            o.y = pack2(tile[(kc + 2) * 65 + n], tile[(kc + 3) * 65 + n]);
            o.z = pack2(tile[(kc + 4) * 65 + n], tile[(kc + 5) * 65 + n]);
            o.w = pack2(tile[(kc + 6) * 65 + n], tile[(kc + 7) * 65 + n]);
            *(uint4*)(p.W[job] + (size_t)(n0 + n) * K + k0 + kc) = o;
        }
        __syncthreads();
    }
}

__device__ __forceinline__ int swz(int row, int chunk) { return row * 64 + ((chunk ^ (row & 7)) << 3); }

template <class AL, class EP>
__device__ __forceinline__ void gemm_tile(char* smem, AL& al, const bf16_t* __restrict__ Bt, int ldb, int K, EP& ep) {
    bf16_t* As = (bf16_t*)smem;
    bf16_t* Bs = As + 2 * 128 * 64;
    const int tid = opaque_tid(), lane = tid & 63, wave = tid >> 6, wm = wave >> 2, wn = wave & 3, l15 = lane & 15, quad = lane >> 4;
    f32x4 acc[4][4];
#pragma unroll
    for (int i = 0; i < 4; ++i)
#pragma unroll
        for (int j = 0; j < 4; ++j) acc[i][j] = (f32x4){0.f, 0.f, 0.f, 0.f};
    uint4 ra[2], rb[4];
    const int lrow = tid >> 3, lch = tid & 7;
    const int nk = K >> 6;
#pragma unroll
    for (int it = 0; it < 2; ++it) ra[it] = al.load(it, lrow + it * 64, lch * 8);
#pragma unroll
    for (int it = 0; it < 4; ++it) rb[it] = *(const uint4*)(Bt + (size_t)(lrow + it * 64) * ldb + lch * 8);
#pragma unroll
    for (int it = 0; it < 2; ++it) *(uint4*)(As + swz(lrow + it * 64, lch)) = ra[it];
#pragma unroll
    for (int it = 0; it < 4; ++it) *(uint4*)(Bs + swz(lrow + it * 64, lch)) = rb[it];
    __syncthreads();
    for (int kt = 0; kt < nk; ++kt) {
        const int cur = kt & 1;
        const bool more = kt + 1 < nk;
        if (more) {
            const int k0 = (kt + 1) << 6;
#pragma unroll
            for (int it = 0; it < 2; ++it) ra[it] = al.load(it, lrow + it * 64, k0 + lch * 8);
#pragma unroll
            for (int it = 0; it < 4; ++it) rb[it] = *(const uint4*)(Bt + (size_t)(lrow + it * 64) * ldb + k0 + lch * 8);
        }
        const bf16_t* Ac = As + cur * 128 * 64;
        const bf16_t* Bc = Bs + cur * 256 * 64;
#pragma unroll
        for (int kk = 0; kk < 2; ++kk) {
            bf16x8 af[4], bfr[4];
#pragma unroll
            for (int i = 0; i < 4; ++i) af[i] = *(const bf16x8*)(Ac + swz(wm * 64 + i * 16 + l15, kk * 4 + quad));
#pragma unroll
            for (int j = 0; j < 4; ++j) bfr[j] = *(const bf16x8*)(Bc + swz(wn * 64 + j * 16 + l15, kk * 4 + quad));
#pragma unroll
            for (int i = 0; i < 4; ++i)
#pragma unroll
                for (int j = 0; j < 4; ++j) acc[i][j] = mfma16(bfr[j], af[i], acc[i][j]);
        }
        if (more) {
            bf16_t* An = As + (cur ^ 1) * 128 * 64;
            bf16_t* Bn = Bs + (cur ^ 1) * 256 * 64;
#pragma unroll
            for (int it = 0; it < 2; ++it) *(uint4*)(An + swz(lrow + it * 64, lch)) = ra[it];
#pragma unroll
            for (int it = 0; it < 4; ++it) *(uint4*)(Bn + swz(lrow + it * 64, lch)) = rb[it];
        }
        __syncthreads();
    }
    ep(acc, wm * 64 + l15, wn * 64 + quad * 4);
}

struct ALPlain {
    const bf16_t* A; int lda;
    __device__ __forceinline__ uint4 load(int, int row, int k) const { return *(const uint4*)(A + (size_t)row * lda + k); }
};
struct ALRet {
    const bf16_t* y; const bf16_t* g; const float* ssp;
    float sc[2];
    __device__ __forceinline__ uint4 load(int it, int row, int k) {
        if ((k & 511) < 64) {
            const float* s = ssp + (size_t)row * 64 + (k >> 9) * 16;
            const float4 a = *(const float4*)s, b = *(const float4*)(s + 4), c = *(const float4*)(s + 8), d = *(const float4*)(s + 12);
            const float tot = a.x + a.y + a.z + a.w + b.x + b.y + b.z + b.w + c.x + c.y + c.z + c.w + d.x + d.y + d.z + d.w;
            sc[it] = rsqrtf(tot * (1.0f / 512.0f) + EPS);
        }
        const float f = sc[it];
        const uint4 a = *(const uint4*)(y + (size_t)row * E + k);
        const uint4 gg = *(const uint4*)(g + (size_t)row * E + k);
        uint4 o;
        o.x = pack2(bflo(a.x) * f * bflo(gg.x), bfhi(a.x) * f * bfhi(gg.x));
        o.y = pack2(bflo(a.y) * f * bflo(gg.y), bfhi(a.y) * f * bfhi(gg.y));
        o.z = pack2(bflo(a.z) * f * bflo(gg.z), bfhi(a.z) * f * bfhi(gg.z));
        o.w = pack2(bflo(a.w) * f * bflo(gg.w), bfhi(a.w) * f * bfhi(gg.w));
        return o;
    }
};

struct OpZ {
    float* Z;
    __device__ __forceinline__ int row_ctx(int) const { return 0; }
    __device__ __forceinline__ void operator()(int row, int col, f32x4 v, int) const { *(f32x4*)(Z + (size_t)row * D + col) = v; }
    __device__ __forceinline__ void call8(int row, int col, f32x4 a, f32x4 b, int c) const { (*this)(row, col, a, c); (*this)(row, col + 4, b, c); }
};
struct OpInProj {
    bf16_t* U; bf16_t* SG; float* out; bool lru;
    __device__ __forceinline__ float* row_ctx(int row) const {
        if (!lru || row >= R) return nullptr;
        const bool prompt = row < RP;
        const int b = prompt ? row / SEQT : (row - RP) / DSEQ;
        const int t = prompt ? row % SEQT : (row - RP) % DSEQ;
        const int tl = t - (prompt ? SEQT - 3 : DSEQ - 3);
        return tl >= 0 ? out + (prompt ? O_P_LRU_CONV : O_S_LRU_CONV) + ((size_t)b * 3 + tl) * E : nullptr;
    }
    __device__ __forceinline__ void call8(int row, int col, f32x4 a, f32x4 b, float* crow) const {
        if (col >= E) {
#pragma unroll
            for (int e = 0; e < 4; ++e) { a[e] = siluf_(a[e]); b[e] = siluf_(b[e]); }
            const uint2 lo = pack4(a), hi = pack4(b);
            *(uint4*)(SG + (size_t)row * E + col - E) = make_uint4(lo.x, lo.y, hi.x, hi.y);
        } else {
            const uint2 lo = pack4(a), hi = pack4(b);
            *(uint4*)(U + (size_t)row * E + col) = make_uint4(lo.x, lo.y, hi.x, hi.y);
            if (crow) { *(f32x4*)(crow + col) = a; *(f32x4*)(crow + col + 4) = b; }
        }
    }
    __device__ __forceinline__ void operator()(int row, int col, f32x4 v, float* crow) const {
        if (col >= E) {
            v[0] = siluf_(v[0]); v[1] = siluf_(v[1]); v[2] = siluf_(v[2]); v[3] = siluf_(v[3]);
            *(uint2*)(SG + (size_t)row * E + col - E) = pack4(v);
        } else {
            *(uint2*)(U + (size_t)row * E + col) = pack4(v);
            if (crow) *(f32x4*)(crow + col) = v;
        }
    }
};
struct OpGlu {
    const bf16_t* Y1; const bf16_t* SG; bf16_t* Y2; const float* bias;
    __device__ __forceinline__ void call8(int row, int col, f32x4 a, f32x4 b, int c) const { (*this)(row, col, a, c); (*this)(row, col + 4, b, c); }
    __device__ __forceinline__ int row_ctx(int) const { return 0; }
    __device__ __forceinline__ void operator()(int row, int col, f32x4 v, int) const {
        const float4 bb = *(const float4*)(bias + col);
        const size_t o = (size_t)row * E + col;
        const uint2 y1 = *(const uint2*)(Y1 + o), sg = *(const uint2*)(SG + o);
        v[0] = bflo(y1.x) * sigmoidf_(v[0] + bb.x) * bflo(sg.x);
        v[1] = bfhi(y1.x) * sigmoidf_(v[1] + bb.y) * bfhi(sg.x);
        v[2] = bflo(y1.y) * sigmoidf_(v[2] + bb.z) * bflo(sg.y);
        v[3] = bfhi(y1.y) * sigmoidf_(v[3] + bb.w) * bfhi(sg.y);
        *(uint2*)(Y2 + o) = pack4(v);
    }
};
struct OpRwkvIn {
    bf16_t* d0; bf16_t* d1; bf16_t* d2; bf16_t* d3; bf16_t* L1;
    __device__ __forceinline__ void call8(int row, int col, f32x4 a, f32x4 b, int c) const { (*this)(row, col, a, c); (*this)(row, col + 4, b, c); }
    __device__ __forceinline__ int row_ctx(int) const { return 0; }
    __device__ __forceinline__ void operator()(int row, int col, f32x4 v, int) const {
        if (col < 8192) {
            const int reg = col >> 11;
            if (reg == 3) { v[0] = siluf_(v[0]); v[1] = siluf_(v[1]); v[2] = siluf_(v[2]); v[3] = siluf_(v[3]); }
            bf16_t* dst = reg == 0 ? d0 : reg == 1 ? d1 : reg == 2 ? d2 : d3;
            *(uint2*)(dst + (size_t)row * E + (col & 2047)) = pack4(v);
        } else {
            const int cc = col - 8192, part = cc >> 8, c = cc & 255;
            if (c < 64) {
                if (part == 0) { v[0] = tanhf_(v[0]); v[1] = tanhf_(v[1]); v[2] = tanhf_(v[2]); v[3] = tanhf_(v[3]); }
                *(uint2*)(L1 + (size_t)row * 128 + part * 64 + c) = pack4(v);
            }
        }
    }
};
struct OpLora2 {
    bf16_t* DL; bf16_t* AA; const float* w0; const float* a0;
    __device__ __forceinline__ void call8(int row, int col, f32x4 a, f32x4 b, int c) const { (*this)(row, col, a, c); (*this)(row, col + 4, b, c); }
    __device__ __forceinline__ int row_ctx(int) const { return 0; }
    __device__ __forceinline__ void operator()(int row, int col, f32x4 v, int) const {
        const bool isw = col < E; const int c = col & 2047;
        const float4 bb = *(const float4*)((isw ? w0 : a0) + c);
        v[0] += bb.x; v[1] += bb.y; v[2] += bb.z; v[3] += bb.w;
#pragma unroll
        for (int e = 0; e < 4; ++e) v[e] = isw ? __expf(-softplusf_(-v[e]) - 0.5f) : sigmoidf_(v[e]);
        *(uint2*)((isw ? DL : AA) + (size_t)row * E + c) = pack4(v);
    }
};

template <class Op> struct OldEpi {
    Op op; int m0, n0;
    __device__ __forceinline__ void operator()(f32x4 (&acc)[4][4], int r0, int c0) const {
#pragma unroll
        for (int i = 0; i < 4; ++i) {
            const auto ctx = op.row_ctx(m0 + r0 + i * 16);
#pragma unroll
            for (int j = 0; j < 4; ++j) op(m0 + r0 + i * 16, n0 + c0 + j * 16, acc[i][j], ctx);
        }
    }
};

namespace pg8 {
constexpr int BM = 256, BK = 64, HALF = 128, HTB = HALF * BK * 2, STAGE_BYTES = 8 * HTB, NXCD = 8, WGM = 8;
__device__ __forceinline__ int lds_byte(int r, int c) { const int st = (r >> 4) * 2 + (c >> 5), rr = r & 15, cc = c & 31, ob = rr * 64 + cc * 2; return st * 1024 + (ob ^ (((ob >> 9) & 1) << 5)); }
__device__ __forceinline__ void stage_rc(int b, int& Rr, int& C) { const int st = b / 1024, sb = b % 1024, swz = sb ^ (((sb >> 9) & 1) << 5); Rr = (st >> 1) * 16 + swz / 64; C = (st & 1) * 32 + (swz % 64) / 2; }
__device__ __forceinline__ int perm32(int rho) { const int n = rho >> 4, i = rho & 15; return 8 * (i >> 2) + 4 * n + (i & 3); }
struct Unit { int pm, pn; };
struct Gemm { const bf16_t* A; const bf16_t* Bt; int M, N, K; size_t a_sel_bytes; };
__device__ __forceinline__ size_t a_sel(const Gemm& g, int pn) { const int sgrp = pn >> 3; return g.a_sel_bytes * (size_t)((sgrp < 4 ? sgrp : 4) + (pn == 33 ? 1 : 0)); }
struct StaticOrder {
    int nM, nN, nwg, G, c;
    __device__ void init(int M, int N, int G_, int c_) { nM = M / BM; nN = N / BM; nwg = nM * nN; G = G_; c = c_; }
    __device__ bool next(int i, Unit& u) const {
        const long L = (long)i * G + c; if (L >= nwg) return false;
        int wgid = (int)L; { const int q = nwg / NXCD, r = nwg % NXCD, xcd = wgid % NXCD, off = wgid / NXCD; wgid = (xcd < r ? xcd * (q + 1) : r * (q + 1) + (xcd - r) * q) + off; }
        const int nig = WGM * nN, gid = wgid / nig, fm = gid * WGM, gsz = (nM - fm) < WGM ? (nM - fm) : WGM;
        u.pm = fm + ((wgid % nig) % gsz); u.pn = (wgid % nig) / gsz; return true;
    }
};
template <class Epi>
__device__ __forceinline__ void gemm_phase(LAS unsigned char* lds, const Gemm g, const StaticOrder& S, const Epi& Ep) {
    const int tid = opaque_tid(), wid = __builtin_amdgcn_readfirstlane(tid >> 6), lane = tid & 63, wr = wid >> 2, wc = wid & 3, fr = lane & 15, fq = lane >> 4;
    const int K = g.K, nt = K / BK;
    unsigned voffA[2], voffB[2];
#pragma unroll
    for (int i = 0; i < 2; ++i) { int Rr, C; stage_rc(tid * 16 + i * 8192, Rr, C); const int Rb = Epi::PERM ? ((Rr & ~31) + perm32(Rr & 31)) : Rr;
        voffA[i] = (unsigned)(Rr * K + C) * 2u; voffB[i] = (unsigned)(Rb * K + C) * 2u; }
    const size_t kstep = (size_t)(BK * 2);
    const size_t hstep = (size_t)HALF * K * 2;
    const size_t tstep = 2 * hstep;
    const unsigned ldsw = (unsigned)wid * 1024u;
    const int aoff = lds_byte(wr * 64 + fr, fq * 8), boff = lds_byte(wc * 32 + fr, fq * 8);
#define PG8_SA(b, h) (((b) * 2 + (h)) * HTB)
#define PG8_SB(b, h) ((4 + (b) * 2 + (h)) * HTB)
#define PG8_STAGE(bufoff, gbase, voff) do { _Pragma("unroll") for (int _i = 0; _i < 2; ++_i) \
        __builtin_amdgcn_global_load_lds((const unsigned*)((const char*)(gbase) + (voff)[_i]), (LAS unsigned*)(lds + (bufoff) + ldsw + _i * 8192), 16, 0, 0); } while (0)
#define PG8_LDA(dst, b, h) do { _Pragma("unroll") for (int m = 0; m < 4; ++m) _Pragma("unroll") for (int k = 0; k < 2; ++k) dst[m][k] = *(const LAS bf16x8*)(lds + PG8_SA(b, h) + aoff + m * 2048 + k * 1024); } while (0)
#define PG8_LDB(dst, b, h) do { _Pragma("unroll") for (int n = 0; n < 2; ++n) _Pragma("unroll") for (int k = 0; k < 2; ++k) dst[n][k] = *(const LAS bf16x8*)(lds + PG8_SB(b, h) + boff + n * 2048 + k * 1024); } while (0)
#define PG8_MMA(ai, bj, At, Bt) do { __builtin_amdgcn_s_setprio(1); _Pragma("unroll") for (int m = 0; m < 4; ++m) _Pragma("unroll") for (int n = 0; n < 2; ++n) _Pragma("unroll") for (int k = 0; k < 2; ++k) \
        acc[ai][bj][m][n] = __builtin_amdgcn_mfma_f32_16x16x32_bf16(Bt[n][k], At[m][k], acc[ai][bj][m][n], 0, 0, 0); __builtin_amdgcn_s_setprio(0); } while (0)
#define PG8_WAIT_V(n) asm volatile("s_waitcnt vmcnt(" #n ")" ::: "memory")
#define PG8_WAIT_L(n) asm volatile("s_waitcnt lgkmcnt(" #n ")" ::: "memory")
#define PG8_BAR __builtin_amdgcn_s_barrier()
#define PG8_SCHED __builtin_amdgcn_sched_barrier(0)
    Unit cur, nxt; int ui = 0;
    if (!S.next(0, cur)) return;
    f32x4 acc[2][2][4][2];
#pragma unroll
    for (int a = 0; a < 2; ++a)
#pragma unroll
        for (int b = 0; b < 2; ++b)
#pragma unroll
            for (int m = 0; m < 4; ++m)
#pragma unroll
                for (int n = 0; n < 2; ++n) acc[a][b][m][n] = (f32x4){0.f, 0.f, 0.f, 0.f};
    bf16x8 At[4][2], B0[2][2], B1[2][2];
    const char* cA = (const char*)g.A + a_sel(g, cur.pn) + (size_t)cur.pm * tstep; const char* cB = (const char*)g.Bt + (size_t)cur.pn * tstep;
    PG8_STAGE(PG8_SB(0, 0), cB, voffB); PG8_STAGE(PG8_SA(0, 0), cA, voffA); PG8_STAGE(PG8_SB(0, 1), cB + hstep, voffB); PG8_STAGE(PG8_SA(0, 1), cA + hstep, voffA);
    if (wr == 1) PG8_BAR;
    PG8_WAIT_V(4); PG8_BAR;
    PG8_STAGE(PG8_SB(1, 0), cB + kstep, voffB); PG8_STAGE(PG8_SA(1, 0), cA + kstep, voffA); PG8_STAGE(PG8_SB(1, 1), cB + hstep + kstep, voffB);
    PG8_WAIT_V(6); PG8_BAR;
    for (;;) {
        const bool has_next = S.next(ui + 1, nxt);
        const char* nA = has_next ? (const char*)g.A + a_sel(g, nxt.pn) + (size_t)nxt.pm * tstep : cA; const char* nB = has_next ? (const char*)g.Bt + (size_t)nxt.pn * tstep : cB;
        for (int t = 0; t < nt; t += 2) {
            const bool last = (t == nt - 2);
            const char* a1 = cA + (size_t)(t + 1) * kstep;
            const char* a2 = last ? nA : cA + (size_t)(t + 2) * kstep; const char* b2 = last ? nB : cB + (size_t)(t + 2) * kstep;
            const char* a3 = a2 + kstep; const char* b3 = b2 + kstep;
            PG8_LDB(B0, 0, 0); PG8_SCHED; PG8_LDA(At, 0, 0); PG8_STAGE(PG8_SA(1, 1), a1 + hstep, voffA);
            PG8_WAIT_L(8); PG8_BAR; PG8_WAIT_L(0); PG8_MMA(0, 0, At, B0); PG8_BAR; PG8_SCHED;
            PG8_LDB(B1, 0, 1); PG8_STAGE(PG8_SB(0, 0), b2, voffB);
            PG8_BAR; PG8_WAIT_L(0); PG8_MMA(0, 1, At, B1); PG8_BAR;
            PG8_LDA(At, 0, 1); PG8_STAGE(PG8_SA(0, 0), a2, voffA);
            PG8_BAR; PG8_WAIT_L(0); PG8_MMA(1, 0, At, B0); PG8_BAR; PG8_SCHED;
            PG8_STAGE(PG8_SB(0, 1), b2 + hstep, voffB);
            PG8_WAIT_V(6); PG8_BAR; PG8_MMA(1, 1, At, B1); PG8_BAR;
            PG8_LDB(B0, 1, 0); PG8_SCHED; PG8_LDA(At, 1, 0); PG8_STAGE(PG8_SA(0, 1), a2 + hstep, voffA);
            PG8_WAIT_L(8); PG8_BAR; PG8_WAIT_L(0); PG8_MMA(0, 0, At, B0); PG8_BAR; PG8_SCHED;
            PG8_LDB(B1, 1, 1); PG8_STAGE(PG8_SB(1, 0), b3, voffB);
            PG8_BAR; PG8_WAIT_L(0); PG8_MMA(0, 1, At, B1); PG8_BAR;
            PG8_LDA(At, 1, 1); PG8_STAGE(PG8_SA(1, 0), a3, voffA);
            PG8_BAR; PG8_WAIT_L(0); PG8_MMA(1, 0, At, B0); PG8_BAR; PG8_SCHED;
            PG8_STAGE(PG8_SB(1, 1), b3 + hstep, voffB);
            PG8_WAIT_V(6); PG8_BAR; PG8_MMA(1, 1, At, B1); PG8_BAR;
            if constexpr (Epi::HEAD_RESCALE) {
                if ((t & 7) == 6 && !last) {
                    const LAS float* sc = (const LAS float*)(lds + 131072) + (ui & 1) * 1024 + (t >> 3);
#pragma unroll
                    for (int ai = 0; ai < 2; ++ai)
#pragma unroll
                        for (int m = 0; m < 4; ++m) {
                            const int r = ai * 128 + wr * 64 + m * 16 + fr;
                            const float ratio = sc[r * 4] * __builtin_amdgcn_rcpf(sc[r * 4 + 1]);
#pragma unroll
                            for (int bj = 0; bj < 2; ++bj)
#pragma unroll
                                for (int n = 0; n < 2; ++n) acc[ai][bj][m][n] *= ratio;
                        }
                }
            }
        }
        if constexpr (Epi::HEAD_RESCALE) Ep.call_ui(acc, cur, ui, wr, wc, fr, fq, lds);
        else Ep(acc, cur, wr, wc, fr, fq);
        if (!has_next) break;
#pragma unroll
        for (int a = 0; a < 2; ++a)
#pragma unroll
            for (int b = 0; b < 2; ++b)
#pragma unroll
                for (int m = 0; m < 4; ++m)
#pragma unroll
                    for (int n = 0; n < 2; ++n) acc[a][b][m][n] = (f32x4){0.f, 0.f, 0.f, 0.f};
        cur = nxt; cA = nA; cB = nB; ++ui;
    }
    PG8_WAIT_V(0);
    if (wr == 0) PG8_BAR;
    PG8_BAR;
#undef PG8_SA
#undef PG8_SB
#undef PG8_STAGE
#undef PG8_LDA
#undef PG8_LDB
#undef PG8_MMA
#undef PG8_WAIT_V
#undef PG8_WAIT_L
#undef PG8_BAR
#undef PG8_SCHED
}
}

template <class Op, bool PERM_> struct Pg8Epi {
    static constexpr bool PERM = PERM_, HEAD_RESCALE = false;
    Op op;
    __device__ __forceinline__ void operator()(const f32x4 (&acc)[2][2][4][2], const pg8::Unit& u, int wr, int wc, int fr, int fq) const {
#pragma unroll
        for (int ai = 0; ai < 2; ++ai)
#pragma unroll
            for (int m = 0; m < 4; ++m) {
                const int row = u.pm * 256 + ai * 128 + wr * 64 + m * 16 + fr;
                const auto ctx = op.row_ctx(row);
#pragma unroll
                for (int bj = 0; bj < 2; ++bj) {
                    if (PERM) op.call8(row, u.pn * 256 + bj * 128 + wc * 32 + fq * 8, acc[ai][bj][m][0], acc[ai][bj][m][1], ctx);
                    else {
#pragma unroll
                        for (int n = 0; n < 2; ++n) op(row, u.pn * 256 + bj * 128 + wc * 32 + n * 16 + fq * 4, acc[ai][bj][m][n], ctx);
                    }
                }
            }
    }
};
struct Pg8EpiRetIn {
    static constexpr bool PERM = true, HEAD_RESCALE = false;
    bf16_t* Q; bf16_t* Kk; bf16_t* V; bf16_t* G;
    __device__ __forceinline__ void operator()(const f32x4 (&acc)[2][2][4][2], const pg8::Unit& u, int wr, int wc, int fr, int fq) const {
        const int nt = u.pn;
        float invf[2][4];
#pragma unroll
        for (int n = 0; n < 2; ++n)
#pragma unroll
            for (int e = 0; e < 4; ++e) invf[n][e] = __builtin_amdgcn_exp2f(-(float)(wc * 32 + fq * 8 + n * 4 + e) * (13.287712379549449f / 128.0f)) * 0.15915494309189535f;
#pragma unroll
        for (int ai = 0; ai < 2; ++ai)
#pragma unroll
            for (int m = 0; m < 4; ++m) {
                const int row = u.pm * 256 + ai * 128 + wr * 64 + m * 16 + fr;
                if (nt >= 8) {
#pragma unroll
                    for (int bj = 0; bj < 2; ++bj)
#pragma unroll
                        for (int n = 0; n < 2; ++n) {
                            f32x4 v = acc[ai][bj][m][n];
                            if (nt >= 16) { v[0] = siluf_(v[0]); v[1] = siluf_(v[1]); v[2] = siluf_(v[2]); v[3] = siluf_(v[3]); }
                            *(uint2*)((nt >= 16 ? G : V) + (size_t)row * E + (nt & 7) * 256 + bj * 128 + wc * 32 + fq * 8 + n * 4) = pack4(v);
                        }
                } else {
                    const int h = nt & 3;
                    const float scl = nt >= 4 ? 0.0625f : 1.0f;
                    bf16_t* dst = nt >= 4 ? Kk : Q;
                    const float pos = (float)(row < RP ? row % SEQT : 16384 + (row - RP) % DSEQ);
#pragma unroll
                    for (int n = 0; n < 2; ++n) {
                        const int d1 = wc * 32 + fq * 8 + n * 4;
                        f32x4 o1, o2;
#pragma unroll
                        for (int e = 0; e < 4; ++e) {
                            const float rev = __builtin_amdgcn_fractf(pos * invf[n][e]);
                            const float sn = __builtin_amdgcn_sinf(rev), cs = __builtin_amdgcn_cosf(rev);
                            const float x1 = acc[ai][0][m][n][e], x2 = acc[ai][1][m][n][e];
                            o1[e] = (x1 * cs - x2 * sn) * scl; o2[e] = (x2 * cs + x1 * sn) * scl;
                        }
                        *(uint2*)(dst + (size_t)row * D + h * 256 + d1) = pack4(o1);
                        *(uint2*)(dst + (size_t)row * D + h * 256 + 128 + d1) = pack4(o2);
                    }
                }
            }
    }
};

struct Pg8EpiRetOut {
    static constexpr bool PERM = false, HEAD_RESCALE = true;
    float* Z;
    __device__ __forceinline__ void call_ui(const f32x4 (&acc)[2][2][4][2], const pg8::Unit& u, int ui, int wr, int wc, int fr, int fq, LAS unsigned char* lds) const {
        const LAS float* sc = (const LAS float*)(lds + 131072) + (ui & 1) * 1024 + 3;
#pragma unroll
        for (int ai = 0; ai < 2; ++ai)
#pragma unroll
            for (int m = 0; m < 4; ++m) {
                const int r = ai * 128 + wr * 64 + m * 16 + fr;
                const float s3 = sc[r * 4];
                float* rp = Z + (size_t)(u.pm * 256 + r) * D + u.pn * 256 + wc * 32 + fq * 4;
#pragma unroll
                for (int bj = 0; bj < 2; ++bj)
#pragma unroll
                    for (int n = 0; n < 2; ++n) *(f32x4*)(rp + bj * 128 + n * 16) = acc[ai][bj][m][n] * s3;
            }
    }
};
template <class Epi>
__device__ __forceinline__ void run_pg8(char* smem, const bf16_t* A, const bf16_t* Bt, int N, int K, const Epi& ep, size_t a_sel_bytes = 0) {
    const int slot = (int)((volatile LAS unsigned*)(smem + LDS_BYTES - 16))[2];
    pg8::StaticOrder so; so.init(RPAD, N, gridDim.x, slot);
    pg8::Gemm g{A, Bt, RPAD, N, K, a_sel_bytes};
    pg8::gemm_phase((LAS unsigned char*)smem, g, so, ep);
}
__device__ __forceinline__ void phase_gemm_inproj(const Params& p, char* smem, int wj, bool lru) {
    Pg8Epi<OpInProj, true> ep{{p.ACT[0], p.ACT[1], p.out, lru}};
    run_pg8(smem, p.XN, p.W[wj], 4096, D, ep);
}
__device__ __forceinline__ void phase_gemm_out(const Params& p, char* smem, int wj, const bf16_t* Y) {
    Pg8Epi<OpZ, false> ep{{p.Z}};
    run_pg8(smem, Y, p.W[wj], D, E, ep);
}
__device__ __forceinline__ void phase_gemm_glu(const Params& p, char* smem) {
    Pg8Epi<OpGlu, true> ep{{p.ACT[2], p.ACT[1], p.ACT[3], p.in[I_S5_GLUB]}};
    run_pg8(smem, p.ACT[2], p.W[W_S5_GLU], E, E, ep);
}
__device__ __forceinline__ void phase_gemm_rwkv_in(const Params& p, char* smem) {
    Pg8Epi<OpRwkvIn, true> ep{{p.ACT[0], p.ACT[1], p.ACT[2], p.ACT[3], p.L1}};
    run_pg8(smem, p.XM, p.W[W_RW_IN], 8704, D, ep, (size_t)RPAD * D * 2);
}
__device__ __forceinline__ void phase_gemm_lora2(const Params& p, char* smem) {
    for (int tile = blockIdx.x; tile < MT * 16; tile += gridDim.x) {
        const int nt = tile / MT, mt = tile % MT;
        ALPlain al{p.L1 + (size_t)mt * 128 * 128 + (nt < 8 ? 0 : 64), 128};
        OldEpi<OpLora2> ep{{p.ACT[4], p.ACT[5], p.in[I_RW_W0], p.in[I_RW_A0]}, mt * 128, nt * 256};
        gemm_tile(smem, al, p.W[W_RW_L2] + (size_t)nt * 256 * 64, 64, 64, ep);
    }
}
__device__ __forceinline__ void phase_gemm_ret_in(const Params& p, char* smem) {
    Pg8EpiRetIn ep{p.ACT[0], p.ACT[1], p.ACT[2], p.ACT[3]};
    run_pg8(smem, p.XN, p.W[W_RT_IN], 6144, D, ep);
}
__device__ __forceinline__ void phase_gemm_ret_out(const Params& p, char* smem) {
    const int slot = (int)((volatile LAS unsigned*)(smem + LDS_BYTES - 16))[2];
    pg8::StaticOrder so; so.init(RPAD, D, gridDim.x, slot);
    {
        float* sc = (float*)(smem + 131072);
        const int tid = opaque_tid(), r = tid >> 1, h0 = (tid & 1) * 2;
#pragma unroll
        for (int ui = 0; ui < 2; ++ui) {
            pg8::Unit u;
            if (so.next(ui, u)) {
                const int row = u.pm * 256 + r;
#pragma unroll
                for (int hh = 0; hh < 2; ++hh) {
                    float scale = 1.0f;
                    if (row < R) {
                        const float* q = p.SSP + (size_t)row * 64 + (h0 + hh) * 16;
                        const float4 a = *(const float4*)q, b = *(const float4*)(q + 4), c = *(const float4*)(q + 8), d = *(const float4*)(q + 12);
                        const float tot = a.x + a.y + a.z + a.w + b.x + b.y + b.z + b.w + c.x + c.y + c.z + c.w + d.x + d.y + d.z + d.w;
                        scale = rsqrtf(tot * (1.0f / 512.0f) + EPS);
                    }
                    sc[ui * 1024 + r * 4 + h0 + hh] = scale;
                }
            }
        }
    }
    __syncthreads();
    pg8::Gemm g{p.ACT[4], p.W[W_RT_OUT], RPAD, D, E, 0};
    Pg8EpiRetOut ep{p.Z};
    pg8::gemm_phase((LAS unsigned char*)smem, g, so, ep);
}

__device__ __forceinline__ void lru_uload(uint4 (&ubuf)[7], const bf16_t* U, int bg, int c, int rg, int h, int cgp) {
    const int nrows = c < 16 ? 128 : 16;
    const int lr = rg * 4;
#pragma unroll
    for (int jj = 0; jj < 7; ++jj) {
        const int tt = c * 128 + lr - 3 + jj;
        ubuf[jj] = make_uint4(0u, 0u, 0u, 0u);
        if (lr < nrows && tt >= 0) ubuf[jj] = *(const uint4*)(U + (size_t)(bg * SEQT + tt) * E + h * 128 + cgp * 8);
    }
}
__device__ __forceinline__ void phase_lru(const Params& p, char* smem) {
    bf16_t* Al = (bf16_t*)smem;
    bf16_t* Bl = Al + 128 * 136;
    float* SA = (float*)(smem + 2 * 128 * 136 * 2);
    float* SB = SA + 128 * 64;
    float* SEG = SB + 128 * 64;
    float* CAR = SEG + 2 * 8 * 64;
    float* CWL = CAR + 128;
    float* EPL = CWL + 640;
    const int tid = opaque_tid(), lane = tid & 63, wave = tid >> 6, l15 = lane & 15, quad = lane >> 4;
    const int wm = wave >> 1, wn = wave & 1;
    const bf16_t* U = p.ACT[0]; const bf16_t* SG = p.ACT[1]; bf16_t* Y = p.ACT[2];
    for (int item = blockIdx.x; item < 512; item += gridDim.x) {
        const bool sample = item >= 256;
        const int it = item & 255, bg = it >> 5, h = (it >> 1) & 15, q = it & 1;
        const int chbase = h * 128 + q * 64;
#pragma unroll
        for (int i = 0; i < 4; ++i) {
            const int idx = tid + i * 512, row = idx >> 4, ch = idx & 15;
            *(uint4*)(Bl + row * 136 + ch * 8) = *(const uint4*)(p.W[W_LRU_G] + (size_t)(h * 256 + q * 128 + row) * 128 + ch * 8);
        }
        if (tid < 128) {
            CAR[tid] = 0.f;
            const int kch = h * 128 + tid;
#pragma unroll
            for (int j = 0; j < 4; ++j) CWL[j * 128 + tid] = p.in[I_LRU_CW][j * E + kch];
            CWL[4 * 128 + tid] = p.in[I_LRU_CB][kch];
        } else if (tid < 192) {
            const int cl = tid - 128, ch = chbase + cl;
            EPL[cl] = p.in[I_LRU_BA][ch]; EPL[64 + cl] = p.in[I_LRU_BX][ch]; EPL[128 + cl] = softplusf_(-p.in[I_LRU_LAM][ch]);
        }
        const int cgp = tid & 15, rg = tid >> 4;
        const int ntiles = sample ? 1 : 17;
        float hc = 0.f;
        uint4 ubuf[7];
        if (!sample) lru_uload(ubuf, U, bg, 0, rg, h, cgp);
        __syncthreads();
        for (int c = 0; c < ntiles; ++c) {
            const int nrows = sample ? 128 : (c < 16 ? 128 : 16);
#pragma unroll
            for (int ps = 0; ps < 2; ++ps) {
                const int lr = rg * 4 + ps * 2;
                if (lr < nrows) {
                    float uu[5][8];
#pragma unroll
                    for (int jj = 0; jj < 5; ++jj) {
                        uint4 raw = make_uint4(0u, 0u, 0u, 0u); bool have = true; float4 f0 = make_float4(0.f, 0.f, 0.f, 0.f), f1 = f0;
                        if (!sample) {
                            raw = ubuf[ps * 2 + jj];
                        } else {
                            const int sq = lr >> 3, ts = lr & 7, sb = bg * 16 + sq, ee = ts - 3 + jj;
                            if (ee >= 0) { raw = *(const uint4*)(U + (size_t)(RP + sb * 8 + ee) * E + h * 128 + cgp * 8); }
                            else { have = false; const float* s = p.in[I_ST_LRU_CONV] + ((size_t)sb * 3 + (3 + ee)) * E + h * 128 + cgp * 8; f0 = *(const float4*)s; f1 = *(const float4*)(s + 4); }
                        }
                        if (have) { f0.x = bflo(raw.x); f0.y = bfhi(raw.x); f0.z = bflo(raw.y); f0.w = bfhi(raw.y); f1.x = bflo(raw.z); f1.y = bfhi(raw.z); f1.z = bflo(raw.w); f1.w = bfhi(raw.w); }
                        uu[jj][0] = f0.x; uu[jj][1] = f0.y; uu[jj][2] = f0.z; uu[jj][3] = f0.w; uu[jj][4] = f1.x; uu[jj][5] = f1.y; uu[jj][6] = f1.z; uu[jj][7] = f1.w;
                    }
#pragma unroll
                    for (int rr = 0; rr < 2; ++rr) {
                        float xc[8];
#pragma unroll
                        for (int k = 0; k < 8; ++k) {
                            const int kc = cgp * 8 + k;
                            xc[k] = CWL[512 + kc] + CWL[kc] * uu[rr][k] + CWL[128 + kc] * uu[rr + 1][k] + CWL[256 + kc] * uu[rr + 2][k] + CWL[384 + kc] * uu[rr + 3][k];
                        }
                        uint4 o; o.x = pack2(xc[0], xc[1]); o.y = pack2(xc[2], xc[3]); o.z = pack2(xc[4], xc[5]); o.w = pack2(xc[6], xc[7]);
                        *(uint4*)(Al + (lr + rr) * 136 + cgp * 8) = o;
                    }
                } else {
#pragma unroll
                    for (int rr = 0; rr < 2; ++rr) *(uint4*)(Al + (lr + rr) * 136 + cgp * 8) = make_uint4(0u, 0u, 0u, 0u);
                }
            }
            __syncthreads();
            if (!sample && c + 1 < ntiles) lru_uload(ubuf, U, bg, c + 1, rg, h, cgp);
            f32x4 acc[2][4];
#pragma unroll
            for (int i = 0; i < 2; ++i)
#pragma unroll
                for (int j = 0; j < 4; ++j) acc[i][j] = (f32x4){0.f, 0.f, 0.f, 0.f};
#pragma unroll
            for (int kk = 0; kk < 4; ++kk) {
                bf16x8 af[2], bfr[4];
#pragma unroll
                for (int i = 0; i < 2; ++i) af[i] = *(const bf16x8*)(Al + (wm * 32 + i * 16 + l15) * 136 + kk * 32 + quad * 8);
#pragma unroll
                for (int j = 0; j < 4; ++j) bfr[j] = *(const bf16x8*)(Bl + (wn * 64 + j * 16 + l15) * 136 + kk * 32 + quad * 8);
#pragma unroll
                for (int i = 0; i < 2; ++i)
#pragma unroll
                    for (int j = 0; j < 4; ++j) acc[i][j] = mfma16(bfr[j], af[i], acc[i][j]);
            }
#pragma unroll
            for (int i = 0; i < 2; ++i) {
                const int row = wm * 32 + i * 16 + l15;
#pragma unroll
                for (int j = 0; j < 2; ++j) {
                    const int chl = wn * 32 + j * 16 + quad * 4;
                    const uint2 xr = *(const uint2*)(Al + row * 136 + q * 64 + chl);
                    const float xcv[4] = {bflo(xr.x), bfhi(xr.x), bflo(xr.y), bfhi(xr.y)};
                    f32x4 av, bv;
#pragma unroll
                    for (int e = 0; e < 4; ++e) {
                        const float gr = sigmoidf_(acc[i][j][e] + EPL[chl + e]), gi = sigmoidf_(acc[i][j + 2][e] + EPL[64 + chl + e]);
                        const float la = -8.0f * gr * EPL[128 + chl + e];
                        av[e] = __expf(la);
                        bv[e] = __builtin_amdgcn_sqrtf(fmaxf(1.0f - av[e] * av[e], 0.f)) * gi * xcv[e];
                    }
                    *(f32x4*)(SA + row * 64 + chl) = av;
                    *(f32x4*)(SB + row * 64 + chl) = bv;
                }
            }
            __syncthreads();
            const int ch = tid & 63, seg = tid >> 6;
            if (!sample) {
                float P = 1.f, H = 0.f;
#pragma unroll 4
                for (int rr = 0; rr < 16; ++rr) {
                    const int row = seg * 16 + rr;
                    if (row < nrows) { const float a = SA[row * 64 + ch], bx = SB[row * 64 + ch]; H = a * H + bx; P *= a; }
                }
                SEG[seg * 64 + ch] = P; SEG[512 + seg * 64 + ch] = H;
                __syncthreads();
                hc = CAR[(c & 1) * 64 + ch];
                for (int s2 = 0; s2 < seg; ++s2) hc = SEG[s2 * 64 + ch] * hc + SEG[512 + s2 * 64 + ch];
#pragma unroll
                for (int rr = 0; rr < 16; ++rr) {
                    const int row = seg * 16 + rr;
                    if (row < nrows) {
                        const float a = SA[row * 64 + ch], bx = SB[row * 64 + ch];
                        hc = a * hc + bx;
                        const size_t o = (size_t)(bg * SEQT + c * 128 + row) * E + chbase + ch;
                        Y[o] = f2bf(hc * bf2f(SG[o]));
                    }
                }
                if (seg == 7) CAR[((c + 1) & 1) * 64 + ch] = hc;
            } else {
#pragma unroll 1
                for (int sq = 0; sq < 2; ++sq) {
                    const int sb = bg * 16 + seg * 2 + sq;
                    float hh = p.in[I_ST_LRU_H][(size_t)sb * E + chbase + ch];
#pragma unroll 4
                    for (int t = 0; t < 8; ++t) {
                        const int row = seg * 16 + sq * 8 + t;
                        hh = SA[row * 64 + ch] * hh + SB[row * 64 + ch];
                        const size_t o = (size_t)(RP + sb * 8 + t) * E + chbase + ch;
                        Y[o] = f2bf(hh * bf2f(SG[o]));
                    }
                    p.out[O_S_LRU_H + (size_t)sb * E + chbase + ch] = hh;
                }
            }
        }
        if (!sample && (tid >> 6) == 7) p.out[O_P_LRU_H + (size_t)bg * E + chbase + (tid & 63)] = hc;
        __syncthreads();
    }
}

__device__ __forceinline__ void phase_s5(const Params& p, char* smem) {
    const int lane = opaque_tid() & 63, wave = opaque_tid() >> 6, l15 = lane & 15, quad = lane >> 4;
    float* BU = (float*)(smem + wave * 13312);
    bf16_t* XL = (bf16_t*)(smem + wave * 13312 + 8448);
    float* FL = (float*)(smem + wave * 13312 + 8448 + 4352);
    const bf16_t* U = p.ACT[0]; bf16_t* Y1 = p.ACT[2];
    const int slot4 = (wave & 3) * gridDim.x + blockIdx.x, nslots4 = 4 * gridDim.x;
    const int item_lo = wave < 4 ? 0 : 1024, item_hi = wave < 4 ? 1024 : 1024 + 16384;
    for (int item = item_lo + slot4; item < item_hi; item += nslots4) {
        const bool sample = item >= 1024;
        const int it = sample ? item - 1024 : item, b = it >> 7, g = it & 127;
        const int row0 = sample ? RP + b * 8 : b * SEQT, nsteps = sample ? 8 : SEQT;
        const int n = lane;
        const float dt = __expf(p.in[I_S5_LOGDT][g]);
        const float are = p.in[I_S5_ARE][g * 64 + n], aim = p.in[I_S5_AIM][g * 64 + n];
        const float mag = __expf(dt * are), ang = dt * aim;
        const float abr = mag * __cosf(ang), abi = mag * __sinf(ang);
        const float den = are * are + aim * aim;
        FL[n] = ((abr - 1.0f) * are + abi * aim) / den;
        FL[64 + n] = (abi * are - (abr - 1.0f) * aim) / den;
        wave_lds_sync();
        bf16x8 bbf[8];
#pragma unroll
        for (int grp = 0; grp < 4; ++grp) {
            bbf[grp] = (bf16x8){0, 0, 0, 0, 0, 0, 0, 0}; bbf[grp + 4] = bbf[grp];
            if (quad < 2) {
                const int np = grp * 16 + l15;
                const float fr_ = FL[np], fi_ = FL[64 + np];
                const float* br = p.in[I_S5_BRE] + ((size_t)g * 64 + np) * 16 + quad * 8;
                const float* bi = p.in[I_S5_BIM] + ((size_t)g * 64 + np) * 16 + quad * 8;
                const float4 r0 = *(const float4*)br, r1 = *(const float4*)(br + 4), i0 = *(const float4*)bi, i1 = *(const float4*)(bi + 4);
                const float rr[8] = {r0.x, r0.y, r0.z, r0.w, r1.x, r1.y, r1.z, r1.w}, ii[8] = {i0.x, i0.y, i0.z, i0.w, i1.x, i1.y, i1.z, i1.w};
#pragma unroll
                for (int k = 0; k < 8; ++k) { bbf[grp][k] = (short)f2bf(fr_ * rr[k] - fi_ * ii[k]); bbf[grp + 4][k] = (short)f2bf(fr_ * ii[k] + fi_ * rr[k]); }
            }
        }
        bf16x8 cf[4];
#pragma unroll
        for (int kb = 0; kb < 4; ++kb) {
            const float* src = (kb < 2 ? p.in[I_S5_CRE] : p.in[I_S5_CIM]) + ((size_t)g * 16 + l15) * 64 + (kb & 1) * 32 + quad * 8;
            const float sgn = kb < 2 ? 1.0f : -1.0f;
            const float4 c0 = *(const float4*)src, c1 = *(const float4*)(src + 4);
            cf[kb][0] = (short)f2bf(sgn * c0.x); cf[kb][1] = (short)f2bf(sgn * c0.y); cf[kb][2] = (short)f2bf(sgn * c0.z); cf[kb][3] = (short)f2bf(sgn * c0.w);
            cf[kb][4] = (short)f2bf(sgn * c1.x); cf[kb][5] = (short)f2bf(sgn * c1.y); cf[kb][6] = (short)f2bf(sgn * c1.z); cf[kb][7] = (short)f2bf(sgn * c1.w);
        }
        const float4 dd = *(const float4*)(p.in[I_S5_D] + g * 16 + quad * 4);
        float xr = 0.f, xi = 0.f;
        if (sample) { xr = p.in[I_ST_S5_RE][((size_t)b * 128 + g) * 64 + n]; xi = p.in[I_ST_S5_IM][((size_t)b * 128 + g) * 64 + n]; }
        uint4 ufn = make_uint4(0u, 0u, 0u, 0u); uint2 udn = make_uint2(0u, 0u);
        if (l15 < nsteps) {
            if (quad < 2) ufn = *(const uint4*)(U + (size_t)(row0 + l15) * E + g * 16 + quad * 8);
            udn = *(const uint2*)(U + (size_t)(row0 + l15) * E + g * 16 + quad * 4);
        }
        for (int tt = 0; tt < nsteps; tt += 16) {
            const int nv = min(16, nsteps - tt);
            const uint4 ufc = ufn; const uint2 udc = udn;
            ufn = make_uint4(0u, 0u, 0u, 0u); udn = make_uint2(0u, 0u);
            if (tt + 16 + l15 < nsteps) {
                if (quad < 2) ufn = *(const uint4*)(U + (size_t)(row0 + tt + 16 + l15) * E + g * 16 + quad * 8);
                udn = *(const uint2*)(U + (size_t)(row0 + tt + 16 + l15) * E + g * 16 + quad * 4);
            }
            bf16x8 uf;
            uf[0] = (short)(ufc.x & 0xffffu); uf[1] = (short)(ufc.x >> 16); uf[2] = (short)(ufc.y & 0xffffu); uf[3] = (short)(ufc.y >> 16);
            uf[4] = (short)(ufc.z & 0xffffu); uf[5] = (short)(ufc.z >> 16); uf[6] = (short)(ufc.w & 0xffffu); uf[7] = (short)(ufc.w >> 16);
#pragma unroll
            for (int blk = 0; blk < 8; ++blk) {
                const f32x4 r = mfma16(bbf[blk], uf, (f32x4){0.f, 0.f, 0.f, 0.f});
                *(f32x4*)(BU + l15 * 132 + blk * 16 + quad * 4) = r;
            }
            wave_lds_sync();
            float bur[16], bui[16];
#pragma unroll
            for (int t = 0; t < 16; ++t) { bur[t] = BU[t * 132 + n]; bui[t] = BU[t * 132 + 64 + n]; }
#pragma unroll
            for (int t = 0; t < 16; ++t) {
                if (t < nv) {
                    const float nxr = abr * xr - abi * xi + bur[t], nxi = abr * xi + abi * xr + bui[t];
                    xr = nxr; xi = nxi;
                }
                XL[t * 136 + n] = f2bf(xr); XL[t * 136 + 64 + n] = f2bf(xi);
            }
            wave_lds_sync();
            f32x4 acc = (f32x4){0.f, 0.f, 0.f, 0.f};
#pragma unroll
            for (int kb = 0; kb < 4; ++kb) {
                const bf16x8 xf = *(const bf16x8*)(XL + l15 * 136 + kb * 32 + quad * 8);
                acc = mfma16(cf[kb], xf, acc);
            }
            if (l15 < nv) {
                f32x4 y; y[0] = acc[0] + dd.x * bflo(udc.x); y[1] = acc[1] + dd.y * bfhi(udc.x); y[2] = acc[2] + dd.z * bflo(udc.y); y[3] = acc[3] + dd.w * bfhi(udc.y);
#pragma unroll
                for (int e = 0; e < 4; ++e) { const float v = y[e]; y[e] = 0.5f * v * (1.0f + tanhf_(0.7978845608028654f * (v + 0.044715f * v * v * v))); }
                *(uint2*)(Y1 + (size_t)(row0 + tt + l15) * E + g * 16 + quad * 4) = pack4(y);
            }
            wave_lds_sync();
        }
        float* o = p.out + (sample ? O_S_S5_RE : O_P_S5_RE) + ((size_t)b * 128 + g) * 64 + n;
        o[0] = xr;
        o[(sample ? O_S_S5_IM - O_S_S5_RE : O_P_S5_IM - O_P_S5_RE)] = xi;
    }
}

typedef float f32x2 __attribute__((ext_vector_type(2)));
__device__ __forceinline__ float half_sum(float v) {
#pragma unroll
    for (int o = 16; o > 0; o >>= 1) v += __shfl_xor(v, o, 64);
    return v;
}
__device__ __forceinline__ float dpp_sum8(float x) {
    x += __int_as_float(__builtin_amdgcn_mov_dpp(__float_as_int(x), 0xB1, 0xf, 0xf, true));
    x += __int_as_float(__builtin_amdgcn_mov_dpp(__float_as_int(x), 0x4E, 0xf, 0xf, true));
    x += __int_as_float(__builtin_amdgcn_mov_dpp(__float_as_int(x), 0x141, 0xf, 0xf, true));
    return x;
}
struct RwItem { int sample, b, h, row0, nsteps; };
__device__ __forceinline__ RwItem rw_decode(int item) {
    RwItem r; r.sample = item >= 256; const int it = r.sample ? item - 256 : item; r.b = it >> 5; r.h = it & 31;
    r.row0 = r.sample ? RP + r.b * 8 : r.b * SEQT; r.nsteps = r.sample ? 8 : SEQT; return r;
}
constexpr int RW_NIT = 256 + 4096;
struct RwTile { int item, tt, have; };
__device__ __forceinline__ RwTile rw_next(const RwTile& c) {
    RwTile n = c;
    if (!c.have) return n;
    const int nsteps = c.item >= 256 ? 8 : SEQT;
    n.tt = c.tt + 16;
    if (n.tt >= nsteps) { n.item = c.item + gridDim.x; n.tt = 0; n.have = n.item < RW_NIT; }
    return n;
}
struct RwPre { unsigned r2, k2, v2, d2, a2, g2; float2 kkp, kap, rkp, lnw, lnb; size_t o; int valid; };
struct RwEpi { unsigned g2; float2 lnw, lnb; size_t o; int valid; };
__device__ __forceinline__ void rw_load(RwPre& q, const Params& p, const RwTile& tl, int pt, int c2) {
    const RwItem it = rw_decode(tl.have ? tl.item : 0);
    const int chh = it.h * 64 + c2 * 2;
    q.valid = tl.have && (tl.tt + pt) < it.nsteps;
    q.o = (size_t)(it.row0 + tl.tt + pt) * E + chh;
    q.r2 = q.k2 = q.v2 = q.d2 = q.a2 = q.g2 = 0u;
    if (q.valid) {
        q.r2 = *(const unsigned*)(p.ACT[0] + q.o); q.k2 = *(const unsigned*)(p.ACT[1] + q.o); q.v2 = *(const unsigned*)(p.ACT[2] + q.o);
        q.g2 = *(const unsigned*)(p.ACT[3] + q.o); q.d2 = *(const unsigned*)(p.ACT[4] + q.o); q.a2 = *(const unsigned*)(p.ACT[5] + q.o);
    }
    q.kkp = *(const float2*)(p.in[I_RW_KK] + chh); q.kap = *(const float2*)(p.in[I_RW_KA] + chh); q.rkp = *(const float2*)(p.in[I_RW_RK] + chh);
    q.lnw = *(const float2*)(p.in[I_RW_LNW] + chh); q.lnb = *(const float2*)(p.in[I_RW_LNB] + chh);
}
__device__ __forceinline__ float row_sum16(float x) {
    x += __int_as_float(__builtin_amdgcn_mov_dpp(__float_as_int(x), 0xB1, 0xf, 0xf, true));
    x += __int_as_float(__builtin_amdgcn_mov_dpp(__float_as_int(x), 0x4E, 0xf, 0xf, true));
    x += __int_as_float(__builtin_amdgcn_mov_dpp(__float_as_int(x), 0x141, 0xf, 0xf, true));
    x += __int_as_float(__builtin_amdgcn_mov_dpp(__float_as_int(x), 0x140, 0xf, 0xf, true));
    return x;
}
__device__ __forceinline__ float half_sum32(float x) { x = row_sum16(x); return x + __shfl_xor(x, 16, 64); }
__device__ __forceinline__ void rw_store(const RwPre& q, float* VEC, float* VV, float* BON, int pt, int c2) {
    const float r0 = bflo(q.r2), r1 = bfhi(q.r2), k0 = bflo(q.k2), k1 = bfhi(q.k2), a0 = bflo(q.a2), a1 = bfhi(q.a2);
    const float w0 = __expf(-bflo(q.d2)), w1 = __expf(-bfhi(q.d2));
    float kk0 = k0 * q.kkp.x, kk1 = k1 * q.kkp.y;
    const float ss = half_sum32(kk0 * kk0 + kk1 * kk1);
    const float inv = rsqrtf(fmaxf(ss, 1e-24f));
    kk0 *= inv; kk1 *= inv;
    const float km0 = k0 * (1.0f + (a0 - 1.0f) * q.kap.x), km1 = k1 * (1.0f + (a1 - 1.0f) * q.kap.y);
    const float bon = half_sum32(r0 * km0 * q.rkp.x + r1 * km1 * q.rkp.y);
    float* ve = VEC + pt * 320 + c2 * 2;
    *(float2*)(ve) = make_float2(w0, w1);
    *(float2*)(ve + 64) = make_float2(-kk0, -kk1);
    *(float2*)(ve + 128) = make_float2(kk0 * a0, kk1 * a1);
    *(float2*)(ve + 192) = make_float2(km0, km1);
    *(float2*)(ve + 256) = make_float2(r0, r1);
    *(float2*)(VV + pt * 64 + c2 * 2) = make_float2(bflo(q.v2), bfhi(q.v2));
    if (c2 == 0) BON[pt] = bon;
}
__device__ __forceinline__ void rw_epilogue(const RwEpi& e, const Params& p, const float* VV, const float* BON, const float* YL, int pt, int c2) {
    const float2 yy = *(const float2*)(YL + pt * 64 + c2 * 2);
    const float mean = half_sum32(yy.x + yy.y) * (1.0f / 64.0f);
    const float d0 = yy.x - mean, d1 = yy.y - mean;
    const float var = half_sum32(d0 * d0 + d1 * d1) * (1.0f / 64.0f);
    const float rstd = rsqrtf(var + 64e-5f);
    if (e.valid) {
        const float2 v2 = *(const float2*)(VV + pt * 64 + c2 * 2);
        const float bon = BON[pt];
        const float o0 = (d0 * rstd * e.lnw.x + e.lnb.x + bon * v2.x) * bflo(e.g2);
        const float o1 = (d1 * rstd * e.lnw.y + e.lnb.y + bon * v2.y) * bfhi(e.g2);
        *(unsigned*)(p.ACT[6] + e.o) = pack2(o0, o1);
    }
}
__device__ __forceinline__ RwEpi rw_epi_of(const RwPre& q) { RwEpi e; e.g2 = q.g2; e.lnw = q.lnw; e.lnb = q.lnb; e.o = q.o; e.valid = q.valid; return e; }
struct RwVec { f32x4 w[2], a[2], b[2], k[2], r[2]; float2 vv; };
__device__ __forceinline__ void rw_vload(RwVec& q, const float* VEC, const float* VV, int t, int oct, int v0) {
    const float* ve = VEC + t * 320 + oct * 8;
    q.w[0] = *(const f32x4*)ve; q.w[1] = *(const f32x4*)(ve + 4);
    q.a[0] = *(const f32x4*)(ve + 64); q.a[1] = *(const f32x4*)(ve + 68);
    q.b[0] = *(const f32x4*)(ve + 128); q.b[1] = *(const f32x4*)(ve + 132);
    q.k[0] = *(const f32x4*)(ve + 192); q.k[1] = *(const f32x4*)(ve + 196);
    q.r[0] = *(const f32x4*)(ve + 256); q.r[1] = *(const f32x4*)(ve + 260);
    q.vv = *(const float2*)(VV + t * 64 + v0);
}
__device__ __forceinline__ void rw_step(f32x2 (&S)[2][4], const RwVec& q, float* YL, int t, int oct, int v0) {
    const f32x2 a0 = (f32x2){q.a[0][0], q.a[0][1]}, a1 = (f32x2){q.a[0][2], q.a[0][3]}, a2 = (f32x2){q.a[1][0], q.a[1][1]}, a3 = (f32x2){q.a[1][2], q.a[1][3]};
    const f32x2 sp0 = S[0][0] * a0 + S[0][1] * a1 + S[0][2] * a2 + S[0][3] * a3;
    const f32x2 sp1 = S[1][0] * a0 + S[1][1] * a1 + S[1][2] * a2 + S[1][3] * a3;
    const float sa0 = dpp_sum8(sp0[0] + sp0[1]), sa1 = dpp_sum8(sp1[0] + sp1[1]);
    const f32x2 w0 = (f32x2){q.w[0][0], q.w[0][1]}, w1 = (f32x2){q.w[0][2], q.w[0][3]}, w2 = (f32x2){q.w[1][0], q.w[1][1]}, w3 = (f32x2){q.w[1][2], q.w[1][3]};
    const f32x2 b0 = (f32x2){q.b[0][0], q.b[0][1]}, b1 = (f32x2){q.b[0][2], q.b[0][3]}, b2 = (f32x2){q.b[1][0], q.b[1][1]}, b3 = (f32x2){q.b[1][2], q.b[1][3]};
    const f32x2 k0 = (f32x2){q.k[0][0], q.k[0][1]}, k1 = (f32x2){q.k[0][2], q.k[0][3]}, k2 = (f32x2){q.k[1][0], q.k[1][1]}, k3 = (f32x2){q.k[1][2], q.k[1][3]};
    {
        const f32x2 sa2 = (f32x2){sa0, sa0}, vv2 = (f32x2){q.vv.x, q.vv.x};
        S[0][0] = S[0][0] * w0 + sa2 * b0 + vv2 * k0; S[0][1] = S[0][1] * w1 + sa2 * b1 + vv2 * k1;
        S[0][2] = S[0][2] * w2 + sa2 * b2 + vv2 * k2; S[0][3] = S[0][3] * w3 + sa2 * b3 + vv2 * k3;
    }
    {
        const f32x2 sa2 = (f32x2){sa1, sa1}, vv2 = (f32x2){q.vv.y, q.vv.y};
        S[1][0] = S[1][0] * w0 + sa2 * b0 + vv2 * k0; S[1][1] = S[1][1] * w1 + sa2 * b1 + vv2 * k1;
        S[1][2] = S[1][2] * w2 + sa2 * b2 + vv2 * k2; S[1][3] = S[1][3] * w3 + sa2 * b3 + vv2 * k3;
    }
    const f32x2 r0 = (f32x2){q.r[0][0], q.r[0][1]}, r1 = (f32x2){q.r[0][2], q.r[0][3]}, r2 = (f32x2){q.r[1][0], q.r[1][1]}, r3 = (f32x2){q.r[1][2], q.r[1][3]};
    const f32x2 yp0 = S[0][0] * r0 + S[0][1] * r1 + S[0][2] * r2 + S[0][3] * r3;
    const f32x2 yp1 = S[1][0] * r0 + S[1][1] * r1 + S[1][2] * r2 + S[1][3] * r3;
    const float y0 = dpp_sum8(yp0[0] + yp0[1]), y1 = dpp_sum8(yp1[0] + yp1[1]);
    if (oct == 0) *(float2*)(YL + t * 64 + v0) = make_float2(y0, y1);
}
__device__ __forceinline__ void phase_rwkv(const Params& p, char* smem) {
    constexpr int BUF_F = 16 * 5 * 64 + 16 * 64 + 64 + 16 * 64;
    float* base = (float*)smem;
    const int tid = opaque_tid(), lane = tid & 63, wave = tid >> 6;
    const bool scanner = wave < 4;
    const int oct = lane & 7, v0 = (wave & 3) * 16 + (lane >> 3) * 2;
    const int hid = tid & 255, pt0 = hid >> 5, c2 = hid & 31;
    RwTile tk; tk.item = blockIdx.x; tk.tt = 0; tk.have = blockIdx.x < RW_NIT;
    f32x2 S[2][4], Sn[2][4];
#pragma unroll
    for (int r = 0; r < 2; ++r)
#pragma unroll
        for (int i = 0; i < 4; ++i) { S[r][i] = (f32x2){0.f, 0.f}; Sn[r][i] = S[r][i]; }
    RwPre preN[2]; RwEpi epiP[2], epiC[2];
    epiP[0].valid = 0; epiP[1].valid = 0; epiP[0].o = 0; epiP[1].o = 0; epiP[0].g2 = 0; epiP[1].g2 = 0;
    epiP[0].lnw = epiP[0].lnb = epiP[1].lnw = epiP[1].lnb = make_float2(0.f, 0.f);
    epiC[0] = epiP[0]; epiC[1] = epiP[1];
    if (scanner) {
        const RwItem it = rw_decode(tk.have ? tk.item : 0);
        if (tk.have && it.sample) {
#pragma unroll
            for (int r = 0; r < 2; ++r) {
                const float* st = p.in[I_ST_RW_WKV] + (((size_t)it.b * 32 + it.h) * 64 + v0 + r) * 64 + oct * 8;
                const float4 s0 = *(const float4*)st, s1 = *(const float4*)(st + 4);
                Sn[r][0] = (f32x2){s0.x, s0.y}; Sn[r][1] = (f32x2){s0.z, s0.w}; Sn[r][2] = (f32x2){s1.x, s1.y}; Sn[r][3] = (f32x2){s1.z, s1.w};
            }
        }
    } else {
        RwPre pre0[2];
        rw_load(pre0[0], p, tk, pt0, c2); rw_load(pre0[1], p, tk, pt0 + 8, c2);
        const RwTile t1 = rw_next(tk);
        rw_load(preN[0], p, t1, pt0, c2); rw_load(preN[1], p, t1, pt0 + 8, c2);
        rw_store(pre0[0], base, base + 5120, base + 6144, pt0, c2); rw_store(pre0[1], base, base + 5120, base + 6144, pt0 + 8, c2);
        epiC[0] = rw_epi_of(pre0[0]); epiC[1] = rw_epi_of(pre0[1]);
    }
    __syncthreads();
    int kb = 0;
    bool first = true;
    while (tk.have) {
        const RwTile t1 = rw_next(tk);
        const int kn = kb == 2 ? 0 : kb + 1, kp = kb == 0 ? 2 : kb - 1;
        if (scanner) {
            const RwItem cur = rw_decode(tk.item);
            f32x2 Snn[2][4];
#pragma unroll
            for (int r = 0; r < 2; ++r)
#pragma unroll
                for (int i = 0; i < 4; ++i) Snn[r][i] = (f32x2){0.f, 0.f};
            if (t1.have && t1.tt == 0 && t1.item >= 256) {
                const RwItem nx = rw_decode(t1.item);
#pragma unroll
                for (int r = 0; r < 2; ++r) {
                    const float* st = p.in[I_ST_RW_WKV] + (((size_t)nx.b * 32 + nx.h) * 64 + v0 + r) * 64 + oct * 8;
                    const float4 s0 = *(const float4*)st, s1 = *(const float4*)(st + 4);
                    Snn[r][0] = (f32x2){s0.x, s0.y}; Snn[r][1] = (f32x2){s0.z, s0.w}; Snn[r][2] = (f32x2){s1.x, s1.y}; Snn[r][3] = (f32x2){s1.z, s1.w};
                }
            }
            if (tk.tt == 0) {
#pragma unroll
                for (int r = 0; r < 2; ++r)
#pragma unroll
                    for (int i = 0; i < 4; ++i) S[r][i] = Sn[r][i];
            }
            {
                const float* VEC = base + kb * BUF_F; const float* VV = VEC + 5120; float* YL = base + kb * BUF_F + 6144 + 64;
                const int nv = min(16, cur.nsteps - tk.tt);
                RwVec A, B;
                rw_vload(A, VEC, VV, 0, oct, v0);
                for (int t = 0; t < nv; t += 2) {
                    rw_vload(B, VEC, VV, t + 1, oct, v0);
                    rw_step(S, A, YL, t, oct, v0);
                    rw_vload(A, VEC, VV, t + 2, oct, v0);
                    rw_step(S, B, YL, t + 1, oct, v0);
                }
            }
            if (tk.tt + 16 >= cur.nsteps) {
#pragma unroll
                for (int r = 0; r < 2; ++r) {
                    float* dst = p.out + (cur.sample ? O_S_RW_WKV : O_P_RW_WKV) + (((size_t)cur.b * 32 + cur.h) * 64 + v0 + r) * 64 + oct * 8;
                    *(float4*)dst = make_float4(S[r][0][0], S[r][0][1], S[r][1][0], S[r][1][1]);
                    *(float4*)(dst + 4) = make_float4(S[r][2][0], S[r][2][1], S[r][3][0], S[r][3][1]);
                }
            }
            if (t1.tt == 0) {
#pragma unroll
                for (int r = 0; r < 2; ++r)
#pragma unroll
                    for (int i = 0; i < 4; ++i) Sn[r][i] = Snn[r][i];
            }
        } else {
            float* Bn = base + kn * BUF_F;
            rw_store(preN[0], Bn, Bn + 5120, Bn + 6144, pt0, c2); rw_store(preN[1], Bn, Bn + 5120, Bn + 6144, pt0 + 8, c2);
            RwEpi epiN[2]; epiN[0] = rw_epi_of(preN[0]); epiN[1] = rw_epi_of(preN[1]);
            const RwTile t2 = rw_next(t1);
            rw_load(preN[0], p, t2, pt0, c2); rw_load(preN[1], p, t2, pt0 + 8, c2);
            if (!first) {
                const float* Bp = base + kp * BUF_F;
                rw_epilogue(epiP[0], p, Bp + 5120, Bp + 6144, Bp + 6144 + 64, pt0, c2); rw_epilogue(epiP[1], p, Bp + 5120, Bp + 6144, Bp + 6144 + 64, pt0 + 8, c2);
            }
            epiP[0] = epiC[0]; epiP[1] = epiC[1]; epiC[0] = epiN[0]; epiC[1] = epiN[1];
        }
        __syncthreads();
        tk = t1; kb = kn; first = false;
    }
    if (!scanner && !first) {
        const int kp = kb == 0 ? 2 : kb - 1;
        const float* Bp = base + kp * BUF_F;
        rw_epilogue(epiP[0], p, Bp + 5120, Bp + 6144, Bp + 6144 + 64, pt0, c2); rw_epilogue(epiP[1], p, Bp + 5120, Bp + 6144, Bp + 6144 + 64, pt0 + 8, c2);
    }
}

__device__ __forceinline__ void ret_gload(uint4 (&qn)[4], uint4 (&kn)[4], uint4& vn, const bf16_t* Q, const bf16_t* Kg, const bf16_t* V,
                                          int row0, int c0, int nsteps, int h, int s, int tid, int lane, int wave) {
    const int Lv = min(64, nsteps - c0);
#pragma unroll
    for (int i4 = 0; i4 < 4; ++i4) {
        const int idx = tid + i4 * 512, row = idx >> 5, kc = (idx & 31) * 8;
        qn[i4] = make_uint4(0u, 0u, 0u, 0u); kn[i4] = qn[i4];
        if (row < Lv) qn[i4] = *(const uint4*)(Q + (size_t)(row0 + c0 + row) * D + h * 256 + kc);
        if (lane < Lv) kn[i4] = *(const uint4*)(Kg + (size_t)(row0 + c0 + lane) * D + h * 256 + (wave + i4 * 8) * 8);
    }
    vn = make_uint4(0u, 0u, 0u, 0u);
    if (lane < Lv) vn = *(const uint4*)(V + (size_t)(row0 + c0 + lane) * E + h * 512 + s * 64 + wave * 8);
}
__device__ __forceinline__ void phase_ret(const Params& p, char* smem) {
    bf16_t* Ql = (bf16_t*)smem;
    bf16_t* Kl = Ql + 64 * 264;
    bf16_t* VT = Kl + 256 * 72;
    bf16_t* Pl = VT + 64 * 72;
    bf16_t* ST = Pl + 64 * 72;
    const int tid = opaque_tid(), lane = tid & 63, wave = tid >> 6, l15 = lane & 15, quad = lane >> 4;
    const bf16_t* Q = p.ACT[0]; const bf16_t* Kg = p.ACT[1]; const bf16_t* V = p.ACT[2]; bf16_t* Y = p.ACT[4];
    for (int item = blockIdx.x; item < 256 + 4096; item += gridDim.x) {
        const bool sample = item >= 256;
        const int it = sample ? item - 256 : item, b = it >> 5, h = (it >> 3) & 3, s = it & 7;
        const int row0 = sample ? RP + b * 8 : b * SEQT, nsteps = sample ? 8 : SEQT;
        const float lg2 = log2f(1.0f - exp2f(-5.0f - (float)h));
        f32x4 accS[2][4];
        const size_t sbase = (((size_t)b * 4 + h) * 256 + wave * 32 + quad * 4) * 512 + s * 64 + l15;
#pragma unroll
        for (int i = 0; i < 2; ++i)
#pragma unroll
            for (int j = 0; j < 4; ++j) {
                if (sample) {
#pragma unroll
                    for (int e = 0; e < 4; ++e) accS[i][j][e] = p.in[I_ST_RET][sbase + (size_t)(i * 16 + e) * 512 + j * 16];
                } else accS[i][j] = (f32x4){0.f, 0.f, 0.f, 0.f};
            }
#pragma unroll
        for (int i = 0; i < 2; ++i)
#pragma unroll
            for (int j = 0; j < 4; ++j) *(uint2*)(ST + (j * 16 + l15) * 264 + wave * 32 + i * 16 + quad * 4) = pack4(accS[i][j]);
        uint4 qn[4], kn[4], vn;
        ret_gload(qn, kn, vn, Q, Kg, V, row0, 0, nsteps, h, s, tid, lane, wave);
        for (int c0 = 0; c0 < nsteps; c0 += 64) {
            const int Lv = min(64, nsteps - c0);
            uint4 kq[4];
#pragma unroll
            for (int i4 = 0; i4 < 4; ++i4) {
                const int idx = tid + i4 * 512, row = idx >> 5, kc = (idx & 31) * 8;
                kq[i4] = kn[i4];
                *(uint4*)(Ql + row * 264 + kc) = qn[i4];
                *(uint4*)(Kl + lane * 264 + (wave + i4 * 8) * 8) = kq[i4];
            }
            {
                const int row = lane, dvc = wave * 8; const uint4 vv = vn;
                VT[(dvc + 0) * 72 + row] = (bf16_t)(vv.x & 0xffffu); VT[(dvc + 1) * 72 + row] = (bf16_t)(vv.x >> 16);
                VT[(dvc + 2) * 72 + row] = (bf16_t)(vv.y & 0xffffu); VT[(dvc + 3) * 72 + row] = (bf16_t)(vv.y >> 16);
                VT[(dvc + 4) * 72 + row] = (bf16_t)(vv.z & 0xffffu); VT[(dvc + 5) * 72 + row] = (bf16_t)(vv.z >> 16);
                VT[(dvc + 6) * 72 + row] = (bf16_t)(vv.w & 0xffffu); VT[(dvc + 7) * 72 + row] = (bf16_t)(vv.w >> 16);
            }
            __syncthreads();
            if (c0 + 64 < nsteps) ret_gload(qn, kn, vn, Q, Kg, V, row0, c0 + 64, nsteps, h, s, tid, lane, wave);
            uint2 gpre[2];
#pragma unroll
            for (int d2 = 0; d2 < 2; ++d2)
                gpre[d2] = *(const uint2*)(p.ACT[3] + (size_t)(row0 + c0 + (wave >> 1) * 16 + l15) * E + h * 512 + s * 64 + ((wave & 1) * 2 + d2) * 16 + quad * 4);
            {
                const int ti = wave >> 1, t_abs = ti * 16 + l15;
#pragma unroll
                for (int s2 = 0; s2 < 2; ++s2) {
                    const int si = (wave & 1) * 2 + s2;
                    f32x4 acc = (f32x4){0.f, 0.f, 0.f, 0.f};
#pragma unroll
                    for (int kb = 0; kb < 8; ++kb) {
                        const bf16x8 kf = *(const bf16x8*)(Kl + (si * 16 + l15) * 264 + kb * 32 + quad * 8);
                        const bf16x8 qf = *(const bf16x8*)(Ql + (ti * 16 + l15) * 264 + kb * 32 + quad * 8);
                        acc = mfma16(kf, qf, acc);
                    }
                    f32x4 pv;
#pragma unroll
                    for (int e = 0; e < 4; ++e) { const int s_abs = si * 16 + quad * 4 + e; pv[e] = s_abs <= t_abs ? acc[e] * __builtin_amdgcn_exp2f((float)(t_abs - s_abs) * lg2) : 0.f; }
                    *(uint2*)(Pl + t_abs * 72 + si * 16 + quad * 4) = pack4(pv);
                }
            }
            __syncthreads();
#pragma unroll
            for (int i4 = 0; i4 < 4; ++i4) {
                const int row = lane, kc = (wave + i4 * 8) * 8;
                const float wgt = row < Lv ? __builtin_amdgcn_exp2f((float)(Lv - 1 - row) * lg2) : 0.f;
                const uint4 kv = kq[i4];
                Kl[(kc + 0) * 72 + row] = f2bf(bflo(kv.x) * wgt); Kl[(kc + 1) * 72 + row] = f2bf(bfhi(kv.x) * wgt);
                Kl[(kc + 2) * 72 + row] = f2bf(bflo(kv.y) * wgt); Kl[(kc + 3) * 72 + row] = f2bf(bfhi(kv.y) * wgt);
                Kl[(kc + 4) * 72 + row] = f2bf(bflo(kv.z) * wgt); Kl[(kc + 5) * 72 + row] = f2bf(bfhi(kv.z) * wgt);
                Kl[(kc + 6) * 72 + row] = f2bf(bflo(kv.w) * wgt); Kl[(kc + 7) * 72 + row] = f2bf(bfhi(kv.w) * wgt);
            }
            __syncthreads();
            {
                const int ti = wave >> 1, t_abs = ti * 16 + l15;
                const float dec = __builtin_amdgcn_exp2f((float)(t_abs + 1) * lg2);
                float ssq = 0.f;
#pragma unroll
                for (int d2 = 0; d2 < 2; ++d2) {
                    const int dvt = (wave & 1) * 2 + d2;
                    f32x4 a1 = (f32x4){0.f, 0.f, 0.f, 0.f}, a2 = a1;
#pragma unroll
                    for (int kb = 0; kb < 2; ++kb) {
                        const bf16x8 vf = *(const bf16x8*)(VT + (dvt * 16 + l15) * 72 + kb * 32 + quad * 8);
                        const bf16x8 pf = *(const bf16x8*)(Pl + (ti * 16 + l15) * 72 + kb * 32 + quad * 8);
                        a1 = mfma16(vf, pf, a1);
                    }
#pragma unroll
                    for (int kb = 0; kb < 8; ++kb) {
                        const bf16x8 sf = *(const bf16x8*)(ST + (dvt * 16 + l15) * 264 + kb * 32 + quad * 8);
                        const bf16x8 qf = *(const bf16x8*)(Ql + (ti * 16 + l15) * 264 + kb * 32 + quad * 8);
                        a2 = mfma16(sf, qf, a2);
                    }
                    f32x4 yv;
#pragma unroll
                    for (int e = 0; e < 4; ++e) { yv[e] = a1[e] + dec * a2[e]; ssq += yv[e] * yv[e]; }
                    if (t_abs < Lv) {
                        const size_t yo = (size_t)(row0 + c0 + t_abs) * E + h * 512 + s * 64 + dvt * 16 + quad * 4;
                        const uint2 gg = gpre[d2];
                        yv[0] *= bflo(gg.x); yv[1] *= bfhi(gg.x); yv[2] *= bflo(gg.y); yv[3] *= bfhi(gg.y);
                        *(uint2*)(Y + yo) = pack4(yv);
                    }
                }
                ssq += __shfl_xor(ssq, 16, 64); ssq += __shfl_xor(ssq, 32, 64);
                if (quad == 0 && t_abs < Lv) p.SSP[(size_t)(row0 + c0 + t_abs) * 64 + h * 16 + s * 2 + (wave & 1)] = ssq;
            }
            {
                const float dL = __builtin_amdgcn_exp2f((float)Lv * lg2);
#pragma unroll
                for (int i = 0; i < 2; ++i)
#pragma unroll
                    for (int j = 0; j < 4; ++j) accS[i][j] *= dL;
#pragma unroll
                for (int kb = 0; kb < 2; ++kb) {
                    bf16x8 kf[2], vf[4];
#pragma unroll
                    for (int i = 0; i < 2; ++i) kf[i] = *(const bf16x8*)(Kl + (wave * 32 + i * 16 + l15) * 72 + kb * 32 + quad * 8);
#pragma unroll
                    for (int j = 0; j < 4; ++j) vf[j] = *(const bf16x8*)(VT + (j * 16 + l15) * 72 + kb * 32 + quad * 8);
#pragma unroll
                    for (int i = 0; i < 2; ++i)
#pragma unroll
                        for (int j = 0; j < 4; ++j) accS[i][j] = mfma16(kf[i], vf[j], accS[i][j]);
                }
            }
            __syncthreads();
            if (c0 + 64 < nsteps) {
#pragma unroll
                for (int i = 0; i < 2; ++i)
#pragma unroll
                    for (int j = 0; j < 4; ++j) *(uint2*)(ST + (j * 16 + l15) * 264 + wave * 32 + i * 16 + quad * 4) = pack4(accS[i][j]);
            }
        }
        float* dst = p.out + (sample ? O_S_RET : O_P_RET);
#pragma unroll
        for (int i = 0; i < 2; ++i)
#pragma unroll
            for (int j = 0; j < 4; ++j)
#pragma unroll
                for (int e = 0; e < 4; ++e) dst[sbase + (size_t)(i * 16 + e) * 512 + j * 16] = accS[i][j][e];
        __syncthreads();
    }
}

#define XB_TMO      128
#define XB_XCNT(j)  (256  + 64 * (j))
#define XB_XSUB(j)  (1280 + 64 * (j))
#define XB_XGEN(j)  (2304 + 64 * (j))
#define XB_TOP      3328
#define XB_TOPGEN   3392
#define XCD_BAR_WORDS 3456
#define XB_SPIN_CAP (1u << 22)
__device__ __forceinline__ unsigned xb_ld(unsigned* p)              { return __hip_atomic_load(p, __ATOMIC_RELAXED, __HIP_MEMORY_SCOPE_AGENT); }
__device__ __forceinline__ unsigned xb_add(unsigned* p, unsigned v) { return __hip_atomic_fetch_add(p, v, __ATOMIC_RELAXED, __HIP_MEMORY_SCOPE_AGENT); }
__device__ __forceinline__ unsigned xb_xcc_id() { return (unsigned)__builtin_amdgcn_s_getreg((3 << 11) | 20) & 0xFu; }
#define XB_SPIN(cond, bar) do { unsigned _sp = 0; while (cond) { __builtin_amdgcn_s_sleep(1); \
    if ((++_sp & 255u) == 0u) { if (xb_ld(&(bar)[XB_TMO])) break; if (_sp > XB_SPIN_CAP) { atomicAdd(&(bar)[XB_TMO], 1u); break; } } } } while (0)
struct XcdBarrier { unsigned* bar; unsigned x; volatile LAS unsigned* st; };
__device__ __forceinline__ XcdBarrier xcd_barrier_post(unsigned* bar, volatile LAS unsigned* st) {
    XcdBarrier b; b.bar = bar; b.x = xb_xcc_id(); b.st = st;
    if (threadIdx.x == 0) st[3] = xb_add(&bar[XB_XCNT(b.x)], 1u);
    return b;
}
__device__ __forceinline__ void xcd_barrier_complete(unsigned* bar, unsigned x, unsigned& nloc, unsigned& nx) {
    const unsigned G = gridDim.x * gridDim.y * gridDim.z;
    unsigned sum, cnt, mine, sp = 0u;
    for (;;) {
        sum = 0u; cnt = 0u; mine = 0u;
#pragma unroll
        for (unsigned j = 0; j < 16; ++j) { const unsigned c = xb_ld(&bar[XB_XCNT(j)]); sum += c; cnt += (c > 0u) ? 1u : 0u; mine = (j == x) ? c : mine; }
        if (sum == G) break;
        __builtin_amdgcn_s_sleep(1);
        if ((++sp & 255u) == 0u) { if (xb_ld(&bar[XB_TMO])) break; if (sp > XB_SPIN_CAP) { atomicAdd(&bar[XB_TMO], 1u); break; } }
    }
    nloc = mine > 0u ? mine : 1u; nx = cnt > 0u ? cnt : 1u;
}
__device__ __forceinline__ void xcd_barrier(const XcdBarrier& b) {
    asm volatile("s_waitcnt vmcnt(0)" ::: "memory");
    __syncthreads();
    if (threadIdx.x == 0) {
        unsigned* bar = b.bar;
        __builtin_amdgcn_s_waitcnt(0);
        unsigned nloc = b.st[0], nx = b.st[1];
        if (nloc == 0u) { xcd_barrier_complete(bar, b.x, nloc, nx); b.st[0] = nloc; b.st[1] = nx; }
        const unsigned old = xb_add(&bar[XB_XSUB(b.x)], 1u);
        const unsigned gen = old / nloc;
        if (old + 1u == (gen + 1u) * nloc) {
            __builtin_amdgcn_fence(__ATOMIC_RELEASE, "agent");
            asm volatile("s_waitcnt vmcnt(0)" ::: "memory");
            const unsigned og = xb_add(&bar[XB_TOP], 1u);
            const unsigned tg = og / nx;
            if (og + 1u == (tg + 1u) * nx) xb_add(&bar[XB_TOPGEN], 1u);
            else XB_SPIN(xb_ld(&bar[XB_TOPGEN]) == tg, bar);
            __builtin_amdgcn_fence(__ATOMIC_ACQUIRE, "agent");
            xb_add(&bar[XB_XGEN(b.x)], 1u);
            asm volatile("s_waitcnt vmcnt(0)" ::: "memory");
        } else {
            XB_SPIN(xb_ld(&bar[XB_XGEN(b.x)]) == gen, bar);
            __builtin_amdgcn_fence(__ATOMIC_ACQUIRE, "agent");
            asm volatile("s_waitcnt vmcnt(0)" ::: "memory");
        }
    }
    __syncthreads();
}

__global__ void __launch_bounds__(NTHREADS) fwd_megakernel(Params p) {
    extern __shared__ __attribute__((aligned(16))) char smem[];
    cg::grid_group grid = cg::this_grid();
    volatile LAS unsigned* xst = (volatile LAS unsigned*)(smem + LDS_BYTES - 16);
    if (threadIdx.x < 4) xst[threadIdx.x] = threadIdx.x == 2 ? blockIdx.x : 0u;
    __syncthreads();
    const XcdBarrier xb = xcd_barrier_post(p.bar, xst);
    phase_prep(p, smem);
    phase_norm(p, 0, 0, p.X, p.X);
    grid.sync();
    if (threadIdx.x == 0) {
        bool even = gridDim.x == 256;
        for (int j = 0; j < 8; ++j) even = even && xb_ld(&p.bar[XB_XCNT(j)]) == 32u;
        if (even) xst[2] = xb.x + 8u * xst[3];
    }
    __syncthreads();
    phase_gemm_inproj(p, smem, W_LRU_IN, true);
    xcd_barrier(xb);
    phase_lru(p, smem);
    xcd_barrier(xb);
    phase_gemm_out(p, smem, W_LRU_OUT, p.ACT[2]);
    xcd_barrier(xb);
    phase_norm(p, 1, 1, p.X, p.X);
    xcd_barrier(xb);
    phase_gemm_inproj(p, smem, W_S5_IN, false);
    xcd_barrier(xb);
    phase_s5(p, smem);
    xcd_barrier(xb);
    phase_gemm_glu(p, smem);
    xcd_barrier(xb);
    phase_gemm_out(p, smem, W_S5_OUT, p.ACT[3]);
    xcd_barrier(xb);
    phase_norm_rwkv(p, p.X, p.X2);
    xcd_barrier(xb);
    phase_gemm_rwkv_in(p, smem);
    xcd_barrier(xb);
    phase_gemm_lora2(p, smem);
    xcd_barrier(xb);
    phase_rwkv(p, smem);
    xcd_barrier(xb);
    phase_gemm_out(p, smem, W_RW_OUT, p.ACT[6]);
    xcd_barrier(xb);
    phase_norm(p, 1, 3, p.X2, p.X2);
    xcd_barrier(xb);
    phase_gemm_ret_in(p, smem);
    xcd_barrier(xb);
    phase_ret(p, smem);
    xcd_barrier(xb);
    phase_gemm_ret_out(p, smem);
    xcd_barrier(xb);
    phase_norm(p, 3, 4, p.X2, p.X2);
}

extern "C" void kernel_launch(void* const* d_in, const int* in_sizes, int n_in, void* d_out, int out_size, void* d_ws, size_t ws_size, hipStream_t stream) {
    static int grid_blocks = 0;
    if (!grid_blocks) {
        int dev = 0, cus = 0, per_cu = 0;
        hipGetDevice(&dev);
        hipDeviceGetAttribute(&cus, hipDeviceAttributeMultiprocessorCount, dev);
        hipFuncSetAttribute((const void*)fwd_megakernel, hipFuncAttributeMaxDynamicSharedMemorySize, LDS_BYTES);
        hipOccupancyMaxActiveBlocksPerMultiprocessor(&per_cu, fwd_megakernel, NTHREADS, LDS_BYTES);
        if (per_cu < 1) per_cu = 1;
        if (per_cu > 1) per_cu = 1;
        grid_blocks = cus * per_cu;
    }
    Params p{};
    for (int i = 0; i < N_IN; ++i) p.in[i] = (const float*)d_in[i];
    p.out = (float*)d_out;
    char* ws = (char*)d_ws;
    size_t off = 0;
    auto take = [&](size_t bytes) { char* r = ws + off; off += (bytes + 255) & ~(size_t)255; return r; };
    p.X = (float*)take((size_t)RPAD * D * 4);
    p.Z = (float*)take((size_t)RPAD * D * 4);
    p.XN = (bf16_t*)take((size_t)RPAD * D * 2);
    p.XM = (bf16_t*)take((size_t)6 * RPAD * D * 2);
    p.X2 = (float*)take((size_t)RPAD * D * 4);
    for (int i = 0; i < 7; ++i) p.ACT[i] = (bf16_t*)take((size_t)RPAD * E * 2);
    p.L1 = (bf16_t*)take((size_t)RPAD * 128 * 2);
    p.SSP = (float*)take((size_t)R * 64 * 4);
    for (int j = 0; j < N_W; ++j) p.W[j] = (bf16_t*)take((size_t)w_rows(j) * w_k(j) * 2);
    p.bar = (unsigned*)take(XCD_BAR_WORDS * 4);
    if (off > ws_size) { fprintf(stderr, "workspace too small: need %zu have %zu\n", off, ws_size); return; }
    hipMemsetAsync(p.bar, 0, XCD_BAR_WORDS * 4, stream);
    void* args[] = {&p};
    hipError_t e = hipLaunchCooperativeKernel((const void*)fwd_megakernel, dim3(grid_blocks), dim3(NTHREADS), args, LDS_BYTES, stream);
    if (e != hipSuccess) fprintf(stderr, "cooperative launch failed: %s (grid %d)\n", hipGetErrorString(e), grid_blocks);
}
```
